# Optimizing an MI355X kernel written in HIP

```python
import jax, jax.numpy as jnp
from jax import lax
import numpy as np

D_MODEL = 1024
BATCH = 8
SEQ = 2048
DEPTH = 4
DEC_BATCH = 128
DEC_SEQ = 1
PAST_LEN = 16384
PAGE_SIZE = 128

N_EVEN = (DEPTH + 1) // 2
N_ODD = DEPTH // 2
CHUNK = 128
W_A = D_MODEL // 2
H_A = 8
DH_A = W_A // H_A
W_B = D_MODEL // 2
H_B = 8
DH_B = W_B // H_B
CONV_W = 4
LRU_C = 8.0
D_IN = 2 * W_A + 2 * W_B
POOL_WINDOWS = (2, 4, 8, 16)
N_POOL = len(POOL_WINDOWS)
G_POOL = D_MODEL // N_POOL
POOL_HIST = max(POOL_WINDOWS) - 1
D_FF = 4 * D_MODEL
EPS = 1e-6

kernel_name = 'hybrid_sgu_rglru_pool_decoder_step'


def rmsnorm(x, g):
    xf = x.astype(jnp.float32)
    y = xf * lax.rsqrt(jnp.mean(xf * xf, axis=-1, keepdims=True) + EPS)
    return (y * g.astype(jnp.float32)).astype(x.dtype)


def chunk_spatial_gate(u, v, ws, bs):
    b, l, _ = v.shape
    n_chunks = -(-l // CHUNK)
    pad = n_chunks * CHUNK - l
    vp = jnp.pad(v, ((0, 0), (0, pad), (0, 0))).reshape(b, n_chunks, CHUNK, H_A, DH_A)
    mask = jnp.tril(jnp.ones((CHUNK, CHUNK), dtype=bool))
    wm = jnp.where(mask, ws, 0).astype(v.dtype)
    s = jnp.einsum('hts,bcshd->bcthd', wm, vp) + bs.T.astype(v.dtype)[None, None, :, :, None]
    s = s.reshape(b, n_chunks * CHUNK, W_A)[:, :l]
    return u * s


def causal_conv(x, hist, w, bias):
    xx = jnp.concatenate([hist.astype(x.dtype), x], axis=1)
    l = x.shape[1]
    y = bias + sum(xx[:, k:k + l] * w[k] for k in range(CONV_W))
    return y, xx[:, -(CONV_W - 1):]


def rg_lru(xc, h0, wa, ba, wx, bx, lam):
    b, l, _ = xc.shape
    xh = xc.reshape(b, l, H_B, DH_B)
    r = jax.nn.sigmoid(jnp.einsum('blhi,hij->blhj', xh, wa).reshape(b, l, W_B) + ba)
    i = jax.nn.sigmoid(jnp.einsum('blhi,hij->blhj', xh, wx).reshape(b, l, W_B) + bx)
    log_a = (-LRU_C * r.astype(jnp.float32)) * jax.nn.softplus(-lam.astype(jnp.float32))
    a = jnp.exp(log_a)
    mult = jnp.sqrt(-jnp.expm1(2.0 * log_a))
    bt = mult * (i * xc).astype(jnp.float32)

    def step(h, ab):
        a_t, b_t = ab
        h = a_t * h + b_t
        return h, h

    h_last, hs = lax.scan(step, h0.astype(jnp.float32), (jnp.swapaxes(a, 0, 1), jnp.swapaxes(bt, 0, 1)))
    return jnp.swapaxes(hs, 0, 1).astype(xc.dtype), h_last.astype(h0.dtype)


def even_mixer(xn, conv_hist, h0, w_in, w_out, v_norm, sgu_w, sgu_b, conv_w, conv_b,
               gate_a_w, gate_a_b, gate_x_w, gate_x_b, lru_lambda):
    proj = xn @ w_in
    u = jax.nn.gelu(proj[..., :W_A])
    v = rmsnorm(jax.nn.gelu(proj[..., W_A:2 * W_A]), v_norm)
    gate = proj[..., 2 * W_A:2 * W_A + W_B]
    xb = proj[..., 2 * W_A + W_B:]
    a_out = chunk_spatial_gate(u, v, sgu_w, sgu_b)
    xc, conv_new = causal_conv(xb, conv_hist, conv_w, conv_b)
    hs, h_new = rg_lru(xc, h0, gate_a_w, gate_a_b, gate_x_w, gate_x_b, lru_lambda)
    b_out = hs * jax.nn.gelu(gate)
    y = jnp.concatenate([a_out, b_out], axis=-1) @ w_out
    return y, v, conv_new, h_new


def multi_pool(xn, hist, start_pos, wp, bp, scale):
    b, l, d = xn.shape
    z = jnp.concatenate([hist.astype(xn.dtype), xn], axis=1)
    zf = z.astype(jnp.float32)
    cs = jnp.concatenate([jnp.zeros((b, 1, d), jnp.float32), jnp.cumsum(zf, axis=1)], axis=1)
    pos = start_pos + jnp.arange(l)
    outs = []
    for g, w in enumerate(POOL_WINDOWS):
        sl = slice(g * G_POOL, (g + 1) * G_POOL)
        wsum = cs[:, POOL_HIST + 1:POOL_HIST + 1 + l, sl] - cs[:, POOL_HIST + 1 - w:POOL_HIST + 1 - w + l, sl]
        cnt = jnp.minimum(pos + 1, w).astype(jnp.float32)[None, :, None]
        outs.append(wsum / cnt - xn[..., sl].astype(jnp.float32))
    p = jnp.stack(outs, axis=2).astype(xn.dtype)
    y = jnp.einsum('blgi,gij->blgj', p, wp).reshape(b, l, d) + bp
    return y * scale, z[:, -POOL_HIST:]


def channel_mlp(xn, w1, w2):
    return jnp.square(jax.nn.relu(xn @ w1)) @ w2


def setup_inputs(seed: int = 0) -> dict:
    key = jax.random.key(seed)
    ks = jax.random.split(key, 32)
    f32 = jnp.float32

    def nrm(k, shape, s):
        return jax.random.normal(k, shape, f32) * s

    a0 = jax.random.uniform(ks[15], (N_EVEN, W_B), f32, 0.9, 0.999)
    p = a0 ** (1.0 / LRU_C)
    lru_lambda = jnp.log(p) - jnp.log1p(-p)
    return {
        'x_prompt': nrm(ks[0], (BATCH, SEQ, D_MODEL), 1.0),
        'x_sample': nrm(ks[1], (DEC_BATCH, DEC_SEQ, D_MODEL), 1.0),
        'state_conv': nrm(ks[2], (N_EVEN, DEC_BATCH, CONV_W - 1, W_B), 1.0),
        'state_rglru': nrm(ks[3], (N_EVEN, DEC_BATCH, W_B), 0.5),
        'state_pool': nrm(ks[4], (N_ODD, DEC_BATCH, POOL_HIST, D_MODEL), 1.0),
        'norm_mix': 1.0 + nrm(ks[5], (DEPTH, D_MODEL), 0.05),
        'norm_ffn': 1.0 + nrm(ks[6], (DEPTH, D_MODEL), 0.05),
        'norm_final': 1.0 + nrm(ks[7], (D_MODEL,), 0.05),
        'w_in': nrm(ks[8], (N_EVEN, D_MODEL, D_IN), D_MODEL ** -0.5),
        'w_out': nrm(ks[9], (N_EVEN, W_A + W_B, D_MODEL), (W_A + W_B) ** -0.5),
        'v_norm': 1.0 + nrm(ks[10], (N_EVEN, W_A), 0.05),
        'sgu_w': nrm(ks[11], (N_EVEN, H_A, CHUNK, CHUNK), CHUNK ** -0.5),
        'sgu_b': 1.0 + nrm(ks[12], (N_EVEN, H_A, CHUNK), 0.1),
        'conv_w': nrm(ks[13], (N_EVEN, CONV_W, W_B), CONV_W ** -0.5),
        'conv_b': nrm(ks[14], (N_EVEN, W_B), 0.01),
        'gate_a_w': nrm(ks[16], (N_EVEN, H_B, DH_B, DH_B), DH_B ** -0.5),
        'gate_a_b': nrm(ks[17], (N_EVEN, W_B), 0.01),
        'gate_x_w': nrm(ks[18], (N_EVEN, H_B, DH_B, DH_B), DH_B ** -0.5),
        'gate_x_b': nrm(ks[19], (N_EVEN, W_B), 0.01),
        'lru_lambda': lru_lambda,
        'pool_w': nrm(ks[20], (N_ODD, N_POOL, G_POOL, G_POOL), G_POOL ** -0.5),
        'pool_b': nrm(ks[21], (N_ODD, D_MODEL), 0.01),
        'pool_scale': 1.0 + nrm(ks[22], (N_ODD, D_MODEL), 0.1),
        'ffn_w1': nrm(ks[23], (DEPTH, D_MODEL, D_FF), D_MODEL ** -0.5),
        'ffn_w2': nrm(ks[24], (DEPTH, D_FF, D_MODEL), D_FF ** -0.5),
    }


def reference(x_prompt, x_sample, state_conv, state_rglru, state_pool,
              norm_mix, norm_ffn, norm_final, w_in, w_out, v_norm, sgu_w, sgu_b,
              conv_w, conv_b, gate_a_w, gate_a_b, gate_x_w, gate_x_b, lru_lambda,
              pool_w, pool_b, pool_scale, ffn_w1, ffn_w2):
    xp, xs = x_prompt, x_sample
    n_p = xp.shape[0]
    sgu_v_s, conv_p, conv_s, h_p, h_s, pool_p, pool_s = [], [], [], [], [], [], []
    for layer in range(DEPTH):
        g = norm_mix[layer]
        if layer % 2 == 0:
            e = layer // 2
            prm = (w_in[e], w_out[e], v_norm[e], sgu_w[e], sgu_b[e], conv_w[e], conv_b[e],
                   gate_a_w[e], gate_a_b[e], gate_x_w[e], gate_x_b[e], lru_lambda[e])
            zero_conv = jnp.zeros((n_p, CONV_W - 1, W_B), xp.dtype)
            zero_h = jnp.zeros((n_p, W_B), state_rglru.dtype)
            yp, _, cp, hp = even_mixer(rmsnorm(xp, g), zero_conv, zero_h, *prm)
            ys, vs, cs_, hs_ = even_mixer(rmsnorm(xs, g), state_conv[e], state_rglru[e], *prm)
            sgu_v_s.append(vs)
            conv_p.append(cp)
            conv_s.append(cs_)
            h_p.append(hp)
            h_s.append(hs_)
        else:
            o = layer // 2
            zero_hist = jnp.zeros((n_p, POOL_HIST, D_MODEL), xp.dtype)
            yp, pp = multi_pool(rmsnorm(xp, g), zero_hist, 0, pool_w[o], pool_b[o], pool_scale[o])
            ys, ps = multi_pool(rmsnorm(xs, g), state_pool[o], PAST_LEN, pool_w[o], pool_b[o], pool_scale[o])
            pool_p.append(pp)
            pool_s.append(ps)
        xp = xp + yp
        xs = xs + ys
        xp = xp + channel_mlp(rmsnorm(xp, norm_ffn[layer]), ffn_w1[layer], ffn_w2[layer])
        xs = xs + channel_mlp(rmsnorm(xs, norm_ffn[layer]), ffn_w1[layer], ffn_w2[layer])
    y_prompt = rmsnorm(xp, norm_final)
    y_sample = rmsnorm(xs, norm_final)
    return (y_prompt, y_sample, jnp.stack(sgu_v_s), jnp.stack(conv_p), jnp.stack(conv_s),
            jnp.stack(h_p), jnp.stack(h_s), jnp.stack(pool_p), jnp.stack(pool_s))
```

```cpp
#include <hip/hip_runtime.h>
#include <hip/hip_cooperative_groups.h>
#include <cstdio>
namespace cg = cooperative_groups;

#define LAS __attribute__((address_space(3)))
typedef unsigned short bf16_t;
typedef short bf16x8 __attribute__((ext_vector_type(8)));
typedef float f32x4 __attribute__((ext_vector_type(4)));
typedef float f32x2 __attribute__((ext_vector_type(2)));
typedef unsigned u32x4 __attribute__((ext_vector_type(4)));
typedef unsigned u32x2 __attribute__((ext_vector_type(2)));

constexpr int DM = 1024, NBATCH = 8, SEQ = 2048, MP = NBATCH * SEQ, MS = 128, MR = MP + MS, MPAD = 16640;
constexpr int DFF = 4096, WA = 512, WB = 512, DIN = 2048;
constexpr float EPS = 1e-6f;
constexpr int NTHR = 512;
constexpr int LDS_BYTES = 148 * 1024;

constexpr size_t O_YP = 0, O_YS = O_YP + (size_t)MP * DM, O_SGUV = O_YS + (size_t)MS * DM, O_CONVP = O_SGUV + 2 * MS * WA,
                 O_CONVS = O_CONVP + 2 * NBATCH * 3 * WB, O_HP = O_CONVS + 2 * MS * 3 * WB, O_HS = O_HP + 2 * NBATCH * WB,
                 O_POOLP = O_HS + 2 * MS * WB, O_POOLS = O_POOLP + 2 * NBATCH * 15 * DM, O_END = O_POOLS + (size_t)2 * MS * 15 * DM;

constexpr size_t WS_WIN = 0;
constexpr size_t WS_WOUT = WS_WIN + (size_t)2 * DIN * DM * 2;
constexpr size_t WS_W1 = WS_WOUT + (size_t)2 * DM * DM * 2;
constexpr size_t WS_W2 = WS_W1 + (size_t)4 * DFF * DM * 2;
constexpr size_t WS_WP = WS_W2 + (size_t)4 * DFF * DM * 2;
constexpr size_t WS_GW = WS_WP + (size_t)2 * DM * 256 * 2;
constexpr size_t WS_SW = WS_GW + (size_t)2 * 2 * 8 * 64 * 64 * 2;
constexpr size_t WS_SP = WS_SW + (size_t)2 * 8 * 128 * 128 * 2;
constexpr size_t WS_SSQ = WS_SP + 4096;
constexpr size_t WS_VSSQ = WS_SSQ + (size_t)MPAD * 16 * 4;
constexpr size_t WS_XG = WS_VSSQ + (size_t)MPAD * 8 * 4;
constexpr size_t WS_H = WS_XG + (size_t)MPAD * DM * 2;
constexpr size_t WS_U = WS_H, WS_VP = WS_U + (size_t)MPAD * 512 * 2, WS_GG = WS_VP + (size_t)MPAD * 512 * 2, WS_XB = WS_GG + (size_t)MPAD * 512 * 2,
                 WS_AB = WS_XB + (size_t)MPAD * 512 * 2, WS_PA = WS_H;
constexpr size_t WS_SSQS = WS_H + (size_t)MPAD * DFF * 2;
constexpr size_t WS_VSSQS = WS_SSQS + (size_t)MS * 64 * 4;
constexpr size_t WS_CG = WS_VSSQS + (size_t)MS * 32 * 4;
constexpr size_t WS_BAR = WS_CG + (size_t)2 * 1024 * 128 * 8;
constexpr size_t WS_SPSUM = WS_BAR + 16384;
constexpr size_t WS_SSQ2 = WS_SPSUM + (size_t)2 * MS * DM * 4;
constexpr size_t WS_HALO = WS_SSQ2 + (size_t)MPAD * 16 * 4;
constexpr size_t WS_XS2 = WS_HALO + (size_t)64 * 16 * DM * 2;
constexpr size_t WS_SSQS2 = WS_XS2 + (size_t)MS * DM * 2;
constexpr size_t WS_END = WS_SSQS2 + (size_t)MS * 64 * 4;

struct Params {
    const float *x_prompt, *x_sample, *state_conv, *state_rglru, *state_pool;
    const float *norm_mix, *norm_ffn, *norm_final, *w_in, *w_out, *v_norm, *sgu_w, *sgu_b;
    const float *conv_w, *conv_b, *gate_a_w, *gate_a_b, *gate_x_w, *gate_x_b, *lru_lambda;
    const float *pool_w, *pool_b, *pool_scale, *ffn_w1, *ffn_w2;
    float* out;
    unsigned char* ws;
};

__device__ __forceinline__ int opaque_tid() { int t = threadIdx.x; asm volatile("" : "+v"(t)); return t; }
__device__ __forceinline__ unsigned cvt_pk_bf16(float lo, float hi) { unsigned r; asm volatile("v_cvt_pk_bf16_f32 %0, %1, %2" : "=v"(r) : "v"(lo), "v"(hi)); return r; }
__device__ __forceinline__ float bf2f(unsigned short b) { return __uint_as_float(((unsigned)b) << 16); }
__device__ __forceinline__ float bflo(unsigned w) { return __uint_as_float(w << 16); }
__device__ __forceinline__ float bfhi(unsigned w) { return __uint_as_float(w & 0xffff0000u); }
__device__ __forceinline__ unsigned short f2bf(float f) { return (unsigned short)(cvt_pk_bf16(f, 0.f) & 0xffffu); }
__device__ __forceinline__ void bf8_to_f32(u32x4 w, f32x4& lo, f32x4& hi) {
    lo[0] = bflo(w.x); lo[1] = bfhi(w.x); lo[2] = bflo(w.y); lo[3] = bfhi(w.y);
    hi[0] = bflo(w.z); hi[1] = bfhi(w.z); hi[2] = bflo(w.w); hi[3] = bfhi(w.w);
}
__device__ __forceinline__ void st_wt16(void* base, unsigned off, u32x4 v) { const __amdgpu_buffer_rsrc_t rs = __builtin_amdgcn_make_buffer_rsrc(base, 0, 0x7fffffff, 0x00020000); __builtin_amdgcn_raw_buffer_store_b128(v, rs, off, 0, 16); }
__device__ __forceinline__ void st_wt8(void* base, unsigned off, u32x2 v) { const __amdgpu_buffer_rsrc_t rs = __builtin_amdgcn_make_buffer_rsrc(base, 0, 0x7fffffff, 0x00020000); __builtin_amdgcn_raw_buffer_store_b64(v, rs, off, 0, 16); }
__device__ __forceinline__ float gelu_t(float x) {
    const float z = x * (0.7978845608f + 0.0356774081f * x * x);
    const float e = __builtin_amdgcn_exp2f(z * 2.885390082f);
    return x - x * __builtin_amdgcn_rcpf(e + 1.0f);
}
__device__ __forceinline__ f32x2 gelu_t2(f32x2 x) {
    const f32x2 t = x * x;
    const f32x2 u = t * 0.1029432397f + 2.302208198f;
    const f32x2 a = x * u;
    f32x2 e; e.x = __builtin_amdgcn_exp2f(a.x); e.y = __builtin_amdgcn_exp2f(a.y);
    const f32x2 d = e + 1.0f;
    f32x2 r; r.x = __builtin_amdgcn_rcpf(d.x); r.y = __builtin_amdgcn_rcpf(d.y);
    return x - x * r;
}
__device__ __forceinline__ float sigmoid_f(float x) { return __builtin_amdgcn_rcpf(1.0f + __builtin_amdgcn_exp2f(-1.442695041f * x)); }
__device__ __forceinline__ float row_rs16(const float* ssq, int row) {
    const f32x4* q = (const f32x4*)(ssq + (size_t)row * 16);
    const f32x4 a = q[0], b = q[1], c = q[2], d = q[3];
    const float s = (a[0] + a[1] + a[2] + a[3]) + (b[0] + b[1] + b[2] + b[3]) + (c[0] + c[1] + c[2] + c[3]) + (d[0] + d[1] + d[2] + d[3]);
    return __builtin_amdgcn_rsqf(s * (1.0f / 1024.0f) + EPS);
}
__device__ __forceinline__ float row_rs8(const float* vssq, int row) {
    const f32x4* q = (const f32x4*)(vssq + (size_t)row * 8);
    const f32x4 a = q[0], b = q[1];
    const float s = (a[0] + a[1] + a[2] + a[3]) + (b[0] + b[1] + b[2] + b[3]);
    return __builtin_amdgcn_rsqf(s * (1.0f / 512.0f) + EPS);
}


__device__ __forceinline__ float rs_sample_q(const float* ssqs, int r, int fq) {
    const f32x4* q = (const f32x4*)(ssqs + (size_t)r * 64 + fq * 16);
    const f32x4 a = q[0], b = q[1], c = q[2], d = q[3];
    float s = (a[0] + a[1] + a[2] + a[3]) + (b[0] + b[1] + b[2] + b[3]) + (c[0] + c[1] + c[2] + c[3]) + (d[0] + d[1] + d[2] + d[3]);
    s += __shfl_xor(s, 16); s += __shfl_xor(s, 32);
    return __builtin_amdgcn_rsqf(s * (1.0f / 1024.0f) + EPS);
}
__device__ __forceinline__ float rs_sample_full(const float* ssqs, int r) {
    float s = 0.f;
#pragma unroll
    for (int i = 0; i < 16; ++i) { const f32x4 a = *(const f32x4*)(ssqs + (size_t)r * 64 + i * 4); s += (a[0] + a[1]) + (a[2] + a[3]); }
    return __builtin_amdgcn_rsqf(s * (1.0f / 1024.0f) + EPS);
}
__device__ __forceinline__ float rsv_sample_full(const float* vssqs, int r) {
    float s = 0.f;
#pragma unroll
    for (int i = 0; i < 8; ++i) { const f32x4 a = *(const f32x4*)(vssqs + (size_t)r * 32 + i * 4); s += (a[0] + a[1]) + (a[2] + a[3]); }
    return __builtin_amdgcn_rsqf(s * (1.0f / 512.0f) + EPS);
}

#define XB_TMO      128
#define XB_XCNT(j)  (256  + 64 * (j))
#define XB_XSUB(j)  (1280 + 64 * (j))
#define XB_XGEN(j)  (2304 + 64 * (j))
#define XB_TOP      3328
#define XB_TOPGEN   3392
#define XCD_BAR_WORDS 3456
#define XB_SPIN_CAP (1u << 22)
__device__ __forceinline__ unsigned xb_ld(unsigned* p)              { return __hip_atomic_load(p, __ATOMIC_RELAXED, __HIP_MEMORY_SCOPE_AGENT); }
__device__ __forceinline__ unsigned xb_add(unsigned* p, unsigned v) { return __hip_atomic_fetch_add(p, v, __ATOMIC_RELAXED, __HIP_MEMORY_SCOPE_AGENT); }
__device__ __forceinline__ unsigned xb_xcc_id() { return (unsigned)__builtin_amdgcn_s_getreg((3 << 11) | 20) & 0xFu; }
#define XB_SPIN(cond, bar) do { unsigned _sp = 0; while (cond) { __builtin_amdgcn_s_sleep(1); \
    if ((++_sp & 255u) == 0u) { if (xb_ld(&(bar)[XB_TMO])) break; if (_sp > XB_SPIN_CAP) { atomicAdd(&(bar)[XB_TMO], 1u); break; } } } } while (0)
struct XcdBarrier { unsigned* bar; unsigned x; volatile LAS unsigned* st; };
__device__ __forceinline__ XcdBarrier xcd_barrier_post(unsigned* bar, volatile LAS unsigned* st) {
    XcdBarrier b; b.bar = bar; b.x = xb_xcc_id(); b.st = st;
    if (threadIdx.x == 0) (void)xb_add(&bar[XB_XCNT(b.x)], 1u);
    return b;
}
__device__ __forceinline__ void xcd_barrier_complete(unsigned* bar, unsigned x, unsigned& nloc, unsigned& nx) {
    const unsigned G = gridDim.x * gridDim.y * gridDim.z;
    unsigned sum, cnt, mine, sp = 0u;
    for (;;) {
        sum = 0u; cnt = 0u; mine = 0u;
#pragma unroll
        for (unsigned j = 0; j < 16; ++j) { const unsigned c = xb_ld(&bar[XB_XCNT(j)]); sum += c; cnt += (c > 0u) ? 1u : 0u; mine = (j == x) ? c : mine; }
        if (sum == G) break;
        __builtin_amdgcn_s_sleep(1);
        if ((++sp & 255u) == 0u) { if (xb_ld(&bar[XB_TMO])) break; if (sp > XB_SPIN_CAP) { atomicAdd(&bar[XB_TMO], 1u); break; } }
    }
    nloc = mine > 0u ? mine : 1u; nx = cnt > 0u ? cnt : 1u;
}
__device__ __forceinline__ void xcd_barrier_arrive(const XcdBarrier& b) {
    asm volatile("s_waitcnt vmcnt(0)" ::: "memory");
    __syncthreads();
    if (threadIdx.x == 0) {
        unsigned* bar = b.bar;
        __builtin_amdgcn_s_waitcnt(0);
        unsigned nloc = b.st[0], nx = b.st[1];
        if (nloc == 0u) { xcd_barrier_complete(bar, b.x, nloc, nx); b.st[0] = nloc; b.st[1] = nx; }
        const unsigned old = xb_add(&bar[XB_XSUB(b.x)], 1u);
        const unsigned gen = old / nloc;
        unsigned leader = 0u, tg = 0u, lastx = 0u;
        if (old + 1u == (gen + 1u) * nloc) {
            leader = 1u;
            __builtin_amdgcn_fence(__ATOMIC_RELEASE, "agent");
            asm volatile("s_waitcnt vmcnt(0)" ::: "memory");
            const unsigned og = xb_add(&bar[XB_TOP], 1u);
            tg = og / nx;
            if (og + 1u == (tg + 1u) * nx) { xb_add(&bar[XB_TOPGEN], 1u); lastx = 1u; }
        }
        b.st[2] = gen * 2u + leader; b.st[3] = tg * 2u + lastx;
    }
}
__device__ __forceinline__ void xcd_barrier_wait(const XcdBarrier& b) {
    if (threadIdx.x == 0) {
        unsigned* bar = b.bar;
        const unsigned s2 = b.st[2], s3 = b.st[3];
        const unsigned gen = s2 >> 1, leader = s2 & 1u, tg = s3 >> 1, lastx = s3 & 1u;
        if (leader) {
            if (!lastx) XB_SPIN(xb_ld(&bar[XB_TOPGEN]) == tg, bar);
            __builtin_amdgcn_fence(__ATOMIC_ACQUIRE, "agent");
            xb_add(&bar[XB_XGEN(b.x)], 1u);
            asm volatile("s_waitcnt vmcnt(0)" ::: "memory");
        } else {
            XB_SPIN(xb_ld(&bar[XB_XGEN(b.x)]) == gen, bar);
            __builtin_amdgcn_fence(__ATOMIC_ACQUIRE, "agent");
            asm volatile("s_waitcnt vmcnt(0)" ::: "memory");
        }
    }
    __syncthreads();
}

namespace pg8 {
constexpr int BM = 256, BK = 64, HALF = 128, HTB = HALF * BK * 2, STAGE_BYTES = 8 * HTB, NXCD = 8, WGM = 8;
__host__ __device__ __forceinline__ int lds_byte(int r, int c) { const int st = (r >> 4) * 2 + (c >> 5), rr = r & 15, cc = c & 31, ob = rr * 64 + cc * 2; return st * 1024 + (ob ^ (((ob >> 9) & 1) << 5)); }
__host__ __device__ __forceinline__ int perm32(int rho) { const int n = rho >> 4, i = rho & 15; return 8 * (i >> 2) + 4 * n + (i & 3); }
__host__ __device__ __forceinline__ void stage_rc(int b, int& R, int& C) { const int st = b / 1024, sb = b % 1024, swz = sb ^ (((sb >> 9) & 1) << 5); R = (st >> 1) * 16 + swz / 64; C = (st & 1) * 32 + (swz % 64) / 2; }

struct Unit { int pm, pn; };
struct Gemm { const bf16_t* A; const bf16_t* Bt; int M, N, K, lda, ldb, a_pn_koff; };

struct StaticOrder {
    int nM, nN, nwg, G, c;
    __device__ void init(int M, int N, int G_, int c_) { nM = M / BM; nN = N / BM; nwg = nM * nN; G = G_; c = c_; }
    __device__ bool next(int i, Unit& u) const {
        const long L = (long)i * G + c; if (L >= nwg) return false;
        int wgid = (int)L; { const int q = nwg / NXCD, r = nwg % NXCD, xcd = wgid % NXCD, off = wgid / NXCD; wgid = (xcd < r ? xcd * (q + 1) : r * (q + 1) + (xcd - r) * q) + off; }
        const int nig = WGM * nN, gid = wgid / nig, fm = gid * WGM, gsz = (nM - fm) < WGM ? (nM - fm) : WGM;
        u.pm = fm + ((wgid % nig) % gsz); u.pn = (wgid % nig) / gsz; return true;
    }
};

constexpr int RS_TAB_OFF = 131072, WT_OFF = 132096, WT_BYTES = 16 * 144;
constexpr int RS_TAB_OFF_UNUSED = 0;
__device__ __forceinline__ f32x4 zero4_b64() {
    f32x2 a, b; asm volatile("v_mov_b64 %0, 0" : "=v"(a)); asm volatile("v_mov_b64 %0, 0" : "=v"(b));
    return (f32x4){a.x, a.y, b.x, b.y};
}
template <class Epi>
__device__ __forceinline__ void gemm_phase(LAS unsigned char* lds, const Gemm g, const StaticOrder& S, const Epi& E) {
    const int tid = opaque_tid(), wid = __builtin_amdgcn_readfirstlane(tid >> 6), lane = tid & 63, wr = wid >> 2, wc = wid & 3, fr = lane & 15, fq = lane >> 4;
    const int K = g.K, nt = K / BK;
    unsigned voffA[2], voffB[2];
#pragma unroll
    for (int i = 0; i < 2; ++i) { int R, C; stage_rc(tid * 16 + i * 8192, R, C);
        const int Rb = 64 * (R >> 5) + 16 * ((R >> 2) & 3) + 4 * ((R >> 4) & 1) + (R & 3);
        voffA[i] = (unsigned)(R * g.lda + C) * 2u; voffB[i] = (unsigned)(Rb * g.ldb + C) * 2u; }
    const size_t kstep = (size_t)(BK * 2);
    const size_t hstepA = (size_t)HALF * g.lda * 2, hstepB = (size_t)8 * g.ldb * 2;
    const size_t tstepA = 2 * hstepA, tstepB = (size_t)BM * g.ldb * 2;
    const size_t pnoffA = (size_t)g.a_pn_koff * 2;
    const unsigned ldsw = (unsigned)wid * 1024u;
    const int aoff = lds_byte(wr * 64 + fr, fq * 8), boff = lds_byte(wc * 32 + fr, fq * 8);
#define PG8_SA(b, h) (((b) * 2 + (h)) * HTB)
#define PG8_SB(b, h) ((4 + (b) * 2 + (h)) * HTB)
#define PG8_STAGE(bufoff, gbase, voff) do { _Pragma("unroll") for (int _i = 0; _i < 2; ++_i) \
        __builtin_amdgcn_global_load_lds((const unsigned*)((const char*)(gbase) + (voff)[_i]), (LAS unsigned*)(lds + (bufoff) + ldsw + _i * 8192), 16, 0, 0); } while (0)
#define PG8_LDA(dst, b, h) do { _Pragma("unroll") for (int m = 0; m < 4; ++m) _Pragma("unroll") for (int k = 0; k < 2; ++k) dst[m][k] = *(const LAS bf16x8*)(lds + PG8_SA(b, h) + aoff + m * 2048 + k * 1024); } while (0)
#define PG8_LDB(dst, b, h) do { _Pragma("unroll") for (int n = 0; n < 2; ++n) _Pragma("unroll") for (int k = 0; k < 2; ++k) dst[n][k] = *(const LAS bf16x8*)(lds + PG8_SB(b, h) + boff + n * 2048 + k * 1024); } while (0)
#define PG8_MMA(ai, bj, At, Bt) do { __builtin_amdgcn_s_setprio(1); _Pragma("unroll") for (int m = 0; m < 4; ++m) _Pragma("unroll") for (int n = 0; n < 2; ++n) _Pragma("unroll") for (int k = 0; k < 2; ++k) \
        acc[ai][bj][m][n] = __builtin_amdgcn_mfma_f32_16x16x32_bf16(Bt[n][k], At[m][k], acc[ai][bj][m][n], 0, 0, 0); __builtin_amdgcn_s_setprio(0); } while (0)
#define PG8_WAIT_V(n) asm volatile("s_waitcnt vmcnt(" #n ")" ::: "memory")
#define PG8_WAIT_L(n) asm volatile("s_waitcnt lgkmcnt(" #n ")" ::: "memory")
#define PG8_BAR __builtin_amdgcn_s_barrier()
#define PG8_SCHED __builtin_amdgcn_sched_barrier(0)
    Unit cur, nxt; int ui = 0;
    if (!S.next(0, cur)) return;
    f32x4 acc[2][2][4][2];
#pragma unroll
    for (int a = 0; a < 2; ++a)
#pragma unroll
        for (int b = 0; b < 2; ++b)
#pragma unroll
            for (int m = 0; m < 4; ++m)
#pragma unroll
                for (int n = 0; n < 2; ++n) acc[a][b][m][n] = zero4_b64();
    bf16x8 At[4][2], B0[2][2], B1[2][2];
    const char* cA = (const char*)g.A + (size_t)cur.pm * tstepA + (size_t)cur.pn * pnoffA; const char* cB = (const char*)g.Bt + (size_t)cur.pn * tstepB;
    PG8_STAGE(PG8_SB(0, 0), cB, voffB); PG8_STAGE(PG8_SA(0, 0), cA, voffA); PG8_STAGE(PG8_SB(0, 1), cB + hstepB, voffB); PG8_STAGE(PG8_SA(0, 1), cA + hstepA, voffA);
    if (wr == 1) PG8_BAR;
    PG8_WAIT_V(4); PG8_BAR;
    PG8_STAGE(PG8_SB(1, 0), cB + kstep, voffB); PG8_STAGE(PG8_SA(1, 0), cA + kstep, voffA); PG8_STAGE(PG8_SB(1, 1), cB + hstepB + kstep, voffB);
    PG8_WAIT_V(6); PG8_BAR;
    for (;;) {
        const bool has_next = S.next(ui + 1, nxt);
        const char* nA = has_next ? (const char*)g.A + (size_t)nxt.pm * tstepA + (size_t)nxt.pn * pnoffA : cA; const char* nB = has_next ? (const char*)g.Bt + (size_t)nxt.pn * tstepB : cB;
        for (int t = 0; t < nt; t += 2) {
            const bool last = (t == nt - 2);
            const char* a1 = cA + (size_t)(t + 1) * kstep;
            const char* a2 = last ? nA : cA + (size_t)(t + 2) * kstep; const char* b2 = last ? nB : cB + (size_t)(t + 2) * kstep;
            const char* a3 = a2 + kstep; const char* b3 = b2 + kstep;
            PG8_LDB(B0, 0, 0); PG8_SCHED; PG8_LDA(At, 0, 0); PG8_STAGE(PG8_SA(1, 1), a1 + hstepA, voffA);
            PG8_WAIT_L(8); PG8_BAR; PG8_WAIT_L(0); PG8_MMA(0, 0, At, B0); PG8_BAR; PG8_SCHED;
            PG8_LDB(B1, 0, 1); PG8_STAGE(PG8_SB(0, 0), b2, voffB);
            PG8_BAR; PG8_WAIT_L(0); PG8_MMA(0, 1, At, B1); PG8_BAR;
            PG8_LDA(At, 0, 1); PG8_STAGE(PG8_SA(0, 0), a2, voffA);
            PG8_BAR; PG8_WAIT_L(0); PG8_MMA(1, 0, At, B0); PG8_BAR; PG8_SCHED;
            PG8_STAGE(PG8_SB(0, 1), b2 + hstepB, voffB);
            PG8_WAIT_V(6); PG8_BAR; PG8_MMA(1, 1, At, B1); PG8_BAR;
            PG8_LDB(B0, 1, 0); PG8_SCHED; PG8_LDA(At, 1, 0); PG8_STAGE(PG8_SA(0, 1), a2 + hstepA, voffA);
            PG8_WAIT_L(8); PG8_BAR; PG8_WAIT_L(0); PG8_MMA(0, 0, At, B0); PG8_BAR; PG8_SCHED;
            PG8_LDB(B1, 1, 1); PG8_STAGE(PG8_SB(1, 0), b3, voffB);
            PG8_BAR; PG8_WAIT_L(0); PG8_MMA(0, 1, At, B1); PG8_BAR;
            PG8_LDA(At, 1, 1); PG8_STAGE(PG8_SA(1, 0), a3, voffA);
            PG8_BAR; PG8_WAIT_L(0); PG8_MMA(1, 0, At, B0); PG8_BAR; PG8_SCHED;
            PG8_STAGE(PG8_SB(1, 1), b3 + hstepB, voffB);
            PG8_WAIT_V(6); PG8_BAR; PG8_MMA(1, 1, At, B1); PG8_BAR;
        }
        E(acc, cur, wr, wc, fr, fq);
        if (!has_next) break;
#pragma unroll
        for (int a = 0; a < 2; ++a)
#pragma unroll
            for (int b = 0; b < 2; ++b)
#pragma unroll
                for (int m = 0; m < 4; ++m)
#pragma unroll
                    for (int n = 0; n < 2; ++n) acc[a][b][m][n] = zero4_b64();
        cur = nxt; cA = nA; cB = nB; ++ui;
    }
    PG8_WAIT_V(0);
    if (wr == 0) PG8_BAR;
    PG8_BAR;
#undef PG8_SA
#undef PG8_SB
#undef PG8_STAGE
#undef PG8_LDA
#undef PG8_LDB
#undef PG8_MMA
#undef PG8_WAIT_V
#undef PG8_WAIT_L
#undef PG8_BAR
#undef PG8_SCHED
}
}

__device__ __forceinline__ void store_bf4(bf16_t* p, f32x4 v) { u32x2 w; w.x = cvt_pk_bf16(v[0], v[1]); w.y = cvt_pk_bf16(v[2], v[3]); *(u32x2*)p = w; }
__device__ __forceinline__ u32x4 pack_bf8(f32x4 a, f32x4 b) { u32x4 w; w.x = cvt_pk_bf16(a[0], a[1]); w.y = cvt_pk_bf16(a[2], a[3]); w.z = cvt_pk_bf16(b[0], b[1]); w.w = cvt_pk_bf16(b[2], b[3]); return w; }
__device__ __forceinline__ void wave_store_lines(LAS unsigned char* wbuf, bf16_t* g0, size_t ld, u32x4 w0, u32x4 w1, int lane) {
    const int fr = lane & 15, fq = lane >> 4;
    *(LAS u32x4*)(wbuf + fr * 144 + fq * 32) = w0; *(LAS u32x4*)(wbuf + fr * 144 + fq * 32 + 16) = w1;
    asm volatile("s_waitcnt lgkmcnt(0)" ::: "memory");
#pragma unroll
    for (int i = 0; i < 2; ++i) { const int row = 8 * i + (lane >> 3); const u32x4 t = *(const LAS u32x4*)(wbuf + row * 144 + (lane & 7) * 16); *(u32x4*)(g0 + (size_t)row * ld + (lane & 7) * 8) = t; }
    asm volatile("" ::: "memory");
}
__device__ __forceinline__ void wave_load_lines(LAS unsigned char* wbuf, const bf16_t* g0, size_t ld, u32x4& w0, u32x4& w1, int lane) {
    const int fr = lane & 15, fq = lane >> 4;
    u32x4 t[2];
#pragma unroll
    for (int i = 0; i < 2; ++i) t[i] = *(const u32x4*)(g0 + (size_t)(8 * i + (lane >> 3)) * ld + (lane & 7) * 8);
#pragma unroll
    for (int i = 0; i < 2; ++i) *(LAS u32x4*)(wbuf + (8 * i + (lane >> 3)) * 144 + (lane & 7) * 16) = t[i];
    asm volatile("s_waitcnt lgkmcnt(0)" ::: "memory");
    w0 = *(const LAS u32x4*)(wbuf + fr * 144 + fq * 32); w1 = *(const LAS u32x4*)(wbuf + fr * 144 + fq * 32 + 16);
    asm volatile("s_waitcnt lgkmcnt(0)" ::: "memory");
}
__device__ __forceinline__ void wave_store_lines_u(LAS unsigned char* wl, LAS unsigned char* rl, char* gbase, unsigned off0, unsigned off1, u32x4 w0, u32x4 w1) {
    *(LAS u32x4*)(wl) = w0; *(LAS u32x4*)(wl + 16) = w1;
    asm volatile("" ::: "memory");
    const u32x4 t0 = *(const LAS u32x4*)(rl), t1 = *(const LAS u32x4*)(rl + 8 * 144);
    asm volatile("" ::: "memory");
    {
        const __amdgpu_buffer_rsrc_t rs = __builtin_amdgcn_make_buffer_rsrc((void*)gbase, 0, 0x7fffffff, 0x00020000);
        __builtin_amdgcn_raw_buffer_store_b128(t0, rs, off0, 0, 16);
        __builtin_amdgcn_raw_buffer_store_b128(t1, rs, off1, 0, 16);
    }
}
__device__ __forceinline__ float unit_rs(LAS unsigned char* lds, const float* ssq, int pm0, int pm, int lr) {
    return *(const LAS float*)(lds + pg8::RS_TAB_OFF + lr * 4);
}
__device__ __forceinline__ void fill_rs_table(LAS unsigned char* lds, const float* ssq, int pm0) {
    const int t = opaque_tid();
    if (t < 256) *(LAS float*)(lds + pg8::RS_TAB_OFF + t * 4) = row_rs16(ssq, pm0 * 256 + t);
    __syncthreads();
}

struct EpiE1 {
    const float* ssq; bf16_t* U; float* vssq; LAS unsigned char* lds; int pm0;
    __device__ __forceinline__ void operator()(const f32x4 (&acc)[2][2][4][2], const pg8::Unit& u, int wr, int wc, int fr_, int fq_) const {
        int lane_o = fq_ * 16 + fr_; asm volatile("" : "+v"(lane_o));
        const int fr = lane_o & 15, fq = lane_o >> 4;
        const int sec = u.pn >> 1, lane = lane_o;
        bf16_t* dst = U + (size_t)sec * ((size_t)MPAD * 512) + (u.pn & 1) * 256 + wc * 64;
        LAS unsigned char* wbuf = lds + pg8::WT_OFF + (wr * 4 + wc) * pg8::WT_BYTES;
        LAS unsigned char* wl = wbuf + fr * 144 + fq * 32; LAS unsigned char* rl = wbuf + (lane >> 3) * 144 + (lane & 7) * 16;
        const unsigned off0 = (unsigned)(lane >> 3) * (512 * 2) + (lane & 7) * 16, off1 = off0 + 8u * (512 * 2);
#pragma unroll
        for (int ai = 0; ai < 2; ++ai) {
#pragma unroll
            for (int m = 0; m < 4; ++m) {
                const int lr = ai * 128 + wr * 64 + m * 16 + fr, row = u.pm * 256 + lr;
                const float rs = unit_rs(lds, ssq, pm0, u.pm, lr);
                float sq = 0.f;
                u32x4 w[2];
#pragma unroll
                for (int bj = 0; bj < 2; ++bj) {
                    f32x4 v0 = acc[ai][bj][m][0] * rs, v1 = acc[ai][bj][m][1] * rs;
                    if (sec != 3) {
                        const f32x2 g0 = gelu_t2((f32x2){v0[0], v0[1]}), g1 = gelu_t2((f32x2){v0[2], v0[3]}), g2 = gelu_t2((f32x2){v1[0], v1[1]}), g3 = gelu_t2((f32x2){v1[2], v1[3]});
                        v0 = (f32x4){g0.x, g0.y, g1.x, g1.y}; v1 = (f32x4){g2.x, g2.y, g3.x, g3.y};
                    }
                    sq += v0[0] * v0[0] + v0[1] * v0[1] + v0[2] * v0[2] + v0[3] * v0[3] + v1[0] * v1[0] + v1[1] * v1[1] + v1[2] * v1[2] + v1[3] * v1[3];
                    w[bj] = pack_bf8(v0, v1);
                }
                wave_store_lines_u(wl, rl, (char*)(dst + (size_t)(u.pm * 256 + ai * 128 + wr * 64 + m * 16) * 512), off0, off1, w[0], w[1]);
                if (sec == 1) {
                    sq += __shfl_xor(sq, 16); sq += __shfl_xor(sq, 32);
                    if (fq == 0) vssq[(size_t)row * 8 + (u.pn & 1) * 4 + wc] = sq;
                }
            }
        }
    }
};

struct EpiF1 {
    const float* ssq; bf16_t* H; LAS unsigned char* lds; int pm0;
    __device__ __forceinline__ void operator()(const f32x4 (&acc)[2][2][4][2], const pg8::Unit& u, int wr, int wc, int fr_, int fq_) const {
        int lane_o = fq_ * 16 + fr_; asm volatile("" : "+v"(lane_o));
        const int fr = lane_o & 15, fq = lane_o >> 4;
        const int lane = lane_o;
        bf16_t* dst = H + u.pn * 256 + wc * 64;
        LAS unsigned char* wbuf = lds + pg8::WT_OFF + (wr * 4 + wc) * pg8::WT_BYTES;
        LAS unsigned char* wl = wbuf + fr * 144 + fq * 32; LAS unsigned char* rl = wbuf + (lane >> 3) * 144 + (lane & 7) * 16;
        const unsigned off0 = (unsigned)(lane >> 3) * (DFF * 2) + (lane & 7) * 16, off1 = off0 + 8u * (DFF * 2);
#pragma unroll
        for (int ai = 0; ai < 2; ++ai) {
#pragma unroll
            for (int m = 0; m < 4; ++m) {
                const int lr = ai * 128 + wr * 64 + m * 16 + fr;
                const float rs = unit_rs(lds, ssq, pm0, u.pm, lr);
                u32x4 w[2];
#pragma unroll
                for (int bj = 0; bj < 2; ++bj) {
                    f32x4 v0 = acc[ai][bj][m][0] * rs, v1 = acc[ai][bj][m][1] * rs;
#pragma unroll
                    for (int j = 0; j < 4; ++j) { v0[j] = fmaxf(v0[j], 0.f); v1[j] = fmaxf(v1[j], 0.f); }
                    v0 = v0 * v0; v1 = v1 * v1;
                    w[bj] = pack_bf8(v0, v1);
                }
                wave_store_lines_u(wl, rl, (char*)(dst + (size_t)(u.pm * 256 + ai * 128 + wr * 64 + m * 16) * DFF), off0, off1, w[0], w[1]);
            }
        }
    }
};

struct EpiRes {
    bf16_t* X; float* ssq; const float* bias; const float* cscale; LAS unsigned char* lds; bf16_t* halo;
    __device__ __forceinline__ void operator()(const f32x4 (&acc)[2][2][4][2], const pg8::Unit& u, int wr, int wc, int fr_, int fq_) const {
        int lane_o = fq_ * 16 + fr_; asm volatile("" : "+v"(lane_o));
        const int fr = lane_o & 15, fq = lane_o >> 4;
        const int lane = lane_o;
        const int colw = u.pn * 256 + wc * 64;
        LAS unsigned char* wbuf = lds + pg8::WT_OFF + (wr * 4 + wc) * pg8::WT_BYTES;
        LAS unsigned char* wl = wbuf + fr * 144 + fq * 32; LAS unsigned char* rl = wbuf + (lane >> 3) * 144 + (lane & 7) * 16;
        const unsigned off0 = (unsigned)(lane >> 3) * (DM * 2) + (lane & 7) * 16, off1 = off0 + 8u * (DM * 2);
        f32x4 bv[2][2], cv[2][2];
#pragma unroll
        for (int bj = 0; bj < 2; ++bj)
#pragma unroll
            for (int hh = 0; hh < 2; ++hh) {
                const int col = colw + 16 * fq + 8 * bj + 4 * hh;
                bv[bj][hh] = bias ? *(const f32x4*)(bias + col) : (f32x4){0.f, 0.f, 0.f, 0.f};
                cv[bj][hh] = bias ? *(const f32x4*)(cscale + col) : (f32x4){1.f, 1.f, 1.f, 1.f};
            }
#pragma unroll
        for (int ai = 0; ai < 2; ++ai) {
            u32x4 t[4][2];
#pragma unroll
            for (int m = 0; m < 4; ++m) {
                const char* xg0 = (const char*)(X + (size_t)(u.pm * 256 + ai * 128 + wr * 64 + m * 16) * DM + colw);
                t[m][0] = *(const u32x4*)(xg0 + off0); t[m][1] = *(const u32x4*)(xg0 + off1);
            }
#pragma unroll
            for (int m = 0; m < 4; ++m) {
                const int row = u.pm * 256 + ai * 128 + wr * 64 + m * 16 + fr;
                char* xg0 = (char*)(X + (size_t)(u.pm * 256 + ai * 128 + wr * 64 + m * 16) * DM + colw);
                u32x4 xw[2];
                *(LAS u32x4*)(rl) = t[m][0]; *(LAS u32x4*)(rl + 8 * 144) = t[m][1];
                asm volatile("" ::: "memory");
                xw[0] = *(const LAS u32x4*)(wl); xw[1] = *(const LAS u32x4*)(wl + 16);
                asm volatile("" ::: "memory");
                float sq = 0.f;
                u32x4 w[2];
#pragma unroll
                for (int bj = 0; bj < 2; ++bj) {
                    const int col = colw + 16 * fq + 8 * bj;
                    f32x4 v0 = acc[ai][bj][m][0], v1 = acc[ai][bj][m][1];
                    if (bias) { v0 = (v0 + bv[bj][0]) * cv[bj][0]; v1 = (v1 + bv[bj][1]) * cv[bj][1]; }
                    f32x4 x0, x1; bf8_to_f32(xw[bj], x0, x1);
                    v0 = v0 + x0; v1 = v1 + x1;
                    sq += v0[0] * v0[0] + v0[1] * v0[1] + v0[2] * v0[2] + v0[3] * v0[3] + v1[0] * v1[0] + v1[1] * v1[1] + v1[2] * v1[2] + v1[3] * v1[3];
                    w[bj] = pack_bf8(v0, v1);
                }
                wave_store_lines_u(wl, rl, xg0, off0, off1, w[0], w[1]);
                if (halo && ai == 1 && m == 3 && wr == 1) wave_store_lines_u(wl, rl, (char*)(halo + (size_t)(u.pm * 16) * DM + colw), off0, off1, w[0], w[1]);
                sq += __shfl_xor(sq, 16); sq += __shfl_xor(sq, 32);
                if (fq == 0) ssq[(size_t)row * 16 + u.pn * 4 + wc] = sq;
            }
        }
    }
};

template <int KSPLIT, int STEPS, class Epi>
__device__ __forceinline__ void skinny_gemm(LAS unsigned char* lds, const bf16_t* A, int lda, int a_grp_koff, const bf16_t* Bt, int ldb, int N, int K, const Epi& E, int G) {
    const int tid = opaque_tid(), wave = tid >> 6, lane = tid & 63, fr = lane & 15, fq = lane >> 4;
    const int ntile = 8 * (N >> 4);
    constexpr int TPB = 8 / KSPLIT;
    const int klen = K / KSPLIT;
    for (int t0 = blockIdx.x * TPB; t0 < ntile; t0 += G * TPB) {
        const int tile = t0 + wave / KSPLIT, ks = wave % KSPLIT;
        const int rt = tile & 7, ct = tile >> 3;
        const bf16_t* ap = A + (size_t)(rt * 16 + fr) * lda + (ct >> 4) * a_grp_koff + ks * klen + fq * 8;
        const bf16_t* bp = Bt + (size_t)(ct * 16 + fr) * ldb + ks * klen + fq * 8;
        f32x2 pp = (f32x2){0.f, 0.f};
        if (ks == 0) pp = E.pre(rt * 16 + fr, ct * 16 + fq * 4, fq);
        f32x4 acc = (f32x4){0.f, 0.f, 0.f, 0.f};
        const int krot = (int)(((unsigned)(wave * 5 + (int)blockIdx.x * 3) * 32u) % (unsigned)klen);
        for (int k = 0; k < klen; k += STEPS * 32) {
            bf16x8 a[STEPS], b[STEPS];
#pragma unroll
            for (int j = 0; j < STEPS; ++j) { int kk = k + j * 32 + krot; kk = kk >= klen ? kk - klen : kk; a[j] = *(const bf16x8*)(ap + kk); b[j] = *(const bf16x8*)(bp + kk); }
#pragma unroll
            for (int j = 0; j < STEPS; ++j) acc = __builtin_amdgcn_mfma_f32_16x16x32_bf16(b[j], a[j], acc, 0, 0, 0);
        }
        if (KSPLIT > 1) {
            *(LAS f32x4*)(lds + (wave * 64 + lane) * 16) = acc;
            __syncthreads();
            if (ks == 0) {
#pragma unroll
                for (int j = 1; j < KSPLIT; ++j) acc = acc + *(const LAS f32x4*)(lds + ((wave + j) * 64 + lane) * 16);
                E(rt * 16 + fr, ct * 16 + fq * 4, ct, fq, acc, pp);
            }
            __syncthreads();
        } else {
            E(rt * 16 + fr, ct * 16 + fq * 4, ct, fq, acc, pp);
        }
    }
}

template <class Epi>
__device__ __forceinline__ void skinny_gemm_k1024(LAS unsigned char* lds, const bf16_t* A, int lda, const bf16_t* Bt, int ldb, int N, const Epi& E, int G) {
    const int tid = opaque_tid(), wave = tid >> 6, lane = tid & 63, fr = lane & 15, fq = lane >> 4;
    const int nct = N >> 4;
    for (int ct = blockIdx.x; ct < nct; ct += G) {
        const bf16_t* ap = A + (size_t)(wave * 16 + fr) * lda + fq * 8;
        const bf16_t* bp = Bt + (size_t)(ct * 16 + fr) * ldb + (4 * wave) * 32 + fq * 8;
        const f32x2 pp = E.pre(wave * 16 + fr, ct * 16 + fq * 4, fq);
        bf16x8 a[32], bl[4];
#pragma unroll
        for (int q = 0; q < 4; ++q) bl[q] = *(const bf16x8*)(bp + q * 32);
#pragma unroll
        for (int j = 0; j < 32; ++j) a[j] = *(const bf16x8*)(ap + j * 32);
#pragma unroll
        for (int q = 0; q < 4; ++q) *(LAS bf16x8*)(lds + ((4 * wave + q) * 64 + lane) * 16) = bl[q];
        __syncthreads();
        f32x4 acc0 = (f32x4){0.f, 0.f, 0.f, 0.f}, acc1 = acc0;
#pragma unroll
        for (int j = 0; j < 32; j += 2) {
            const bf16x8 b0 = *(const LAS bf16x8*)(lds + (j * 64 + lane) * 16), b1 = *(const LAS bf16x8*)(lds + ((j + 1) * 64 + lane) * 16);
            acc0 = __builtin_amdgcn_mfma_f32_16x16x32_bf16(b0, a[j], acc0, 0, 0, 0);
            acc1 = __builtin_amdgcn_mfma_f32_16x16x32_bf16(b1, a[j + 1], acc1, 0, 0, 0);
        }
        E(wave * 16 + fr, ct * 16 + fq * 4, ct, fq, acc0 + acc1, pp);
        __syncthreads();
    }
}

template <class Epi>
__device__ __forceinline__ void skinny_gemm_k4096(LAS unsigned char* lds, const bf16_t* A, int lda, const bf16_t* Bt, int ldb, int N, const Epi& E, int G) {
    const int tid = opaque_tid(), wave = tid >> 6, lane = tid & 63, fr = lane & 15, fq = lane >> 4;
    const int npair = 4 * (N >> 4);
    for (int pr = blockIdx.x; pr < npair; pr += G) {
        const int ct = pr >> 2, rt0 = (pr & 3) * 2;
        const bf16_t* ap0 = A + (size_t)(rt0 * 16 + fr) * lda + wave * 512 + fq * 8;
        const bf16_t* ap1 = ap0 + (size_t)16 * lda;
        const bf16_t* bp = Bt + (size_t)(ct * 16 + fr) * ldb + wave * 512 + fq * 8;
        f32x2 pp = (f32x2){0.f, 0.f};
        if (wave < 2) pp = E.pre((rt0 + wave) * 16 + fr, ct * 16 + fq * 4, fq);
        bf16x8 b[16], a0[16], a1[16];
#pragma unroll
        for (int j = 0; j < 16; ++j) { b[j] = *(const bf16x8*)(bp + j * 32); a0[j] = *(const bf16x8*)(ap0 + j * 32); a1[j] = *(const bf16x8*)(ap1 + j * 32); }
        f32x4 acc0 = (f32x4){0.f, 0.f, 0.f, 0.f}, acc1 = acc0;
#pragma unroll
        for (int j = 0; j < 16; ++j) {
            acc0 = __builtin_amdgcn_mfma_f32_16x16x32_bf16(b[j], a0[j], acc0, 0, 0, 0);
            acc1 = __builtin_amdgcn_mfma_f32_16x16x32_bf16(b[j], a1[j], acc1, 0, 0, 0);
        }
        *(LAS f32x4*)(lds + ((wave * 2 + 0) * 64 + lane) * 16) = acc0;
        *(LAS f32x4*)(lds + ((wave * 2 + 1) * 64 + lane) * 16) = acc1;
        __syncthreads();
        if (wave < 2) {
            f32x4 acc = *(const LAS f32x4*)(lds + ((0 * 2 + wave) * 64 + lane) * 16);
#pragma unroll
            for (int j = 1; j < 8; ++j) acc = acc + *(const LAS f32x4*)(lds + ((j * 2 + wave) * 64 + lane) * 16);
            E((rt0 + wave) * 16 + fr, ct * 16 + fq * 4, ct, fq, acc, pp);
        }
        __syncthreads();
    }
}

__device__ __forceinline__ f32x2 ssqs_part(const float* ssqs, int r, int fq) {
    const f32x4* q = (const f32x4*)(ssqs + (size_t)r * 64 + fq * 16);
    const f32x4 a = q[0], b = q[1], c = q[2], d = q[3];
    f32x2 o; o.x = (a[0] + a[1] + a[2] + a[3]) + (b[0] + b[1] + b[2] + b[3]); o.y = (c[0] + c[1] + c[2] + c[3]) + (d[0] + d[1] + d[2] + d[3]); return o;
}
__device__ __forceinline__ float ssqs_finish(f32x2 pp) {
    float s = pp.x + pp.y; s += __shfl_xor(s, 16); s += __shfl_xor(s, 32);
    return __builtin_amdgcn_rsqf(s * (1.0f / 1024.0f) + EPS);
}
struct SkE1 {
    const float* ssqs; bf16_t* U; float* vssqs;
    __device__ __forceinline__ f32x2 pre(int r, int col, int fq) const { return ssqs_part(ssqs, r, fq); }
    __device__ __forceinline__ void operator()(int r, int col, int ct, int fq, f32x4 v, f32x2 pp) const {
        const float rs = ssqs_finish(pp);
        const int sec = col >> 9, cc = col & 511;
        v = v * rs;
        if (sec != 3) { v[0] = gelu_t(v[0]); v[1] = gelu_t(v[1]); v[2] = gelu_t(v[2]); v[3] = gelu_t(v[3]); }
        store_bf4(U + (size_t)sec * ((size_t)MPAD * 512) + (size_t)(MP + r) * 512 + cc, v);
        float sq = v[0] * v[0] + v[1] * v[1] + v[2] * v[2] + v[3] * v[3];
        sq += __shfl_xor(sq, 16); sq += __shfl_xor(sq, 32);
        if (sec == 1 && fq == 0) vssqs[r * 32 + (cc >> 4)] = sq;
    }
};
struct SkF1 {
    const float* ssqs; bf16_t* H;
    __device__ __forceinline__ f32x2 pre(int r, int col, int fq) const { return ssqs_part(ssqs, r, fq); }
    __device__ __forceinline__ void operator()(int r, int col, int ct, int fq, f32x4 v, f32x2 pp) const {
        const float rs = ssqs_finish(pp);
        v = v * rs;
#pragma unroll
        for (int j = 0; j < 4; ++j) { const float q = fmaxf(v[j], 0.f); v[j] = q * q; }
        store_bf4(H + (size_t)(MP + r) * DFF + col, v);
    }
};
struct SkRes {
    const bf16_t* Xi; bf16_t* Xo; float* ssqs; const float* bias; const float* cscale;
    __device__ __forceinline__ f32x2 pre(int r, int col, int fq) const { const u32x2 xw = *(const u32x2*)(Xi + (size_t)r * DM + col); f32x2 o; o.x = __uint_as_float(xw.x); o.y = __uint_as_float(xw.y); return o; }
    __device__ __forceinline__ void operator()(int r, int col, int ct, int fq, f32x4 v, f32x2 pp) const {
        if (bias) v = (v + *(const f32x4*)(bias + col)) * *(const f32x4*)(cscale + col);
        bf16_t* xr = Xo + (size_t)r * DM + col;
        { const unsigned x0 = __float_as_uint(pp.x), x1 = __float_as_uint(pp.y); v[0] += bflo(x0); v[1] += bfhi(x0); v[2] += bflo(x1); v[3] += bfhi(x1); }
        store_bf4(xr, v);
        float sq = v[0] * v[0] + v[1] * v[1] + v[2] * v[2] + v[3] * v[3];
        sq += __shfl_xor(sq, 16); sq += __shfl_xor(sq, 32);
        if (fq == 0) ssqs[r * 64 + ct] = sq;
    }
};

__device__ void transpose_cvt(const float* __restrict__ src, bf16_t* __restrict__ dst, int K, int N, LAS float* sT, int G, int blk) {
    const int tid = opaque_tid();
    const int tk = K / 64, tn = N / 64, ntile = tk * tn;
    for (int t = blk; t < ntile; t += G) {
        const int k0 = (t / tn) * 64, n0 = (t % tn) * 64;
#pragma unroll
        for (int i = 0; i < 2; ++i) {
            const int k = (tid >> 4) + 32 * i, n4 = (tid & 15) * 4;
            const f32x4 v = *(const f32x4*)(src + (size_t)(k0 + k) * N + n0 + n4);
            sT[k * 65 + n4 + 0] = v[0]; sT[k * 65 + n4 + 1] = v[1]; sT[k * 65 + n4 + 2] = v[2]; sT[k * 65 + n4 + 3] = v[3];
        }
        __syncthreads();
        {
            const int n = tid >> 3, kk = (tid & 7) * 8;
            float f[8];
#pragma unroll
            for (int j = 0; j < 8; ++j) f[j] = sT[(kk + j) * 65 + n];
            u32x4 w; w.x = cvt_pk_bf16(f[0], f[1]); w.y = cvt_pk_bf16(f[2], f[3]); w.z = cvt_pk_bf16(f[4], f[5]); w.w = cvt_pk_bf16(f[6], f[7]);
            *(u32x4*)(dst + (size_t)(n0 + n) * K + k0 + kk) = w;
        }
        __syncthreads();
    }
}
__device__ void transpose_cvt_wide(const float* __restrict__ src, bf16_t* __restrict__ dst, int K, int N, int nmat, LAS float* sT, int G, int rot, const float* gk, int gstride) {
    const int tid = opaque_tid();
    const int tk = K / 64, tn = N / 256, per = tk * tn, ntile = per * nmat;
    int blk = (int)blockIdx.x + rot; if (blk >= G) blk -= G;
    for (int t = blk; t < ntile; t += G) {
        const int mat = t / per, tt = t - mat * per;
        const int k0 = (tt / tn) * 64, n0 = (tt % tn) * 256;
        const float* sp = src + (size_t)mat * K * N; bf16_t* dp = dst + (size_t)mat * K * N;
        f32x4 v[8];
#pragma unroll
        for (int i = 0; i < 8; ++i) v[i] = *(const f32x4*)(sp + (size_t)(k0 + (tid >> 6) + 8 * i) * N + n0 + (tid & 63) * 4);
        if (gk) {
#pragma unroll
            for (int i = 0; i < 8; ++i) v[i] = v[i] * gk[(size_t)mat * gstride + k0 + (tid >> 6) + 8 * i];
        }
#pragma unroll
        for (int i = 0; i < 8; ++i) {
            const int k = (tid >> 6) + 8 * i, n4 = (tid & 63) * 4;
            sT[k * 257 + n4 + 0] = v[i][0]; sT[k * 257 + n4 + 1] = v[i][1]; sT[k * 257 + n4 + 2] = v[i][2]; sT[k * 257 + n4 + 3] = v[i][3];
        }
        __syncthreads();
        {
            const int piece = tid & 7;
#pragma unroll
            for (int i = 0; i < 4; ++i) {
                const int n = (tid >> 3) + 64 * i;
                float f[8];
#pragma unroll
                for (int j = 0; j < 8; ++j) f[j] = sT[(piece * 8 + j) * 257 + n];
                u32x4 w; w.x = cvt_pk_bf16(f[0], f[1]); w.y = cvt_pk_bf16(f[2], f[3]); w.z = cvt_pk_bf16(f[4], f[5]); w.w = cvt_pk_bf16(f[6], f[7]);
                st_wt16(dp, (unsigned)(((n0 + n) * K + k0 + piece * 8) * 2), w);
            }
        }
        __syncthreads();
    }
}

__device__ void gap0_extras(const Params& p, LAS unsigned char* lds, int G) {
    LAS float* sT = (LAS float*)lds;
    unsigned char* ws = p.ws;
    transpose_cvt_wide(p.pool_w, (bf16_t*)(ws + WS_WP), 256, 256, 8, sT, G, 128, nullptr, 0);
    for (int m = (int)blockIdx.x - 192; m >= 0 && m < 32; m += G) {
        const int eh = m >> 1, gate = m & 1, e = eh >> 3, h = eh & 7;
        transpose_cvt((gate ? p.gate_x_w : p.gate_a_w) + (size_t)eh * 4096, (bf16_t*)(ws + WS_GW) + (size_t)((e * 2 + gate) * 8 + h) * 4096, 64, 64, sT, 1 << 30, 0);
    }
    const int tid0 = opaque_tid();
    const int gtid = blockIdx.x * NTHR + tid0, gthr = G * NTHR;
    {
        bf16_t* SW = (bf16_t*)(ws + WS_SW);
        for (int i = gtid; i < 2 * 8 * 128 * 128; i += gthr) { const int s = i & 127, t = (i >> 7) & 127; SW[i] = (s <= t) ? f2bf(p.sgu_w[i]) : (bf16_t)0; }
        float* SP = (float*)(ws + WS_SP);
        for (int i = gtid; i < 1024; i += gthr) { const float z = -p.lru_lambda[i]; SP[i] = fmaxf(z, 0.f) + log1pf(expf(-fabsf(z))); }
    }
    {
        u32x4* cgz = (u32x4*)(ws + WS_CG);
        const u32x4 z = (u32x4){0u, 0u, 0u, 0u};
        for (int i = gtid; i < (int)((size_t)2 * 1024 * 128 * 8 / 16); i += gthr) cgz[i] = z;
    }
}

__device__ void phase_prep(const Params& p, LAS unsigned char* lds, int G) {
    LAS float* sT = (LAS float*)lds;
    unsigned char* ws = p.ws;
    transpose_cvt_wide(p.w_in, (bf16_t*)(ws + WS_WIN), DM, DIN, 1, sT, G, 0, p.norm_mix, 2 * DM);
    const int tid0 = opaque_tid();
    {
        const int wave = tid0 >> 6, lane = tid0 & 63;
        bf16_t* XG = (bf16_t*)(ws + WS_XG); float* SSQ = (float*)(ws + WS_SSQ); float* SSQS = (float*)(ws + WS_SSQS);
        for (int row = blockIdx.x * 8 + wave; row < MR; row += G * 8) {
            float sq = 0.f;
            const float* xr = row < MP ? p.x_prompt + (size_t)row * DM : p.x_sample + (size_t)(row - MP) * DM;
#pragma unroll
            for (int q = 0; q < 4; ++q) {
                const int col = q * 256 + lane * 4;
                const f32x4 v = *(const f32x4*)(xr + col);
                sq += v[0] * v[0] + v[1] * v[1] + v[2] * v[2] + v[3] * v[3];
                { u32x2 w2; w2.x = cvt_pk_bf16(v[0], v[1]); w2.y = cvt_pk_bf16(v[2], v[3]); st_wt8(XG, (unsigned)((row * DM + col) * 2), w2); }
            }
#pragma unroll
            for (int o = 1; o < 64; o <<= 1) sq += __shfl_xor(sq, o);
            if (row < MP) { if (lane < 16) SSQ[(size_t)row * 16 + lane] = (lane == 0) ? sq : 0.f; }
            else SSQS[(size_t)(row - MP) * 64 + lane] = (lane == 0) ? sq : 0.f;
        }
    }
}

__device__ void sample_pool_pre(const Params& p, int G);
__device__ void gap_convert(const Params& p, int g, LAS unsigned char* lds, int G) {
    if (g > 9) return;
    unsigned char* ws = p.ws;
    const float* src; bf16_t* dst; int K, N, nmat = 1; const float* gk = nullptr;
    const int l = (g - 1) >> 1;
    if (g == 0) { src = p.w_out; dst = (bf16_t*)(ws + WS_WOUT); K = DM; N = DM; nmat = 2; }
    else if (g == 5) { src = p.w_in + (size_t)DM * DIN; dst = (bf16_t*)(ws + WS_WIN) + (size_t)DIN * DM; K = DM; N = DIN; gk = p.norm_mix + 2 * DM; }
    else {
        const int gg = g < 5 ? g - 1 : g - 2;
        const int layer = gg >> 1;
        if ((gg & 1) == 0) { src = p.ffn_w1 + (size_t)layer * DM * DFF; dst = (bf16_t*)(ws + WS_W1) + (size_t)layer * DFF * DM; K = DM; N = DFF; gk = p.norm_ffn + layer * DM; }
        else { src = p.ffn_w2 + (size_t)layer * DFF * DM; dst = (bf16_t*)(ws + WS_W2) + (size_t)layer * DM * DFF; K = DFF; N = DM; }
    }
    (void)l;
    transpose_cvt_wide(src, dst, K, N, nmat, (LAS float*)lds, G, 0, gk, 0);
    if (g == 3) sample_pool_pre(p, G);
}

constexpr int L_XC = 0;
constexpr int L_XF = 18432;
constexpr int PF = 68;
constexpr int L_A = L_XF + 128 * PF * 4;
constexpr int L_B = L_A + 128 * PF * 4;
constexpr int L_PE = L_B + 128 * PF * 4;
constexpr int L_HE = L_PE + 2048;
constexpr int L_CARRY = L_HE + 2048;
constexpr int L_GW = L_CARRY + 256;
constexpr int L_SC = L_GW + 2 * 64 * 72 * 2;
static_assert(L_SC + 768 <= LDS_BYTES - 16, "LDS map");

__device__ __forceinline__ void lru_gates(LAS unsigned char* lds) {
    const int tid = opaque_tid(), lane = tid & 63, w = tid >> 6, fr = lane & 15, fq = lane >> 4;
    const int t = 16 * w + fr;
    bf16x8 Af[2];
#pragma unroll
    for (int ks = 0; ks < 2; ++ks) Af[ks] = *(const LAS bf16x8*)(lds + L_XC + (t * 72 + ks * 32 + fq * 8) * 2);
#pragma unroll
    for (int nt = 0; nt < 4; ++nt) {
        f32x4 ra = (f32x4){0.f, 0.f, 0.f, 0.f}, rx = (f32x4){0.f, 0.f, 0.f, 0.f};
#pragma unroll
        for (int ks = 0; ks < 2; ++ks) {
            const bf16x8 Ba = *(const LAS bf16x8*)(lds + L_GW + ((nt * 16 + fr) * 72 + ks * 32 + fq * 8) * 2);
            const bf16x8 Bx = *(const LAS bf16x8*)(lds + L_GW + ((64 + nt * 16 + fr) * 72 + ks * 32 + fq * 8) * 2);
            ra = __builtin_amdgcn_mfma_f32_16x16x32_bf16(Ba, Af[ks], ra, 0, 0, 0);
            rx = __builtin_amdgcn_mfma_f32_16x16x32_bf16(Bx, Af[ks], rx, 0, 0, 0);
        }
        const int c = nt * 16 + fq * 4;
        const f32x4 bav = *(const LAS f32x4*)(lds + L_SC + c * 4), bxv = *(const LAS f32x4*)(lds + L_SC + 256 + c * 4), spv = *(const LAS f32x4*)(lds + L_SC + 512 + c * 4);
        const f32x4 xc = *(const LAS f32x4*)(lds + L_XF + (t * PF + c) * 4);
        f32x4 av, bv;
#pragma unroll
        for (int j = 0; j < 4; ++j) {
            const float r = sigmoid_f(ra[j] + bav[j]), ig = sigmoid_f(rx[j] + bxv[j]);
            const float la = -8.0f * r * spv[j];
            const float a = __builtin_amdgcn_exp2f(la * 1.442695041f);
            const float mult = __builtin_amdgcn_sqrtf(fmaxf(1.0f - a * a, 0.f));
            av[j] = a; bv[j] = mult * ig * xc[j];
        }
        *(LAS f32x4*)(lds + L_A + (t * PF + c) * 4) = av;
        *(LAS f32x4*)(lds + L_B + (t * PF + c) * 4) = bv;
    }
}

__device__ __forceinline__ u32x4 f32_to_bf8(f32x4 lo, f32x4 hi) {
    u32x4 w; w.x = cvt_pk_bf16(lo[0], lo[1]); w.y = cvt_pk_bf16(lo[2], lo[3]); w.z = cvt_pk_bf16(hi[0], hi[1]); w.w = cvt_pk_bf16(hi[2], hi[3]); return w;
}

__device__ void lru_item(const Params& p, int e, int item, LAS unsigned char* lds) {
    const int tid = opaque_tid(), lane = tid & 63, w = tid >> 6;
    const bool sample = item >= 1024;
    const int h = sample ? item - 1024 : (item & 7), b = sample ? 0 : ((item >> 3) & 7);
    const int ch0 = h * 64, ch = lane, tq = w;
    const int rr8 = tid >> 3, part = tid & 7;
    unsigned char* ws = p.ws;
    const bf16_t* XB = (const bf16_t*)(ws + WS_XB); const bf16_t* GG = (const bf16_t*)(ws + WS_GG); bf16_t* AB = (bf16_t*)(ws + WS_AB);
    const float* ba = p.gate_a_b + e * 512; const float* bx = p.gate_x_b + e * 512; const float* sp = (const float*)(ws + WS_SP) + e * 512;
    LAS float* sXF = (LAS float*)(lds + L_XF); LAS bf16_t* sXC = (LAS bf16_t*)(lds + L_XC);
    LAS float* sA = (LAS float*)(lds + L_A); LAS float* sB = (LAS float*)(lds + L_B); LAS float* sXR = (LAS float*)(lds + L_A);
    LAS float* sPE = (LAS float*)(lds + L_PE); LAS float* sHE = (LAS float*)(lds + L_HE);
    {
        const int g = tid >> 8, n = (tid >> 2) & 63, pt = tid & 3;
        const bf16_t* gw = (const bf16_t*)(ws + WS_GW) + (size_t)((e * 2 + g) * 8 + h) * 4096 + n * 64 + pt * 16;
        const u32x4 w0 = *(const u32x4*)gw, w1 = *(const u32x4*)(gw + 8);
        LAS unsigned char* d = lds + L_GW + ((g * 64 + n) * 72 + pt * 16) * 2;
        *(LAS u32x4*)d = w0; *(LAS u32x4*)(d + 16) = w1;
        if (tid < 48) {
            const int which = tid >> 4, c4 = (tid & 15) * 4;
            const float* src = which == 0 ? ba : (which == 1 ? bx : sp);
            *(LAS f32x4*)(lds + L_SC + which * 256 + c4 * 4) = *(const f32x4*)(src + ch0 + c4);
        }
    }

    if (sample) {
        const int cc = ch0 + part * 8;
        f32x4 cwl[4], cwh[4];
#pragma unroll
        for (int k = 0; k < 4; ++k) { cwl[k] = *(const f32x4*)(p.conv_w + (e * 4 + k) * 512 + cc); cwh[k] = *(const f32x4*)(p.conv_w + (e * 4 + k) * 512 + cc + 4); }
        const f32x4 cbl = *(const f32x4*)(p.conv_b + e * 512 + cc), cbh = *(const f32x4*)(p.conv_b + e * 512 + cc + 4);
#pragma unroll
        for (int i = 0; i < 2; ++i) {
            const int r = rr8 + 64 * i;
            const float* sc = p.state_conv + ((size_t)(e * 128 + r) * 3) * 512 + cc;
            const f32x4 s0l = *(const f32x4*)sc, s0h = *(const f32x4*)(sc + 4), s1l = *(const f32x4*)(sc + 512), s1h = *(const f32x4*)(sc + 516),
                        s2l = *(const f32x4*)(sc + 1024), s2h = *(const f32x4*)(sc + 1028);
            f32x4 xl, xh; bf8_to_f32(*(const u32x4*)(XB + (size_t)(MP + r) * 512 + cc), xl, xh);
            const f32x4 xcl = cbl + cwl[0] * s0l + cwl[1] * s1l + cwl[2] * s2l + cwl[3] * xl;
            const f32x4 xch = cbh + cwh[0] * s0h + cwh[1] * s1h + cwh[2] * s2h + cwh[3] * xh;
            *(LAS f32x4*)(sXF + r * PF + part * 8) = xcl; *(LAS f32x4*)(sXF + r * PF + part * 8 + 4) = xch;
            *(LAS u32x4*)(sXC + r * 72 + part * 8) = f32_to_bf8(xcl, xch);
            float* co = p.out + O_CONVS + ((size_t)(e * 128 + r) * 3) * 512 + cc;
            *(f32x4*)co = s1l; *(f32x4*)(co + 4) = s1h; *(f32x4*)(co + 512) = s2l; *(f32x4*)(co + 516) = s2h; *(f32x4*)(co + 1024) = xl; *(f32x4*)(co + 1028) = xh;
        }
        __syncthreads();
        lru_gates(lds);
        __syncthreads();
#pragma unroll
        for (int i = 0; i < 2; ++i) {
            const int r = rr8 + 64 * i;
            const float* hp = p.state_rglru + (size_t)(e * 128 + r) * 512 + cc;
            const f32x4 h0l = *(const f32x4*)hp, h0h = *(const f32x4*)(hp + 4);
            const f32x4 al = *(const LAS f32x4*)(sA + r * PF + part * 8), ah = *(const LAS f32x4*)(sA + r * PF + part * 8 + 4);
            const f32x4 bl = *(const LAS f32x4*)(sB + r * PF + part * 8), bh = *(const LAS f32x4*)(sB + r * PF + part * 8 + 4);
            const f32x4 hl = al * h0l + bl, hh = ah * h0h + bh;
            float* ho = p.out + O_HS + (size_t)(e * 128 + r) * 512 + cc;
            *(f32x4*)ho = hl; *(f32x4*)(ho + 4) = hh;
            f32x4 gl, gh; bf8_to_f32(*(const u32x4*)(GG + (size_t)(MP + r) * 512 + cc), gl, gh);
            *(u32x4*)(AB + (size_t)(MP + r) * DM + 512 + cc) = f32_to_bf8(hl * gl, hh * gh);
        }
        __syncthreads();
        return;
    }

}

constexpr int L_VT = 0;
__device__ void sgu_item(const Params& p, int e, int it, LAS unsigned char* lds) {
    const int tid = opaque_tid(), lane = tid & 63, w = tid >> 6, fr = lane & 15, fq = lane >> 4;
    unsigned char* ws = p.ws;
    const bf16_t* U = (const bf16_t*)(ws + WS_U); const bf16_t* VP = (const bf16_t*)(ws + WS_VP); bf16_t* AB = (bf16_t*)(ws + WS_AB);
    const float* VSSQ = (const float*)(ws + WS_VSSQ);
    if (it >= 1024) {
        float* vo = p.out + O_SGUV + (size_t)e * MS * 512;
        {
            const int r = (it - 1024) * 4 + (tid >> 7), c4 = (tid & 127) * 4, h = c4 >> 6;
            const float rsv = rsv_sample_full((const float*)(ws + WS_VSSQS), r);
            const u32x2 vw = *(const u32x2*)(VP + (size_t)(MP + r) * 512 + c4), uw = *(const u32x2*)(U + (size_t)(MP + r) * 512 + c4);
            const f32x4 vn = *(const f32x4*)(p.v_norm + e * 512 + c4);
            f32x4 v; v[0] = bflo(vw.x) * rsv * vn[0]; v[1] = bfhi(vw.x) * rsv * vn[1]; v[2] = bflo(vw.y) * rsv * vn[2]; v[3] = bfhi(vw.y) * rsv * vn[3];
            *(f32x4*)(vo + (size_t)r * 512 + c4) = v;
            const float w00 = p.sgu_w[(size_t)(e * 8 + h) * 16384], b0 = p.sgu_b[(e * 8 + h) * 128];
            f32x4 a; a[0] = bflo(uw.x) * (w00 * v[0] + b0); a[1] = bfhi(uw.x) * (w00 * v[1] + b0); a[2] = bflo(uw.y) * (w00 * v[2] + b0); a[3] = bfhi(uw.y) * (w00 * v[3] + b0);
            store_bf4(AB + (size_t)(MP + r) * DM + c4, a);
        }
        return;
    }
}

struct SguPre { bf16x8 wf[4]; u32x2 uw[4]; float bsv; u32x4 v0, v1; f32x4 q0, q1; f32x4 vn0, vn1, vn2, vn3; };
__device__ __forceinline__ void sgu_load(const Params& p, int e, int it, SguPre& R, int tid) {
    const int lane = tid & 63, w = tid >> 6, fr = lane & 15, fq = lane >> 4;
    unsigned char* ws = p.ws;
    const bf16_t* U = (const bf16_t*)(ws + WS_U); const bf16_t* VP = (const bf16_t*)(ws + WS_VP); const float* VSSQ = (const float*)(ws + WS_VSSQ);
    const int h = it & 7, row0 = (it >> 3) * 128, t = 16 * w + fr, nks = (16 * w + 15) / 32 + 1;
    const bf16_t* SW = (const bf16_t*)(ws + WS_SW) + (size_t)(e * 8 + h) * 16384;
#pragma unroll
    for (int ks = 0; ks < 4; ++ks) R.wf[ks] = (ks < nks) ? *(const bf16x8*)(SW + t * 128 + ks * 32 + fq * 8) : (bf16x8){0, 0, 0, 0, 0, 0, 0, 0};
#pragma unroll
    for (int nt = 0; nt < 4; ++nt) R.uw[nt] = *(const u32x2*)(U + (size_t)(row0 + t) * 512 + h * 64 + nt * 16 + fq * 4);
    R.bsv = p.sgu_b[(e * 8 + h) * 128 + t];
    const int s = tid >> 2, dq = (tid & 3) * 16;
    R.q0 = *(const f32x4*)(VSSQ + (size_t)(row0 + s) * 8); R.q1 = *(const f32x4*)(VSSQ + (size_t)(row0 + s) * 8 + 4);
    R.v0 = *(const u32x4*)(VP + (size_t)(row0 + s) * 512 + h * 64 + dq); R.v1 = *(const u32x4*)(VP + (size_t)(row0 + s) * 512 + h * 64 + dq + 8);
    const float* vn = p.v_norm + e * 512 + h * 64 + dq;
    R.vn0 = *(const f32x4*)(vn); R.vn1 = *(const f32x4*)(vn + 4); R.vn2 = *(const f32x4*)(vn + 8); R.vn3 = *(const f32x4*)(vn + 12);
}
__device__ __forceinline__ void sgu_compute(const Params& p, int it, const SguPre& R, LAS unsigned char* lds, int tid) {
    const int lane = tid & 63, w = tid >> 6, fr = lane & 15, fq = lane >> 4;
    bf16_t* AB = (bf16_t*)(p.ws + WS_AB);
    const int h = it & 7, row0 = (it >> 3) * 128, t = 16 * w + fr, nks = (16 * w + 15) / 32 + 1;
    LAS bf16_t* sVT = (LAS bf16_t*)(lds + L_VT);
    {
        const int s = tid >> 2, dq = (tid & 3) * 16;
        const float ssum = (R.q0[0] + R.q0[1] + R.q0[2] + R.q0[3]) + (R.q1[0] + R.q1[1] + R.q1[2] + R.q1[3]);
        const float rsv = __builtin_amdgcn_rsqf(ssum * (1.0f / 512.0f) + EPS);
        f32x4 f0, f1, f2, f3; bf8_to_f32(R.v0, f0, f1); bf8_to_f32(R.v1, f2, f3);
        f0 = f0 * R.vn0 * rsv; f1 = f1 * R.vn1 * rsv; f2 = f2 * R.vn2 * rsv; f3 = f3 * R.vn3 * rsv;
#pragma unroll
        for (int j = 0; j < 4; ++j) {
            sVT[(dq + j) * 136 + s] = f2bf(f0[j]); sVT[(dq + 4 + j) * 136 + s] = f2bf(f1[j]);
            sVT[(dq + 8 + j) * 136 + s] = f2bf(f2[j]); sVT[(dq + 12 + j) * 136 + s] = f2bf(f3[j]);
        }
    }
    __syncthreads();
    {
        f32x4 acc[4];
#pragma unroll
        for (int nt = 0; nt < 4; ++nt) acc[nt] = (f32x4){0.f, 0.f, 0.f, 0.f};
#pragma unroll
        for (int ks = 0; ks < 4; ++ks) {
            if (ks < nks) {
#pragma unroll
                for (int nt = 0; nt < 4; ++nt) {
                    const bf16x8 vf = *(const LAS bf16x8*)(lds + L_VT + ((nt * 16 + fr) * 136 + ks * 32 + fq * 8) * 2);
                    acc[nt] = __builtin_amdgcn_mfma_f32_16x16x32_bf16(vf, R.wf[ks], acc[nt], 0, 0, 0);
                }
            }
        }
#pragma unroll
        for (int nt = 0; nt < 4; ++nt) {
            const int c = h * 64 + nt * 16 + fq * 4;
            f32x4 o; o[0] = bflo(R.uw[nt].x) * (acc[nt][0] + R.bsv); o[1] = bfhi(R.uw[nt].x) * (acc[nt][1] + R.bsv); o[2] = bflo(R.uw[nt].y) * (acc[nt][2] + R.bsv); o[3] = bfhi(R.uw[nt].y) * (acc[nt][3] + R.bsv);
            store_bf4(AB + (size_t)(row0 + t) * DM + c, o);
        }
    }
    __syncthreads();
}

struct LruPre { u32x4 x[3]; u32x4 gg[2]; unsigned long long gq[2][2]; };
__device__ __forceinline__ void lru_load(const Params& p, int e, int item, LruPre& R, int tid) {
    const int lane = tid & 63, tq = tid >> 6, ch = lane, rr8 = tid >> 3, part = tid & 7;
    const int h = item & 7, b = (item >> 3) & 7, c = item >> 6, ch0 = h * 64, row0 = b * SEQ + c * 128;
    unsigned char* ws = p.ws;
    const bf16_t* XB = (const bf16_t*)(ws + WS_XB); const bf16_t* GG = (const bf16_t*)(ws + WS_GG);
    unsigned long long* CG = (unsigned long long*)(ws + WS_CG) + (size_t)e * 1024 * 128;
#pragma unroll
    for (int i = 0; i < 3; ++i) {
        const int rr = rr8 + 64 * i, tl = c * 128 - 3 + rr;
        R.x[i] = (rr < 131 && tl >= 0) ? *(const u32x4*)(XB + (size_t)(b * SEQ + tl) * 512 + ch0 + part * 8) : (u32x4){0u, 0u, 0u, 0u};
    }
#pragma unroll
    for (int i = 0; i < 2; ++i) R.gg[i] = *(const u32x4*)(GG + (size_t)(row0 + rr8 + 64 * i) * 512 + ch0 + part * 8);
#pragma unroll
    for (int q = 0; q < 2; ++q) {
        const int j = tq + 8 * q;
        R.gq[q][0] = 0ull; R.gq[q][1] = 0ull;
        if (j < c) { unsigned long long* g = CG + (size_t)(j * 64 + (item & 63)) * 128 + ch;
            R.gq[q][0] = __hip_atomic_load(g, __ATOMIC_RELAXED, __HIP_MEMORY_SCOPE_AGENT); R.gq[q][1] = __hip_atomic_load(g + 64, __ATOMIC_RELAXED, __HIP_MEMORY_SCOPE_AGENT); }
    }
}

__device__ void lru_prompt_loop(const Params& p, int e, LAS unsigned char* lds, int G) {
    const int tid = opaque_tid(), lane = tid & 63, w = tid >> 6;
    const int ch = lane, tq = w, rr8 = tid >> 3, part = tid & 7;
    unsigned char* ws = p.ws;
    bf16_t* AB = (bf16_t*)(ws + WS_AB);
    const float* ba = p.gate_a_b + e * 512; const float* bx = p.gate_x_b + e * 512; const float* sp = (const float*)(ws + WS_SP) + e * 512;
    LAS float* sXF = (LAS float*)(lds + L_XF); LAS bf16_t* sXC = (LAS bf16_t*)(lds + L_XC);
    LAS float* sA = (LAS float*)(lds + L_A); LAS float* sB = (LAS float*)(lds + L_B); LAS float* sXR = (LAS float*)(lds + L_A);
    LAS float* sPE = (LAS float*)(lds + L_PE); LAS float* sHE = (LAS float*)(lds + L_HE);
    LAS float* sCP = (LAS float*)(lds + L_A); LAS float* sCH = (LAS float*)(lds + L_A + 4096);
    unsigned long long* CG = (unsigned long long*)(ws + WS_CG) + (size_t)e * 1024 * 128;
    int item = blockIdx.x;
    if (item >= 1024) return;
    LruPre cur; lru_load(p, e, item, cur, tid);
    int cur_h = -1;
    float cw0 = 0.f, cw1 = 0.f, cw2 = 0.f, cw3 = 0.f, cb = 0.f;
    for (;;) {
        const int h = item & 7, b = (item >> 3) & 7, c = item >> 6, ch0 = h * 64, row0 = b * SEQ + c * 128;
        if (h != cur_h) {
            cur_h = h;
            const int g = tid >> 8, n = (tid >> 2) & 63, pt = tid & 3;
            const bf16_t* gw = (const bf16_t*)(ws + WS_GW) + (size_t)((e * 2 + g) * 8 + h) * 4096 + n * 64 + pt * 16;
            const u32x4 w0 = *(const u32x4*)gw, w1 = *(const u32x4*)(gw + 8);
            LAS unsigned char* d = lds + L_GW + ((g * 64 + n) * 72 + pt * 16) * 2;
            *(LAS u32x4*)d = w0; *(LAS u32x4*)(d + 16) = w1;
            if (tid < 48) {
                const int which = tid >> 4, c4 = (tid & 15) * 4;
                const float* src = which == 0 ? ba : (which == 1 ? bx : sp);
                *(LAS f32x4*)(lds + L_SC + which * 256 + c4 * 4) = *(const f32x4*)(src + ch0 + c4);
            }
            cw0 = p.conv_w[(e * 4 + 0) * 512 + ch0 + ch]; cw1 = p.conv_w[(e * 4 + 1) * 512 + ch0 + ch]; cw2 = p.conv_w[(e * 4 + 2) * 512 + ch0 + ch];
            cw3 = p.conv_w[(e * 4 + 3) * 512 + ch0 + ch]; cb = p.conv_b[e * 512 + ch0 + ch];
        }
#pragma unroll
        for (int i = 0; i < 3; ++i) {
            const int rr = rr8 + 64 * i;
            if (rr < 131) { f32x4 xl, xh; bf8_to_f32(cur.x[i], xl, xh);
                *(LAS f32x4*)(sXR + rr * 64 + part * 8) = xl; *(LAS f32x4*)(sXR + rr * 64 + part * 8 + 4) = xh; }
        }
        const int nitem = item + G; const bool has_next = nitem < 1024;
        LruPre nxt = cur;
        if (has_next) lru_load(p, e, nitem, nxt, tid);
        __syncthreads();
        {
            float xv[19];
#pragma unroll
            for (int j = 0; j < 19; ++j) xv[j] = sXR[(tq * 16 + j) * 64 + ch];
#pragma unroll
            for (int i = 0; i < 16; ++i) {
                const float xc = cb + cw0 * xv[i] + cw1 * xv[i + 1] + cw2 * xv[i + 2] + cw3 * xv[i + 3];
                const int t = tq * 16 + i;
                sXF[t * PF + ch] = xc; sXC[t * 72 + ch] = f2bf(xc);
            }
            if (c == 15 && tq == 7) {
                float* co = p.out + O_CONVP + ((size_t)(e * 8 + b) * 3) * 512 + ch0 + ch;
                co[0] = xv[16]; co[512] = xv[17]; co[1024] = xv[18];
            }
        }
        __syncthreads();
        lru_gates(lds);
        __syncthreads();
        {
            float Hl[16], Pc[16];
            float Hh = 0.f, Pp = 1.f;
#pragma unroll
            for (int i = 0; i < 16; ++i) {
                const float a = sA[(tq * 16 + i) * PF + ch], bb = sB[(tq * 16 + i) * PF + ch];
                Hh = a * Hh + bb; Pp = Pp * a; Hl[i] = Hh; Pc[i] = Pp;
            }
            sPE[tq * 64 + ch] = Pp; sHE[tq * 64 + ch] = Hh;
            __syncthreads();
            if (tq == 7 && c < 15) {
                float Pt = 1.f, Ht = 0.f;
#pragma unroll
                for (int s2 = 0; s2 < 8; ++s2) { const float pe = sPE[s2 * 64 + ch]; Ht = pe * Ht + sHE[s2 * 64 + ch]; Pt *= pe; }
                unsigned long long* g = CG + (size_t)item * 128 + ch;
                __hip_atomic_store(g, (1ull << 32) | (unsigned long long)__float_as_uint(Pt), __ATOMIC_RELAXED, __HIP_MEMORY_SCOPE_AGENT);
                __hip_atomic_store(g + 64, (1ull << 32) | (unsigned long long)__float_as_uint(Ht), __ATOMIC_RELAXED, __HIP_MEMORY_SCOPE_AGENT);
            }
#pragma unroll
            for (int q = 0; q < 2; ++q) {
                const int j = tq + 8 * q;
                if (j < c) {
                    unsigned long long* g = CG + (size_t)(j * 64 + (item & 63)) * 128 + ch;
                    unsigned long long gp = cur.gq[q][0], gh = cur.gq[q][1]; unsigned spin = 0;
                    while (!((gp >> 32) == 1ull && (gh >> 32) == 1ull) && ++spin < (1u << 24)) {
                        __builtin_amdgcn_s_sleep(1);
                        gp = __hip_atomic_load(g, __ATOMIC_RELAXED, __HIP_MEMORY_SCOPE_AGENT); gh = __hip_atomic_load(g + 64, __ATOMIC_RELAXED, __HIP_MEMORY_SCOPE_AGENT);
                    }
                    sCP[j * 64 + ch] = __uint_as_float((unsigned)gp); sCH[j * 64 + ch] = __uint_as_float((unsigned)gh);
                }
            }
            __syncthreads();
            float hin = 0.f;
            {
                float cp[15], chv[15], pe[7], he[7];
#pragma unroll
                for (int j = 0; j < 15; ++j) { cp[j] = sCP[j * 64 + ch]; chv[j] = sCH[j * 64 + ch]; }
#pragma unroll
                for (int s2 = 0; s2 < 7; ++s2) { pe[s2] = sPE[s2 * 64 + ch]; he[s2] = sHE[s2 * 64 + ch]; }
#pragma unroll
                for (int j = 0; j < 15; ++j) hin = (j < c) ? cp[j] * hin + chv[j] : hin;
#pragma unroll
                for (int s2 = 0; s2 < 7; ++s2) hin = (s2 < tq) ? pe[s2] * hin + he[s2] : hin;
            }
            float hlast = 0.f;
#pragma unroll
            for (int i = 0; i < 16; ++i) { const float hv = Hl[i] + Pc[i] * hin; hlast = hv; sXF[(tq * 16 + i) * PF + ch] = hv; }
            if (tq == 7 && c == 15) p.out[O_HP + (size_t)(e * 8 + b) * 512 + ch0 + ch] = hlast;
            __syncthreads();
        }
#pragma unroll
        for (int i = 0; i < 2; ++i) {
            const int t = rr8 + 64 * i;
            f32x4 gl, gh; bf8_to_f32(cur.gg[i], gl, gh);
            const f32x4 hl = *(const LAS f32x4*)(sXF + t * PF + part * 8), hh = *(const LAS f32x4*)(sXF + t * PF + part * 8 + 4);
            *(u32x4*)(AB + (size_t)(row0 + t) * DM + 512 + ch0 + part * 8) = f32_to_bf8(hl * gl, hh * gh);
        }
        if (!has_next) break;
        cur = nxt; item = nitem;
    }
    __syncthreads();
}

__device__ void phase_e2(const Params& p, int e, LAS unsigned char* lds, int G) {
    lru_prompt_loop(p, e, lds, G);
    constexpr int NLRU = 1032;
    int itg = blockIdx.x; while (itg < 1024) itg += G;
    for (; itg < NLRU; itg += G) lru_item(p, e, itg, lds);
    const int tid = opaque_tid();
    const int blk = blockIdx.x;
    const int j0 = blk >= 8 ? blk - 8 : 248 + blk;
    const int nit = blk < 8 ? 2 : ((blk >= 40 && blk < 56) ? 5 : 4);
#define SGU_IDX(k) ((k) < 4 ? j0 + 256 * (k) : 760 + ((blk - 40) & 7) + 256 * ((blk - 40) >> 3))
    {
        SguPre A, B; sgu_load(p, e, SGU_IDX(0), A, tid); B = A;
        int k = 0;
        for (;;) {
            if (k + 1 < nit) sgu_load(p, e, SGU_IDX(k + 1), B, tid);
            sgu_compute(p, SGU_IDX(k), A, lds, tid);
            if (++k >= nit) break;
            if (k + 1 < nit) sgu_load(p, e, SGU_IDX(k + 1), A, tid);
            sgu_compute(p, SGU_IDX(k), B, lds, tid);
            if (++k >= nit) break;
        }
    }
#undef SGU_IDX
    if (blk >= 8 && blk < 40) sgu_item(p, e, 1024 + blk - 8, lds);
}

template <int W>
__device__ __forceinline__ void pool_rows(const float (&v0)[31], const float (&v1)[31], int t0, bf16_t* pa) {
    float s0 = 0.f, s1 = 0.f;
#pragma unroll
    for (int q = 0; q < W; ++q) { s0 += v0[15 - q]; s1 += v1[15 - q]; }
#pragma unroll
    for (int i = 0; i < 16; ++i) {
        const int jj = 15 + i, t = t0 + i;
        if (i > 0) { s0 += v0[jj] - v0[jj - W]; s1 += v1[jj] - v1[jj - W]; }
        const float ic = (t + 1 < W) ? 1.0f / (float)(t + 1) : (1.0f / (float)W);
        *(unsigned*)(pa + (size_t)i * DM) = cvt_pk_bf16(s0 * ic - v0[jj], s1 * ic - v1[jj]);
    }
}

__device__ void sample_pool_pre(const Params& p, int G) {
    const int tid = opaque_tid();
    const int c = tid * 2, w = 2 << (c >> 8);
    float* SPS = (float*)(p.ws + WS_SPSUM);
    for (int it = blockIdx.x; it < 2 * MS; it += G) {
        const int o = it >> 7, r = it & 127;
        const float* sp = p.state_pool + ((size_t)(o * 128 + r) * 15) * DM + c;
        float* po = p.out + O_POOLS + ((size_t)(o * 128 + r) * 15) * DM + c;
        f32x2 z[15];
#pragma unroll
        for (int k = 0; k < 15; ++k) z[k] = *(const f32x2*)(sp + (size_t)k * DM);
        float s0 = 0.f, s1 = 0.f;
#pragma unroll
        for (int k = 14; k >= 0; --k) {
            if (14 - k < w - 1) { s0 += z[k].x; s1 += z[k].y; }
            if (k >= 1) *(f32x2*)(po + (size_t)(k - 1) * DM) = z[k];
        }
        f32x2 sv; sv.x = s0; sv.y = s1;
        *(f32x2*)(SPS + (size_t)(o * 128 + r) * DM + c) = sv;
    }
}

template <int W>
__device__ __forceinline__ void pool_tile_rows(const Params& p, int layer, int pm, int pn, LAS float* sRS, int tid) {
    const int o = layer >> 1, b = pm >> 3, tbase = (pm & 7) * 256;
    const bf16_t* X = (const bf16_t*)(p.ws + WS_XG); bf16_t* PA = (bf16_t*)(p.ws + WS_PA);
    const bf16_t* HALO = (const bf16_t*)(p.ws + WS_HALO);
    const int c = pn * 256 + (tid & 127) * 2;
    const f32x2 gmix = *(const f32x2*)(p.norm_mix + layer * DM + c);
    for (int s = tid >> 7; s < 16; s += 4) {
        const int t0 = tbase + s * 16;
        unsigned wv[31];
#pragma unroll
        for (int j = 0; j < 31; ++j) {
            const int tl = t0 - 15 + j;
            const bf16_t* src = (s == 0 && j < 15) ? HALO + (size_t)((pm - 1) * 16 + j + 1) * DM + c : X + (size_t)(b * SEQ + tl) * DM + c;
            wv[j] = (tl >= 0) ? *(const unsigned*)src : 0u;
        }
        float v0[31], v1[31];
#pragma unroll
        for (int j = 0; j < 31; ++j) { const float rs = sRS[s * 16 + j]; v0[j] = bflo(wv[j]) * rs * gmix.x; v1[j] = bfhi(wv[j]) * rs * gmix.y; }
        pool_rows<W>(v0, v1, t0, PA + (size_t)(b * SEQ + t0) * DM + c);
        if (t0 == SEQ - 16) {
#pragma unroll
            for (int k = 0; k < 15; ++k) { f32x2 z; z.x = v0[16 + k]; z.y = v1[16 + k]; *(f32x2*)(p.out + O_POOLP + ((size_t)(o * 8 + b) * 15 + k) * DM + c) = z; }
        }
    }
}
__device__ void pool_tile_prep(const Params& p, int layer, int pm, int pn, LAS unsigned char* lds) {
    const int tid = opaque_tid();
    const float* SSQ = (const float*)(p.ws + WS_SSQ);
    LAS float* sRS = (LAS float*)lds;
    const int b = pm >> 3, tbase = (pm & 7) * 256;
    if (tid < 271) { const int tl = tbase - 15 + tid; sRS[tid] = tl >= 0 ? row_rs16(SSQ, b * SEQ + tl) : 0.f; }
    __syncthreads();
    if (pn == 0) pool_tile_rows<2>(p, layer, pm, pn, sRS, tid); else if (pn == 1) pool_tile_rows<4>(p, layer, pm, pn, sRS, tid);
    else if (pn == 2) pool_tile_rows<8>(p, layer, pm, pn, sRS, tid); else pool_tile_rows<16>(p, layer, pm, pn, sRS, tid);
    asm volatile("s_waitcnt vmcnt(0)" ::: "memory");
    __syncthreads();
}

template <class Epi>
__device__ __forceinline__ void skinny_pool(const Params& p, int layer, const bf16_t* Bt, const Epi& E, int G, const bf16_t* Xs, const float* SSQS) {
    const int tid = opaque_tid(), wave = tid >> 6, lane = tid & 63, fr = lane & 15, fq = lane >> 4;
    const int o = layer >> 1;
    const float* SPS = (const float*)(p.ws + WS_SPSUM) + (size_t)o * MS * DM;
    for (int ct = blockIdx.x; ct < 64; ct += G) {
        const int r = wave * 16 + fr, grp = ct >> 4, w = 2 << grp;
        const float invw = 1.0f / (float)w;
        const f32x2 pp = E.pre(r, ct * 16 + fq * 4, fq);
        const f32x2 ssp = ssqs_part(SSQS, r, fq);
        u32x4 xw[8]; bf16x8 bfr[8];
#pragma unroll
        for (int j = 0; j < 8; ++j) {
            const int col = grp * 256 + j * 32 + fq * 8;
            xw[j] = *(const u32x4*)(Xs + (size_t)r * DM + col);
            bfr[j] = *(const bf16x8*)(Bt + (size_t)(ct * 16 + fr) * 256 + j * 32 + fq * 8);
        }
        const float rs = ssqs_finish(ssp);
        f32x4 acc = (f32x4){0.f, 0.f, 0.f, 0.f};
#pragma unroll
        for (int j = 0; j < 8; ++j) {
            const int col = grp * 256 + j * 32 + fq * 8;
            const f32x4 s0 = *(const f32x4*)(SPS + (size_t)r * DM + col), s1 = *(const f32x4*)(SPS + (size_t)r * DM + col + 4);
            const f32x4 g0 = *(const f32x4*)(p.norm_mix + layer * DM + col), g1 = *(const f32x4*)(p.norm_mix + layer * DM + col + 4);
            f32x4 x0, x1; bf8_to_f32(xw[j], x0, x1);
            x0 = x0 * g0 * rs; x1 = x1 * g1 * rs;
            if ((ct & 15) == 0) { float* po = p.out + O_POOLS + ((size_t)(o * 128 + r) * 15 + 14) * DM + col; *(f32x4*)po = x0; *(f32x4*)(po + 4) = x1; }
            const f32x4 p0 = (x0 + s0) * invw - x0, p1 = (x1 + s1) * invw - x1;
            const u32x4 pk = pack_bf8(p0, p1);
            bf16x8 af; __builtin_memcpy(&af, &pk, 16);
            acc = __builtin_amdgcn_mfma_f32_16x16x32_bf16(bfr[j], af, acc, 0, 0, 0);
        }
        E(r, ct * 16 + fq * 4, ct, fq, acc, pp);
    }
}

__device__ void phase_final(const Params& p, int G, const bf16_t* Xs, const float* SSQS) {
    const int tidf = opaque_tid();
    const int wave = tidf >> 6, lane = tidf & 63;
    const float* SSQ = (const float*)(p.ws + WS_SSQ);
    const bf16_t* X = (const bf16_t*)(p.ws + WS_XG);
    for (int row = blockIdx.x * 8 + wave; row < MR; row += G * 8) {
        const float rs = row < MP ? row_rs16(SSQ, row) : rs_sample_full(SSQS, row - MP);
        float* yr = p.out + (size_t)row * DM;
#pragma unroll
        for (int q = 0; q < 4; ++q) {
            const int col = q * 256 + lane * 4;
            const u32x2 xw = row < MP ? *(const u32x2*)(X + (size_t)row * DM + col) : *(const u32x2*)(Xs + (size_t)(row - MP) * DM + col);
            const f32x4 gv = *(const f32x4*)(p.norm_final + col);
            f32x4 v; v[0] = bflo(xw.x); v[1] = bfhi(xw.x); v[2] = bflo(xw.y); v[3] = bfhi(xw.y);
            { const f32x4 y4 = v * gv * rs; u32x4 yb; __builtin_memcpy(&yb, &y4, 16); st_wt16(p.out, (unsigned)(((size_t)row * DM + col) * 4), yb); }
        }
    }
}

__global__ void __launch_bounds__(NTHR, 2) fwd_megakernel(Params p) {
    extern __shared__ __attribute__((aligned(16))) unsigned char smem[];
    LAS unsigned char* lds = (LAS unsigned char*)smem;
    cg::grid_group grid = cg::this_grid();
    const int G = gridDim.x;
    unsigned char* ws = p.ws;
    bf16_t* XG = (bf16_t*)(ws + WS_XG); float* SSQ = (float*)(ws + WS_SSQ);

    volatile LAS unsigned* st = (volatile LAS unsigned*)(lds + LDS_BYTES - 16);
    if (threadIdx.x < 4) st[threadIdx.x] = 0u;
    __syncthreads();
    const XcdBarrier bar = xcd_barrier_post((unsigned*)(ws + WS_BAR), st);
    float* SSQ2 = (float*)(ws + WS_SSQ2); bf16_t* HALO = (bf16_t*)(ws + WS_HALO);
    bf16_t* Xs_cur = XG + (size_t)MP * DM; bf16_t* Xs_alt = (bf16_t*)(ws + WS_XS2);
    float* SSQS_cur = (float*)(ws + WS_SSQS); float* SSQS_alt = (float*)(ws + WS_SSQS2);

    if (p.ws == nullptr) grid.sync();
    phase_prep(p, lds, G);
    xcd_barrier_arrive(bar); gap_convert(p, 0, lds, G); gap0_extras(p, lds, G); xcd_barrier_wait(bar);

    for (int ph = 0; ph < 16; ++ph) {
        const int q = ph & 7, layer = (ph >> 3) * 2 + (q >= 5 ? 1 : 0);
        const int kind = q < 5 ? q : (q == 5 ? 6 : q - 3);
        if (kind == 0) {
            const int e = layer >> 1;
            const bf16_t* Wt = (const bf16_t*)(ws + WS_WIN) + (size_t)e * DIN * DM;
            pg8::Gemm g{XG, Wt, MP, DIN, DM, DM, DM, 0};
            pg8::StaticOrder S; S.init(MP, DIN, G, (int)blockIdx.x);
            pg8::Unit u0; const int pm0 = S.next(0, u0) ? u0.pm : -1;
            if (pm0 >= 0) fill_rs_table(lds, SSQ, pm0);
            EpiE1 E{SSQ, (bf16_t*)(ws + WS_U), (float*)(ws + WS_VSSQ), lds, pm0};
            pg8::gemm_phase<EpiE1>(lds, g, S, E);
            SkE1 Es{SSQS_cur, (bf16_t*)(ws + WS_U), (float*)(ws + WS_VSSQS)};
            skinny_gemm_k1024<SkE1>(lds, Xs_cur, DM, Wt, DM, DIN, Es, G);
        } else if (kind == 1) {
            phase_e2(p, layer >> 1, lds, G);
        } else if (kind == 2) {
            const int e = layer >> 1;
            const bf16_t* Wt = (const bf16_t*)(ws + WS_WOUT) + (size_t)e * DM * DM;
            pg8::Gemm g{(const bf16_t*)(ws + WS_AB), Wt, MP, DM, DM, DM, DM, 0};
            pg8::StaticOrder S; S.init(MP, DM, G, (int)blockIdx.x);
            EpiRes E{XG, SSQ, nullptr, nullptr, lds, nullptr};
            pg8::gemm_phase<EpiRes>(lds, g, S, E);
            SkRes Es{Xs_cur, Xs_cur, SSQS_cur, nullptr, nullptr};
            skinny_gemm<4, 8, SkRes>(lds, (const bf16_t*)(ws + WS_AB) + (size_t)MP * DM, DM, 0, Wt, DM, DM, DM, Es, G);
        } else if (kind == 6) {
            const int o = layer >> 1;
            const bf16_t* Wt = (const bf16_t*)(ws + WS_WP) + (size_t)o * DM * 256;
            pg8::Gemm g{(const bf16_t*)(ws + WS_PA), Wt, MP, DM, 256, DM, 256, 256};
            pg8::StaticOrder S; S.init(MP, DM, G, (int)blockIdx.x);
            { pg8::Unit u0; if (S.next(0, u0)) pool_tile_prep(p, layer, u0.pm, u0.pn, lds); }
            EpiRes E{XG, SSQ2, p.pool_b + o * DM, p.pool_scale + o * DM, lds, nullptr};
            pg8::gemm_phase<EpiRes>(lds, g, S, E);
            SkRes Es{Xs_cur, Xs_alt, SSQS_alt, p.pool_b + o * DM, p.pool_scale + o * DM};
            skinny_pool<SkRes>(p, layer, Wt, Es, G, Xs_cur, SSQS_cur);
            { bf16_t* tx = Xs_cur; Xs_cur = Xs_alt; Xs_alt = tx; float* ts = SSQS_cur; SSQS_cur = SSQS_alt; SSQS_alt = ts; }
        } else if (kind == 3) {
            const bf16_t* Wt = (const bf16_t*)(ws + WS_W1) + (size_t)layer * DFF * DM;
            pg8::Gemm g{XG, Wt, MP, DFF, DM, DM, DM, 0};
            pg8::StaticOrder S; S.init(MP, DFF, G, (int)blockIdx.x);
            pg8::Unit u0; const int pm0 = S.next(0, u0) ? u0.pm : -1;
            const float* ssq_in = (layer & 1) ? SSQ2 : SSQ;
            if (pm0 >= 0) fill_rs_table(lds, ssq_in, pm0);
            EpiF1 E{ssq_in, (bf16_t*)(ws + WS_H), lds, pm0};
            pg8::gemm_phase<EpiF1>(lds, g, S, E);
            SkF1 Es{SSQS_cur, (bf16_t*)(ws + WS_H)};
            skinny_gemm_k1024<SkF1>(lds, Xs_cur, DM, Wt, DM, DFF, Es, G);
        } else {
            const bf16_t* Wt = (const bf16_t*)(ws + WS_W2) + (size_t)layer * DM * DFF;
            pg8::Gemm g{(const bf16_t*)(ws + WS_H), Wt, MP, DM, DFF, DFF, DFF, 0};
            pg8::StaticOrder S; S.init(MP, DM, G, (int)blockIdx.x);
            EpiRes E{XG, SSQ, nullptr, nullptr, lds, (layer & 1) ? nullptr : HALO};
            pg8::gemm_phase<EpiRes>(lds, g, S, E);
            SkRes Es{Xs_cur, Xs_cur, SSQS_cur, nullptr, nullptr};
            skinny_gemm_k4096<SkRes>(lds, (const bf16_t*)(ws + WS_H) + (size_t)MP * DFF, DFF, Wt, DFF, DM, Es, G);
        }
        xcd_barrier_arrive(bar); gap_convert(p, ph + 1, lds, G); xcd_barrier_wait(bar);
    }
    phase_final(p, G, Xs_cur, SSQS_cur);
}

extern "C" void kernel_launch(void* const* d_in, const int* in_sizes, int n_in, void* d_out, int out_size, void* d_ws, size_t ws_size, hipStream_t stream) {
    static int grid_blocks = 0;
    if (grid_blocks == 0) {
        if (n_in != 25 || (size_t)out_size != O_END || ws_size < WS_END) {
            fprintf(stderr, "kernel_launch: unexpected shapes: n_in %d out %d (want %zu) ws %zu (need %zu)\n", n_in, out_size, (size_t)O_END, ws_size, (size_t)WS_END);
            grid_blocks = -1; return;
        }
        int dev = 0, cus = 0, per_cu = 0;
        hipGetDevice(&dev);
        hipDeviceGetAttribute(&cus, hipDeviceAttributeMultiprocessorCount, dev);
        if (hipFuncSetAttribute((const void*)fwd_megakernel, hipFuncAttributeMaxDynamicSharedMemorySize, LDS_BYTES) != hipSuccess) { fprintf(stderr, "kernel_launch: hipFuncSetAttribute failed\n"); grid_blocks = -1; return; }
        if (hipOccupancyMaxActiveBlocksPerMultiprocessor(&per_cu, (const void*)fwd_megakernel, NTHR, LDS_BYTES) != hipSuccess || per_cu < 1) { fprintf(stderr, "kernel_launch: occupancy query failed (%d)\n", per_cu); (void)hipGetLastError(); per_cu = 1; }
        grid_blocks = cus * 1;
        if (grid_blocks != 256) { fprintf(stderr, "kernel_launch: this kernel is laid out for 256 CUs, found %d\n", cus); grid_blocks = -1; return; }
    }
    if (grid_blocks < 0) return;
    Params p{};
    const float** pp = (const float**)&p;
    for (int i = 0; i < 25; ++i) pp[i] = (const float*)d_in[i];
    p.out = (float*)d_out; p.ws = (unsigned char*)d_ws;
    if (hipMemsetAsync((char*)d_ws + WS_BAR, 0, 16384, stream) != hipSuccess) { fprintf(stderr, "kernel_launch: memset failed\n"); return; }
    void* args[] = {&p};
    hipError_t e = hipLaunchCooperativeKernel((const void*)fwd_megakernel, dim3(grid_blocks), dim3(NTHR), args, LDS_BYTES, stream);
    if (e != hipSuccess) fprintf(stderr, "cooperative launch failed: %s (grid %d)\n", hipGetErrorString(e), grid_blocks);
}
```

```cpp
#include <hip/hip_runtime.h>
#include <hip/hip_cooperative_groups.h>
#include <cstdio>
namespace cg = cooperative_groups;

#define LAS __attribute__((address_space(3)))
typedef unsigned short bf16_t;
typedef short bf16x8 __attribute__((ext_vector_type(8)));
typedef float f32x4 __attribute__((ext_vector_type(4)));
typedef float f32x2 __attribute__((ext_vector_type(2)));
typedef unsigned u32x4 __attribute__((ext_vector_type(4)));
typedef unsigned u32x2 __attribute__((ext_vector_type(2)));

constexpr int DM = 1024, NBATCH = 8, SEQ = 2048, MP = NBATCH * SEQ, MS = 128, MR = MP + MS, MPAD = 16640;
constexpr int DFF = 4096, WA = 512, WB = 512, DIN = 2048;
constexpr float EPS = 1e-6f;
constexpr int NTHR = 512;
constexpr int LDS_BYTES = 148 * 1024;

constexpr size_t O_YP = 0, O_YS = O_YP + (size_t)MP * DM, O_SGUV = O_YS + (size_t)MS * DM, O_CONVP = O_SGUV + 2 * MS * WA,
                 O_CONVS = O_CONVP + 2 * NBATCH * 3 * WB, O_HP = O_CONVS + 2 * MS * 3 * WB, O_HS = O_HP + 2 * NBATCH * WB,
                 O_POOLP = O_HS + 2 * MS * WB, O_POOLS = O_POOLP + 2 * NBATCH * 15 * DM, O_END = O_POOLS + (size_t)2 * MS * 15 * DM;

constexpr size_t WS_WIN = 0;
constexpr size_t WS_WOUT = WS_WIN + (size_t)2 * DIN * DM * 2;
constexpr size_t WS_W1 = WS_WOUT + (size_t)2 * DM * DM * 2;
constexpr size_t WS_W2 = WS_W1 + (size_t)4 * DFF * DM * 2;
constexpr size_t WS_WP = WS_W2 + (size_t)4 * DFF * DM * 2;
constexpr size_t WS_GW = WS_WP + (size_t)2 * DM * 256 * 2;
constexpr size_t WS_SW = WS_GW + (size_t)2 * 2 * 8 * 64 * 64 * 2;
constexpr size_t WS_SP = WS_SW + (size_t)2 * 8 * 128 * 128 * 2;
constexpr size_t WS_SSQ = WS_SP + 4096;
constexpr size_t WS_VSSQ = WS_SSQ + (size_t)MPAD * 16 * 4;
constexpr size_t WS_XG = WS_VSSQ + (size_t)MPAD * 8 * 4;
constexpr size_t WS_H = WS_XG + (size_t)MPAD * DM * 2;
constexpr size_t WS_U = WS_H, WS_VP = WS_U + (size_t)MPAD * 512 * 2, WS_GG = WS_VP + (size_t)MPAD * 512 * 2, WS_XB = WS_GG + (size_t)MPAD * 512 * 2,
                 WS_AB = WS_XB + (size_t)MPAD * 512 * 2, WS_PA = WS_H;
constexpr size_t WS_SSQS = WS_H + (size_t)MPAD * DFF * 2;
constexpr size_t WS_VSSQS = WS_SSQS + (size_t)MS * 64 * 4;
constexpr size_t WS_CG = WS_VSSQS + (size_t)MS * 32 * 4;
constexpr size_t WS_BAR = WS_CG + (size_t)2 * 1024 * 128 * 8;
constexpr size_t WS_SPSUM = WS_BAR + 16384;
constexpr size_t WS_SSQ2 = WS_SPSUM + (size_t)2 * MS * DM * 4;
constexpr size_t WS_HALO = WS_SSQ2 + (size_t)MPAD * 16 * 4;
constexpr size_t WS_XS2 = WS_HALO + (size_t)64 * 16 * DM * 2;
constexpr size_t WS_SSQS2 = WS_XS2 + (size_t)MS * DM * 2;
constexpr size_t WS_END = WS_SSQS2 + (size_t)MS * 64 * 4;

struct Params {
    const float *x_prompt, *x_sample, *state_conv, *state_rglru, *state_pool;
    const float *norm_mix, *norm_ffn, *norm_final, *w_in, *w_out, *v_norm, *sgu_w, *sgu_b;
    const float *conv_w, *conv_b, *gate_a_w, *gate_a_b, *gate_x_w, *gate_x_b, *lru_lambda;
    const float *pool_w, *pool_b, *pool_scale, *ffn_w1, *ffn_w2;
    float* out;
    unsigned char* ws;
};

__device__ __forceinline__ int opaque_tid() { int t = threadIdx.x; asm volatile("" : "+v"(t)); return t; }
__device__ __forceinline__ unsigned cvt_pk_bf16(float lo, float hi) { unsigned r; asm volatile("v_cvt_pk_bf16_f32 %0, %1, %2" : "=v"(r) : "v"(lo), "v"(hi)); return r; }
__device__ __forceinline__ float bf2f(unsigned short b) { return __uint_as_float(((unsigned)b) << 16); }
__device__ __forceinline__ float bflo(unsigned w) { return __uint_as_float(w << 16); }
__device__ __forceinline__ float bfhi(unsigned w) { return __uint_as_float(w & 0xffff0000u); }
__device__ __forceinline__ unsigned short f2bf(float f) { return (unsigned short)(cvt_pk_bf16(f, 0.f) & 0xffffu); }
__device__ __forceinline__ void bf8_to_f32(u32x4 w, f32x4& lo, f32x4& hi) {
    lo[0] = bflo(w.x); lo[1] = bfhi(w.x); lo[2] = bflo(w.y); lo[3] = bfhi(w.y);
    hi[0] = bflo(w.z); hi[1] = bfhi(w.z); hi[2] = bflo(w.w); hi[3] = bfhi(w.w);
}
__device__ __forceinline__ void st_wt16(void* base, unsigned off, u32x4 v) { const __amdgpu_buffer_rsrc_t rs = __builtin_amdgcn_make_buffer_rsrc(base, 0, 0x7fffffff, 0x00020000); __builtin_amdgcn_raw_buffer_store_b128(v, rs, off, 0, 16); }
__device__ __forceinline__ void st_wt8(void* base, unsigned off, u32x2 v) { const __amdgpu_buffer_rsrc_t rs = __builtin_amdgcn_make_buffer_rsrc(base, 0, 0x7fffffff, 0x00020000); __builtin_amdgcn_raw_buffer_store_b64(v, rs, off, 0, 16); }
__device__ __forceinline__ float gelu_t(float x) {
    const float z = x * (0.7978845608f + 0.0356774081f * x * x);
    const float e = __builtin_amdgcn_exp2f(z * 2.885390082f);
    return x - x * __builtin_amdgcn_rcpf(e + 1.0f);
}
__device__ __forceinline__ f32x2 gelu_t2(f32x2 x) {
    const f32x2 t = x * x;
    const f32x2 u = t * 0.1029432397f + 2.302208198f;
    const f32x2 a = x * u;
    f32x2 e; e.x = __builtin_amdgcn_exp2f(a.x); e.y = __builtin_amdgcn_exp2f(a.y);
    const f32x2 d = e + 1.0f;
    f32x2 r; r.x = __builtin_amdgcn_rcpf(d.x); r.y = __builtin_amdgcn_rcpf(d.y);
    return x - x * r;
}
__device__ __forceinline__ float sigmoid_f(float x) { return __builtin_amdgcn_rcpf(1.0f + __builtin_amdgcn_exp2f(-1.442695041f * x)); }
__device__ __forceinline__ float row_rs16(const float* ssq, int row) {
    const f32x4* q = (const f32x4*)(ssq + (size_t)row * 16);
    const f32x4 a = q[0], b = q[1], c = q[2], d = q[3];
    const float s = (a[0] + a[1] + a[2] + a[3]) + (b[0] + b[1] + b[2] + b[3]) + (c[0] + c[1] + c[2] + c[3]) + (d[0] + d[1] + d[2] + d[3]);
    return __builtin_amdgcn_rsqf(s * (1.0f / 1024.0f) + EPS);
}
__device__ __forceinline__ float row_rs8(const float* vssq, int row) {
    const f32x4* q = (const f32x4*)(vssq + (size_t)row * 8);
    const f32x4 a = q[0], b = q[1];
    const float s = (a[0] + a[1] + a[2] + a[3]) + (b[0] + b[1] + b[2] + b[3]);
    return __builtin_amdgcn_rsqf(s * (1.0f / 512.0f) + EPS);
}


__device__ __forceinline__ float rs_sample_q(const float* ssqs, int r, int fq) {
    const f32x4* q = (const f32x4*)(ssqs + (size_t)r * 64 + fq * 16);
    const f32x4 a = q[0], b = q[1], c = q[2], d = q[3];
    float s = (a[0] + a[1] + a[2] + a[3]) + (b[0] + b[1] + b[2] + b[3]) + (c[0] + c[1] + c[2] + c[3]) + (d[0] + d[1] + d[2] + d[3]);
    s += __shfl_xor(s, 16); s += __shfl_xor(s, 32);
    return __builtin_amdgcn_rsqf(s * (1.0f / 1024.0f) + EPS);
}
__device__ __forceinline__ float rs_sample_full(const float* ssqs, int r) {
    float s = 0.f;
#pragma unroll
    for (int i = 0; i < 16; ++i) { const f32x4 a = *(const f32x4*)(ssqs + (size_t)r * 64 + i * 4); s += (a[0] + a[1]) + (a[2] + a[3]); }
    return __builtin_amdgcn_rsqf(s * (1.0f / 1024.0f) + EPS);
}
__device__ __forceinline__ float rsv_sample_full(const float* vssqs, int r) {
    float s = 0.f;
#pragma unroll
    for (int i = 0; i < 8; ++i) { const f32x4 a = *(const f32x4*)(vssqs + (size_t)r * 32 + i * 4); s += (a[0] + a[1]) + (a[2] + a[3]); }
    return __builtin_amdgcn_rsqf(s * (1.0f / 512.0f) + EPS);
}

#define XB_TMO      128
#define XB_XCNT(j)  (256  + 64 * (j))
#define XB_XSUB(j)  (1280 + 64 * (j))
#define XB_XGEN(j)  (2304 + 64 * (j))
#define XB_TOP      3328
#define XB_TOPGEN   3392
#define XCD_BAR_WORDS 3456
#define XB_SPIN_CAP (1u << 22)
__device__ __forceinline__ unsigned xb_ld(unsigned* p)              { return __hip_atomic_load(p, __ATOMIC_RELAXED, __HIP_MEMORY_SCOPE_AGENT); }
__device__ __forceinline__ unsigned xb_add(unsigned* p, unsigned v) { return __hip_atomic_fetch_add(p, v, __ATOMIC_RELAXED, __HIP_MEMORY_SCOPE_AGENT); }
__device__ __forceinline__ unsigned xb_xcc_id() { return (unsigned)__builtin_amdgcn_s_getreg((3 << 11) | 20) & 0xFu; }
#define XB_SPIN(cond, bar) do { unsigned _sp = 0; while (cond) { __builtin_amdgcn_s_sleep(1); \
    if ((++_sp & 255u) == 0u) { if (xb_ld(&(bar)[XB_TMO])) break; if (_sp > XB_SPIN_CAP) { atomicAdd(&(bar)[XB_TMO], 1u); break; } } } } while (0)
struct XcdBarrier { unsigned* bar; unsigned x; volatile LAS unsigned* st; };
__device__ __forceinline__ XcdBarrier xcd_barrier_post(unsigned* bar, volatile LAS unsigned* st) {
    XcdBarrier b; b.bar = bar; b.x = xb_xcc_id(); b.st = st;
    if (threadIdx.x == 0) (void)xb_add(&bar[XB_XCNT(b.x)], 1u);
    return b;
}
__device__ __forceinline__ void xcd_barrier_complete(unsigned* bar, unsigned x, unsigned& nloc, unsigned& nx) {
    const unsigned G = gridDim.x * gridDim.y * gridDim.z;
    unsigned sum, cnt, mine, sp = 0u;
    for (;;) {
        sum = 0u; cnt = 0u; mine = 0u;
#pragma unroll
        for (unsigned j = 0; j < 16; ++j) { const unsigned c = xb_ld(&bar[XB_XCNT(j)]); sum += c; cnt += (c > 0u) ? 1u : 0u; mine = (j == x) ? c : mine; }
        if (sum == G) break;
        __builtin_amdgcn_s_sleep(1);
        if ((++sp & 255u) == 0u) { if (xb_ld(&bar[XB_TMO])) break; if (sp > XB_SPIN_CAP) { atomicAdd(&bar[XB_TMO], 1u); break; } }
    }
    nloc = mine > 0u ? mine : 1u; nx = cnt > 0u ? cnt : 1u;
}
__device__ __forceinline__ void xcd_barrier_arrive(const XcdBarrier& b) {
    asm volatile("s_waitcnt vmcnt(0)" ::: "memory");
    __syncthreads();
    if (threadIdx.x == 0) {
        unsigned* bar = b.bar;
        __builtin_amdgcn_s_waitcnt(0);
        unsigned nloc = b.st[0], nx = b.st[1];
        if (nloc == 0u) { xcd_barrier_complete(bar, b.x, nloc, nx); b.st[0] = nloc; b.st[1] = nx; }
        const unsigned old = xb_add(&bar[XB_XSUB(b.x)], 1u);
        const unsigned gen = old / nloc;
        unsigned leader = 0u, tg = 0u, lastx = 0u;
        if (old + 1u == (gen + 1u) * nloc) {
            leader = 1u;
            __builtin_amdgcn_fence(__ATOMIC_RELEASE, "agent");
            asm volatile("s_waitcnt vmcnt(0)" ::: "memory");
            const unsigned og = xb_add(&bar[XB_TOP], 1u);
            tg = og / nx;
            if (og + 1u == (tg + 1u) * nx) { xb_add(&bar[XB_TOPGEN], 1u); lastx = 1u; }
        }
        b.st[2] = gen * 2u + leader; b.st[3] = tg * 2u + lastx;
    }
}
__device__ __forceinline__ void xcd_barrier_wait(const XcdBarrier& b) {
    if (threadIdx.x == 0) {
        unsigned* bar = b.bar;
        const unsigned s2 = b.st[2], s3 = b.st[3];
        const unsigned gen = s2 >> 1, leader = s2 & 1u, tg = s3 >> 1, lastx = s3 & 1u;
        if (leader) {
            if (!lastx) XB_SPIN(xb_ld(&bar[XB_TOPGEN]) == tg, bar);
            __builtin_amdgcn_fence(__ATOMIC_ACQUIRE, "agent");
            xb_add(&bar[XB_XGEN(b.x)], 1u);
            asm volatile("s_waitcnt vmcnt(0)" ::: "memory");
        } else {
            XB_SPIN(xb_ld(&bar[XB_XGEN(b.x)]) == gen, bar);
            __builtin_amdgcn_fence(__ATOMIC_ACQUIRE, "agent");
            asm volatile("s_waitcnt vmcnt(0)" ::: "memory");
        }
    }
    __syncthreads();
}

namespace pg8 {
constexpr int BM = 256, BK = 64, HALF = 128, HTB = HALF * BK * 2, STAGE_BYTES = 8 * HTB, NXCD = 8, WGM = 8;
__host__ __device__ __forceinline__ int lds_byte(int r, int c) { const int st = (r >> 4) * 2 + (c >> 5), rr = r & 15, cc = c & 31, ob = rr * 64 + cc * 2; return st * 1024 + (ob ^ (((ob >> 9) & 1) << 5)); }
__host__ __device__ __forceinline__ int perm32(int rho) { const int n = rho >> 4, i = rho & 15; return 8 * (i >> 2) + 4 * n + (i & 3); }
__host__ __device__ __forceinline__ void stage_rc(int b, int& R, int& C) { const int st = b / 1024, sb = b % 1024, swz = sb ^ (((sb >> 9) & 1) << 5); R = (st >> 1) * 16 + swz / 64; C = (st & 1) * 32 + (swz % 64) / 2; }

struct Unit { int pm, pn; };
struct Gemm { const bf16_t* A; const bf16_t* Bt; int M, N, K, lda, ldb, a_pn_koff; };

struct StaticOrder {
    int nM, nN, nwg, G, c;
    __device__ void init(int M, int N, int G_, int c_) { nM = M / BM; nN = N / BM; nwg = nM * nN; G = G_; c = c_; }
    __device__ bool next(int i, Unit& u) const {
        const long L = (long)i * G + c; if (L >= nwg) return false;
        int wgid = (int)L; { const int q = nwg / NXCD, r = nwg % NXCD, xcd = wgid % NXCD, off = wgid / NXCD; wgid = (xcd < r ? xcd * (q + 1) : r * (q + 1) + (xcd - r) * q) + off; }
        const int nig = WGM * nN, gid = wgid / nig, fm = gid * WGM, gsz = (nM - fm) < WGM ? (nM - fm) : WGM;
        u.pm = fm + ((wgid % nig) % gsz); u.pn = (wgid % nig) / gsz; return true;
    }
};

constexpr int RS_TAB_OFF = 131072, WT_OFF = 132096, WT_BYTES = 16 * 144;
constexpr int RS_TAB_OFF_UNUSED = 0;
__device__ __forceinline__ f32x4 zero4_b64() {
    f32x2 a, b; asm volatile("v_mov_b64 %0, 0" : "=v"(a)); asm volatile("v_mov_b64 %0, 0" : "=v"(b));
    return (f32x4){a.x, a.y, b.x, b.y};
}
template <class Epi>
__device__ __forceinline__ void gemm_phase(LAS unsigned char* lds, const Gemm g, const StaticOrder& S, const Epi& E) {
    const int tid = opaque_tid(), wid = __builtin_amdgcn_readfirstlane(tid >> 6), lane = tid & 63, wr = wid >> 2, wc = wid & 3, fr = lane & 15, fq = lane >> 4;
    const int K = g.K, nt = K / BK;
    unsigned voffA[2], voffB[2];
#pragma unroll
    for (int i = 0; i < 2; ++i) { int R, C; stage_rc(tid * 16 + i * 8192, R, C);
        const int Rb = 64 * (R >> 5) + 16 * ((R >> 2) & 3) + 4 * ((R >> 4) & 1) + (R & 3);
        voffA[i] = (unsigned)(R * g.lda + C) * 2u; voffB[i] = (unsigned)(Rb * g.ldb + C) * 2u; }
    const size_t kstep = (size_t)(BK * 2);
    const size_t hstepA = (size_t)HALF * g.lda * 2, hstepB = (size_t)8 * g.ldb * 2;
    const size_t tstepA = 2 * hstepA, tstepB = (size_t)BM * g.ldb * 2;
    const size_t pnoffA = (size_t)g.a_pn_koff * 2;
    const unsigned ldsw = (unsigned)wid * 1024u;
    const int aoff = lds_byte(wr * 64 + fr, fq * 8), boff = lds_byte(wc * 32 + fr, fq * 8);
#define PG8_SA(b, h) (((b) * 2 + (h)) * HTB)
#define PG8_SB(b, h) ((4 + (b) * 2 + (h)) * HTB)
#define PG8_STAGE(bufoff, gbase, voff) do { _Pragma("unroll") for (int _i = 0; _i < 2; ++_i) \
        __builtin_amdgcn_global_load_lds((const unsigned*)((const char*)(gbase) + (voff)[_i]), (LAS unsigned*)(lds + (bufoff) + ldsw + _i * 8192), 16, 0, 0); } while (0)
#define PG8_LDA(dst, b, h) do { _Pragma("unroll") for (int m = 0; m < 4; ++m) _Pragma("unroll") for (int k = 0; k < 2; ++k) dst[m][k] = *(const LAS bf16x8*)(lds + PG8_SA(b, h) + aoff + m * 2048 + k * 1024); } while (0)
#define PG8_LDB(dst, b, h) do { _Pragma("unroll") for (int n = 0; n < 2; ++n) _Pragma("unroll") for (int k = 0; k < 2; ++k) dst[n][k] = *(const LAS bf16x8*)(lds + PG8_SB(b, h) + boff + n * 2048 + k * 1024); } while (0)
#define PG8_MMA(ai, bj, At, Bt) do { __builtin_amdgcn_s_setprio(1); _Pragma("unroll") for (int m = 0; m < 4; ++m) _Pragma("unroll") for (int n = 0; n < 2; ++n) _Pragma("unroll") for (int k = 0; k < 2; ++k) \
        acc[ai][bj][m][n] = __builtin_amdgcn_mfma_f32_16x16x32_bf16(Bt[n][k], At[m][k], acc[ai][bj][m][n], 0, 0, 0); __builtin_amdgcn_s_setprio(0); } while (0)
#define PG8_WAIT_V(n) asm volatile("s_waitcnt vmcnt(" #n ")" ::: "memory")
#define PG8_WAIT_L(n) asm volatile("s_waitcnt lgkmcnt(" #n ")" ::: "memory")
#define PG8_BAR __builtin_amdgcn_s_barrier()
#define PG8_SCHED __builtin_amdgcn_sched_barrier(0)
    Unit cur, nxt; int ui = 0;
    if (!S.next(0, cur)) return;
    f32x4 acc[2][2][4][2];
#pragma unroll
    for (int a = 0; a < 2; ++a)
#pragma unroll
        for (int b = 0; b < 2; ++b)
#pragma unroll
            for (int m = 0; m < 4; ++m)
#pragma unroll
                for (int n = 0; n < 2; ++n) acc[a][b][m][n] = zero4_b64();
    bf16x8 At[4][2], B0[2][2], B1[2][2];
    const char* cA = (const char*)g.A + (size_t)cur.pm * tstepA + (size_t)cur.pn * pnoffA; const char* cB = (const char*)g.Bt + (size_t)cur.pn * tstepB;
    PG8_STAGE(PG8_SB(0, 0), cB, voffB); PG8_STAGE(PG8_SA(0, 0), cA, voffA); PG8_STAGE(PG8_SB(0, 1), cB + hstepB, voffB); PG8_STAGE(PG8_SA(0, 1), cA + hstepA, voffA);
    if (wr == 1) PG8_BAR;
    PG8_WAIT_V(4); PG8_BAR;
    PG8_STAGE(PG8_SB(1, 0), cB + kstep, voffB); PG8_STAGE(PG8_SA(1, 0), cA + kstep, voffA); PG8_STAGE(PG8_SB(1, 1), cB + hstepB + kstep, voffB);
    PG8_WAIT_V(6); PG8_BAR;
    for (;;) {
        const bool has_next = S.next(ui + 1, nxt);
        const char* nA = has_next ? (const char*)g.A + (size_t)nxt.pm * tstepA + (size_t)nxt.pn * pnoffA : cA; const char* nB = has_next ? (const char*)g.Bt + (size_t)nxt.pn * tstepB : cB;
        for (int t = 0; t < nt; t += 2) {
            const bool last = (t == nt - 2);
            const char* a1 = cA + (size_t)(t + 1) * kstep;
            const char* a2 = last ? nA : cA + (size_t)(t + 2) * kstep; const char* b2 = last ? nB : cB + (size_t)(t + 2) * kstep;
            const char* a3 = a2 + kstep; const char* b3 = b2 + kstep;
            PG8_LDB(B0, 0, 0); PG8_SCHED; PG8_LDA(At, 0, 0); PG8_STAGE(PG8_SA(1, 1), a1 + hstepA, voffA);
            PG8_WAIT_L(8); PG8_BAR; PG8_WAIT_L(0); PG8_MMA(0, 0, At, B0); PG8_BAR; PG8_SCHED;
            PG8_LDB(B1, 0, 1); PG8_STAGE(PG8_SB(0, 0), b2, voffB);
            PG8_BAR; PG8_WAIT_L(0); PG8_MMA(0, 1, At, B1); PG8_BAR;
            PG8_LDA(At, 0, 1); PG8_STAGE(PG8_SA(0, 0), a2, voffA);
            PG8_BAR; PG8_WAIT_L(0); PG8_MMA(1, 0, At, B0); PG8_BAR; PG8_SCHED;
            PG8_STAGE(PG8_SB(0, 1), b2 + hstepB, voffB);
            PG8_WAIT_V(6); PG8_BAR; PG8_MMA(1, 1, At, B1); PG8_BAR;
            PG8_LDB(B0, 1, 0); PG8_SCHED; PG8_LDA(At, 1, 0); PG8_STAGE(PG8_SA(0, 1), a2 + hstepA, voffA);
            PG8_WAIT_L(8); PG8_BAR; PG8_WAIT_L(0); PG8_MMA(0, 0, At, B0); PG8_BAR; PG8_SCHED;
            PG8_LDB(B1, 1, 1); PG8_STAGE(PG8_SB(1, 0), b3, voffB);
            PG8_BAR; PG8_WAIT_L(0); PG8_MMA(0, 1, At, B1); PG8_BAR;
            PG8_LDA(At, 1, 1); PG8_STAGE(PG8_SA(1, 0), a3, voffA);
            PG8_BAR; PG8_WAIT_L(0); PG8_MMA(1, 0, At, B0); PG8_BAR; PG8_SCHED;
            PG8_STAGE(PG8_SB(1, 1), b3 + hstepB, voffB);
            PG8_WAIT_V(6); PG8_BAR; PG8_MMA(1, 1, At, B1); PG8_BAR;
        }
        E(acc, cur, wr, wc, fr, fq);
        if (!has_next) break;
#pragma unroll
        for (int a = 0; a < 2; ++a)
#pragma unroll
            for (int b = 0; b < 2; ++b)
#pragma unroll
                for (int m = 0; m < 4; ++m)
#pragma unroll
                    for (int n = 0; n < 2; ++n) acc[a][b][m][n] = zero4_b64();
        cur = nxt; cA = nA; cB = nB; ++ui;
    }
    PG8_WAIT_V(0);
    if (wr == 0) PG8_BAR;
    PG8_BAR;
#undef PG8_SA
#undef PG8_SB
#undef PG8_STAGE
#undef PG8_LDA
#undef PG8_LDB
#undef PG8_MMA
#undef PG8_WAIT_V
#undef PG8_WAIT_L
#undef PG8_BAR
#undef PG8_SCHED
}
}

__device__ __forceinline__ void store_bf4(bf16_t* p, f32x4 v) { u32x2 w; w.x = cvt_pk_bf16(v[0], v[1]); w.y = cvt_pk_bf16(v[2], v[3]); *(u32x2*)p = w; }
__device__ __forceinline__ u32x4 pack_bf8(f32x4 a, f32x4 b) { u32x4 w; w.x = cvt_pk_bf16(a[0], a[1]); w.y = cvt_pk_bf16(a[2], a[3]); w.z = cvt_pk_bf16(b[0], b[1]); w.w = cvt_pk_bf16(b[2], b[3]); return w; }
__device__ __forceinline__ void wave_store_lines(LAS unsigned char* wbuf, bf16_t* g0, size_t ld, u32x4 w0, u32x4 w1, int lane) {
    const int fr = lane & 15, fq = lane >> 4;
    *(LAS u32x4*)(wbuf + fr * 144 + fq * 32) = w0; *(LAS u32x4*)(wbuf + fr * 144 + fq * 32 + 16) = w1;
    asm volatile("s_waitcnt lgkmcnt(0)" ::: "memory");
#pragma unroll
    for (int i = 0; i < 2; ++i) { const int row = 8 * i + (lane >> 3); const u32x4 t = *(const LAS u32x4*)(wbuf + row * 144 + (lane & 7) * 16); *(u32x4*)(g0 + (size_t)row * ld + (lane & 7) * 8) = t; }
    asm volatile("" ::: "memory");
}
__device__ __forceinline__ void wave_load_lines(LAS unsigned char* wbuf, const bf16_t* g0, size_t ld, u32x4& w0, u32x4& w1, int lane) {
    const int fr = lane & 15, fq = lane >> 4;
    u32x4 t[2];
#pragma unroll
    for (int i = 0; i < 2; ++i) t[i] = *(const u32x4*)(g0 + (size_t)(8 * i + (lane >> 3)) * ld + (lane & 7) * 8);
#pragma unroll
    for (int i = 0; i < 2; ++i) *(LAS u32x4*)(wbuf + (8 * i + (lane >> 3)) * 144 + (lane & 7) * 16) = t[i];
    asm volatile("s_waitcnt lgkmcnt(0)" ::: "memory");
    w0 = *(const LAS u32x4*)(wbuf + fr * 144 + fq * 32); w1 = *(const LAS u32x4*)(wbuf + fr * 144 + fq * 32 + 16);
    asm volatile("s_waitcnt lgkmcnt(0)" ::: "memory");
}
template <bool WT>
__device__ __forceinline__ void wave_store_lines_u(LAS unsigned char* wl, LAS unsigned char* rl, char* gbase, unsigned off0, unsigned off1, u32x4 w0, u32x4 w1) {
    *(LAS u32x4*)(wl) = w0; *(LAS u32x4*)(wl + 16) = w1;
    asm volatile("" ::: "memory");
    const u32x4 t0 = *(const LAS u32x4*)(rl), t1 = *(const LAS u32x4*)(rl + 8 * 144);
    asm volatile("" ::: "memory");
    {
        const __amdgpu_buffer_rsrc_t rs = __builtin_amdgcn_make_buffer_rsrc((void*)gbase, 0, 0x7fffffff, 0x00020000);
        if constexpr (WT) { __builtin_amdgcn_raw_buffer_store_b128(t0, rs, off0, 0, 16); __builtin_amdgcn_raw_buffer_store_b128(t1, rs, off1, 0, 16); }
        else { __builtin_amdgcn_raw_buffer_store_b128(t0, rs, off0, 0, 0); __builtin_amdgcn_raw_buffer_store_b128(t1, rs, off1, 0, 0); }
    }
}
__device__ __forceinline__ float unit_rs(LAS unsigned char* lds, const float* ssq, int pm0, int pm, int lr) {
    return *(const LAS float*)(lds + pg8::RS_TAB_OFF + lr * 4);
}
__device__ __forceinline__ void fill_rs_table(LAS unsigned char* lds, const float* ssq, int pm0) {
    const int t = opaque_tid();
    if (t < 256) *(LAS float*)(lds + pg8::RS_TAB_OFF + t * 4) = row_rs16(ssq, pm0 * 256 + t);
    __syncthreads();
}

struct EpiE1 {
    const float* ssq; bf16_t* U; float* vssq; LAS unsigned char* lds; int pm0;
    __device__ __forceinline__ void operator()(const f32x4 (&acc)[2][2][4][2], const pg8::Unit& u, int wr, int wc, int fr_, int fq_) const {
        int lane_o = fq_ * 16 + fr_; asm volatile("" : "+v"(lane_o));
        const int fr = lane_o & 15, fq = lane_o >> 4;
        const int sec = u.pn >> 1, lane = lane_o;
        bf16_t* dst = U + (size_t)sec * ((size_t)MPAD * 512) + (u.pn & 1) * 256 + wc * 64;
        LAS unsigned char* wbuf = lds + pg8::WT_OFF + (wr * 4 + wc) * pg8::WT_BYTES;
        LAS unsigned char* wl = wbuf + fr * 144 + fq * 32; LAS unsigned char* rl = wbuf + (lane >> 3) * 144 + (lane & 7) * 16;
        const unsigned off0 = (unsigned)(lane >> 3) * (512 * 2) + (lane & 7) * 16, off1 = off0 + 8u * (512 * 2);
#pragma unroll
        for (int ai = 0; ai < 2; ++ai) {
#pragma unroll
            for (int m = 0; m < 4; ++m) {
                const int lr = ai * 128 + wr * 64 + m * 16 + fr, row = u.pm * 256 + lr;
                const float rs = unit_rs(lds, ssq, pm0, u.pm, lr);
                float sq = 0.f;
                u32x4 w[2];
#pragma unroll
                for (int bj = 0; bj < 2; ++bj) {
                    f32x4 v0 = acc[ai][bj][m][0] * rs, v1 = acc[ai][bj][m][1] * rs;
                    if (sec != 3) {
                        const f32x2 g0 = gelu_t2((f32x2){v0[0], v0[1]}), g1 = gelu_t2((f32x2){v0[2], v0[3]}), g2 = gelu_t2((f32x2){v1[0], v1[1]}), g3 = gelu_t2((f32x2){v1[2], v1[3]});
                        v0 = (f32x4){g0.x, g0.y, g1.x, g1.y}; v1 = (f32x4){g2.x, g2.y, g3.x, g3.y};
                    }
                    sq += v0[0] * v0[0] + v0[1] * v0[1] + v0[2] * v0[2] + v0[3] * v0[3] + v1[0] * v1[0] + v1[1] * v1[1] + v1[2] * v1[2] + v1[3] * v1[3];
                    w[bj] = pack_bf8(v0, v1);
                }
                wave_store_lines_u<true>(wl, rl, (char*)(dst + (size_t)(u.pm * 256 + ai * 128 + wr * 64 + m * 16) * 512), off0, off1, w[0], w[1]);
                if (sec == 1) {
                    sq += __shfl_xor(sq, 16); sq += __shfl_xor(sq, 32);
                    if (fq == 0) vssq[(size_t)row * 8 + (u.pn & 1) * 4 + wc] = sq;
                }
            }
        }
    }
};

struct EpiF1 {
    const float* ssq; bf16_t* H; LAS unsigned char* lds; int pm0;
    __device__ __forceinline__ void operator()(const f32x4 (&acc)[2][2][4][2], const pg8::Unit& u, int wr, int wc, int fr_, int fq_) const {
        int lane_o = fq_ * 16 + fr_; asm volatile("" : "+v"(lane_o));
        const int fr = lane_o & 15, fq = lane_o >> 4;
        const int lane = lane_o;
        bf16_t* dst = H + u.pn * 256 + wc * 64;
        LAS unsigned char* wbuf = lds + pg8::WT_OFF + (wr * 4 + wc) * pg8::WT_BYTES;
        LAS unsigned char* wl = wbuf + fr * 144 + fq * 32; LAS unsigned char* rl = wbuf + (lane >> 3) * 144 + (lane & 7) * 16;
        const unsigned off0 = (unsigned)(lane >> 3) * (DFF * 2) + (lane & 7) * 16, off1 = off0 + 8u * (DFF * 2);
#pragma unroll
        for (int ai = 0; ai < 2; ++ai) {
#pragma unroll
            for (int m = 0; m < 4; ++m) {
                const int lr = ai * 128 + wr * 64 + m * 16 + fr;
                const float rs = unit_rs(lds, ssq, pm0, u.pm, lr);
                u32x4 w[2];
#pragma unroll
                for (int bj = 0; bj < 2; ++bj) {
                    f32x4 v0 = acc[ai][bj][m][0] * rs, v1 = acc[ai][bj][m][1] * rs;
#pragma unroll
                    for (int j = 0; j < 4; ++j) { v0[j] = fmaxf(v0[j], 0.f); v1[j] = fmaxf(v1[j], 0.f); }
                    v0 = v0 * v0; v1 = v1 * v1;
                    w[bj] = pack_bf8(v0, v1);
                }
                wave_store_lines_u<true>(wl, rl, (char*)(dst + (size_t)(u.pm * 256 + ai * 128 + wr * 64 + m * 16) * DFF), off0, off1, w[0], w[1]);
            }
        }
    }
};

struct EpiRes {
    bf16_t* X; float* ssq; const float* bias; const float* cscale; LAS unsigned char* lds; bf16_t* halo;
    __device__ __forceinline__ void operator()(const f32x4 (&acc)[2][2][4][2], const pg8::Unit& u, int wr, int wc, int fr_, int fq_) const {
        int lane_o = fq_ * 16 + fr_; asm volatile("" : "+v"(lane_o));
        const int fr = lane_o & 15, fq = lane_o >> 4;
        const int lane = lane_o;
        const int colw = u.pn * 256 + wc * 64;
        LAS unsigned char* wbuf = lds + pg8::WT_OFF + (wr * 4 + wc) * pg8::WT_BYTES;
        LAS unsigned char* wl = wbuf + fr * 144 + fq * 32; LAS unsigned char* rl = wbuf + (lane >> 3) * 144 + (lane & 7) * 16;
        const unsigned off0 = (unsigned)(lane >> 3) * (DM * 2) + (lane & 7) * 16, off1 = off0 + 8u * (DM * 2);
        f32x4 bv[2][2], cv[2][2];
#pragma unroll
        for (int bj = 0; bj < 2; ++bj)
#pragma unroll
            for (int hh = 0; hh < 2; ++hh) {
                const int col = colw + 16 * fq + 8 * bj + 4 * hh;
                bv[bj][hh] = bias ? *(const f32x4*)(bias + col) : (f32x4){0.f, 0.f, 0.f, 0.f};
                cv[bj][hh] = bias ? *(const f32x4*)(cscale + col) : (f32x4){1.f, 1.f, 1.f, 1.f};
            }
#pragma unroll
        for (int ai = 0; ai < 2; ++ai) {
            u32x4 t[4][2];
#pragma unroll
            for (int m = 0; m < 4; ++m) {
                const char* xg0 = (const char*)(X + (size_t)(u.pm * 256 + ai * 128 + wr * 64 + m * 16) * DM + colw);
                t[m][0] = *(const u32x4*)(xg0 + off0); t[m][1] = *(const u32x4*)(xg0 + off1);
            }
#pragma unroll
            for (int m = 0; m < 4; ++m) {
                const int row = u.pm * 256 + ai * 128 + wr * 64 + m * 16 + fr;
                char* xg0 = (char*)(X + (size_t)(u.pm * 256 + ai * 128 + wr * 64 + m * 16) * DM + colw);
                u32x4 xw[2];
                *(LAS u32x4*)(rl) = t[m][0]; *(LAS u32x4*)(rl + 8 * 144) = t[m][1];
                asm volatile("" ::: "memory");
                xw[0] = *(const LAS u32x4*)(wl); xw[1] = *(const LAS u32x4*)(wl + 16);
                asm volatile("" ::: "memory");
                float sq = 0.f;
                u32x4 w[2];
#pragma unroll
                for (int bj = 0; bj < 2; ++bj) {
                    const int col = colw + 16 * fq + 8 * bj;
                    f32x4 v0 = acc[ai][bj][m][0], v1 = acc[ai][bj][m][1];
                    if (bias) { v0 = (v0 + bv[bj][0]) * cv[bj][0]; v1 = (v1 + bv[bj][1]) * cv[bj][1]; }
                    f32x4 x0, x1; bf8_to_f32(xw[bj], x0, x1);
                    v0 = v0 + x0; v1 = v1 + x1;
                    sq += v0[0] * v0[0] + v0[1] * v0[1] + v0[2] * v0[2] + v0[3] * v0[3] + v1[0] * v1[0] + v1[1] * v1[1] + v1[2] * v1[2] + v1[3] * v1[3];
                    w[bj] = pack_bf8(v0, v1);
                }
                wave_store_lines_u<false>(wl, rl, xg0, off0, off1, w[0], w[1]);
                if (halo && ai == 1 && m == 3 && wr == 1) wave_store_lines_u<false>(wl, rl, (char*)(halo + (size_t)(u.pm * 16) * DM + colw), off0, off1, w[0], w[1]);
                sq += __shfl_xor(sq, 16); sq += __shfl_xor(sq, 32);
                if (fq == 0) ssq[(size_t)row * 16 + u.pn * 4 + wc] = sq;
            }
        }
    }
};

template <int KSPLIT, int STEPS, class Epi>
__device__ __forceinline__ void skinny_gemm(LAS unsigned char* lds, const bf16_t* A, int lda, int a_grp_koff, const bf16_t* Bt, int ldb, int N, int K, const Epi& E, int G) {
    const int tid = opaque_tid(), wave = tid >> 6, lane = tid & 63, fr = lane & 15, fq = lane >> 4;
    const int ntile = 8 * (N >> 4);
    constexpr int TPB = 8 / KSPLIT;
    const int klen = K / KSPLIT;
    for (int t0 = blockIdx.x * TPB; t0 < ntile; t0 += G * TPB) {
        const int tile = t0 + wave / KSPLIT, ks = wave % KSPLIT;
        const int rt = tile & 7, ct = tile >> 3;
        const bf16_t* ap = A + (size_t)(rt * 16 + fr) * lda + (ct >> 4) * a_grp_koff + ks * klen + fq * 8;
        const bf16_t* bp = Bt + (size_t)(ct * 16 + fr) * ldb + ks * klen + fq * 8;
        f32x2 pp = (f32x2){0.f, 0.f};
        if (ks == 0) pp = E.pre(rt * 16 + fr, ct * 16 + fq * 4, fq);
        f32x4 acc = (f32x4){0.f, 0.f, 0.f, 0.f};
        const int krot = (int)(((unsigned)(wave * 5 + (int)blockIdx.x * 3) * 32u) % (unsigned)klen);
        for (int k = 0; k < klen; k += STEPS * 32) {
            bf16x8 a[STEPS], b[STEPS];
#pragma unroll
            for (int j = 0; j < STEPS; ++j) { int kk = k + j * 32 + krot; kk = kk >= klen ? kk - klen : kk; a[j] = *(const bf16x8*)(ap + kk); b[j] = *(const bf16x8*)(bp + kk); }
#pragma unroll
            for (int j = 0; j < STEPS; ++j) acc = __builtin_amdgcn_mfma_f32_16x16x32_bf16(b[j], a[j], acc, 0, 0, 0);
        }
        if (KSPLIT > 1) {
            *(LAS f32x4*)(lds + (wave * 64 + lane) * 16) = acc;
            __syncthreads();
            if (ks == 0) {
#pragma unroll
                for (int j = 1; j < KSPLIT; ++j) acc = acc + *(const LAS f32x4*)(lds + ((wave + j) * 64 + lane) * 16);
                E(rt * 16 + fr, ct * 16 + fq * 4, ct, fq, acc, pp);
            }
            __syncthreads();
        } else {
            E(rt * 16 + fr, ct * 16 + fq * 4, ct, fq, acc, pp);
        }
    }
}

template <class Epi>
__device__ __forceinline__ void skinny_gemm_k1024(LAS unsigned char* lds, const bf16_t* A, int lda, const bf16_t* Bt, int ldb, int N, const Epi& E, int G) {
    const int tid = opaque_tid(), wave = tid >> 6, lane = tid & 63, fr = lane & 15, fq = lane >> 4;
    const int nct = N >> 4;
    for (int ct = blockIdx.x; ct < nct; ct += G) {
        const bf16_t* ap = A + (size_t)(wave * 16 + fr) * lda + fq * 8;
        const bf16_t* bp = Bt + (size_t)(ct * 16 + fr) * ldb + (4 * wave) * 32 + fq * 8;
        const f32x2 pp = E.pre(wave * 16 + fr, ct * 16 + fq * 4, fq);
        bf16x8 a[32], bl[4];
#pragma unroll
        for (int q = 0; q < 4; ++q) bl[q] = *(const bf16x8*)(bp + q * 32);
#pragma unroll
        for (int j = 0; j < 32; ++j) a[j] = *(const bf16x8*)(ap + j * 32);
#pragma unroll
        for (int q = 0; q < 4; ++q) *(LAS bf16x8*)(lds + ((4 * wave + q) * 64 + lane) * 16) = bl[q];
        __syncthreads();
        f32x4 acc0 = (f32x4){0.f, 0.f, 0.f, 0.f}, acc1 = acc0;
#pragma unroll
        for (int j = 0; j < 32; j += 2) {
            const bf16x8 b0 = *(const LAS bf16x8*)(lds + (j * 64 + lane) * 16), b1 = *(const LAS bf16x8*)(lds + ((j + 1) * 64 + lane) * 16);
            acc0 = __builtin_amdgcn_mfma_f32_16x16x32_bf16(b0, a[j], acc0, 0, 0, 0);
            acc1 = __builtin_amdgcn_mfma_f32_16x16x32_bf16(b1, a[j + 1], acc1, 0, 0, 0);
        }
        E(wave * 16 + fr, ct * 16 + fq * 4, ct, fq, acc0 + acc1, pp);
        __syncthreads();
    }
}

template <class Epi>
__device__ __forceinline__ void skinny_gemm_k4096(LAS unsigned char* lds, const bf16_t* A, int lda, const bf16_t* Bt, int ldb, int N, const Epi& E, int G) {
    const int tid = opaque_tid(), wave = tid >> 6, lane = tid & 63, fr = lane & 15, fq = lane >> 4;
    const int npair = 4 * (N >> 4);
    for (int pr = blockIdx.x; pr < npair; pr += G) {
        const int ct = pr >> 2, rt0 = (pr & 3) * 2;
        const bf16_t* ap0 = A + (size_t)(rt0 * 16 + fr) * lda + wave * 512 + fq * 8;
        const bf16_t* ap1 = ap0 + (size_t)16 * lda;
        const bf16_t* bp = Bt + (size_t)(ct * 16 + fr) * ldb + wave * 512 + fq * 8;
        f32x2 pp = (f32x2){0.f, 0.f};
        if (wave < 2) pp = E.pre((rt0 + wave) * 16 + fr, ct * 16 + fq * 4, fq);
        bf16x8 b[16], a0[16], a1[16];
#pragma unroll
        for (int j = 0; j < 16; ++j) { b[j] = *(const bf16x8*)(bp + j * 32); a0[j] = *(const bf16x8*)(ap0 + j * 32); a1[j] = *(const bf16x8*)(ap1 + j * 32); }
        f32x4 acc0 = (f32x4){0.f, 0.f, 0.f, 0.f}, acc1 = acc0;
#pragma unroll
        for (int j = 0; j < 16; ++j) {
            acc0 = __builtin_amdgcn_mfma_f32_16x16x32_bf16(b[j], a0[j], acc0, 0, 0, 0);
            acc1 = __builtin_amdgcn_mfma_f32_16x16x32_bf16(b[j], a1[j], acc1, 0, 0, 0);
        }
        *(LAS f32x4*)(lds + ((wave * 2 + 0) * 64 + lane) * 16) = acc0;
        *(LAS f32x4*)(lds + ((wave * 2 + 1) * 64 + lane) * 16) = acc1;
        __syncthreads();
        if (wave < 2) {
            f32x4 acc = *(const LAS f32x4*)(lds + ((0 * 2 + wave) * 64 + lane) * 16);
#pragma unroll
            for (int j = 1; j < 8; ++j) acc = acc + *(const LAS f32x4*)(lds + ((j * 2 + wave) * 64 + lane) * 16);
            E((rt0 + wave) * 16 + fr, ct * 16 + fq * 4, ct, fq, acc, pp);
        }
        __syncthreads();
    }
}

__device__ __forceinline__ f32x2 ssqs_part(const float* ssqs, int r, int fq) {
    const f32x4* q = (const f32x4*)(ssqs + (size_t)r * 64 + fq * 16);
    const f32x4 a = q[0], b = q[1], c = q[2], d = q[3];
    f32x2 o; o.x = (a[0] + a[1] + a[2] + a[3]) + (b[0] + b[1] + b[2] + b[3]); o.y = (c[0] + c[1] + c[2] + c[3]) + (d[0] + d[1] + d[2] + d[3]); return o;
}
__device__ __forceinline__ float ssqs_finish(f32x2 pp) {
    float s = pp.x + pp.y; s += __shfl_xor(s, 16); s += __shfl_xor(s, 32);
    return __builtin_amdgcn_rsqf(s * (1.0f / 1024.0f) + EPS);
}
struct SkE1 {
    const float* ssqs; bf16_t* U; float* vssqs;
    __device__ __forceinline__ f32x2 pre(int r, int col, int fq) const { return ssqs_part(ssqs, r, fq); }
    __device__ __forceinline__ void operator()(int r, int col, int ct, int fq, f32x4 v, f32x2 pp) const {
        const float rs = ssqs_finish(pp);
        const int sec = col >> 9, cc = col & 511;
        v = v * rs;
        if (sec != 3) { v[0] = gelu_t(v[0]); v[1] = gelu_t(v[1]); v[2] = gelu_t(v[2]); v[3] = gelu_t(v[3]); }
        store_bf4(U + (size_t)sec * ((size_t)MPAD * 512) + (size_t)(MP + r) * 512 + cc, v);
        float sq = v[0] * v[0] + v[1] * v[1] + v[2] * v[2] + v[3] * v[3];
        sq += __shfl_xor(sq, 16); sq += __shfl_xor(sq, 32);
        if (sec == 1 && fq == 0) vssqs[r * 32 + (cc >> 4)] = sq;
    }
};
struct SkF1 {
    const float* ssqs; bf16_t* H;
    __device__ __forceinline__ f32x2 pre(int r, int col, int fq) const { return ssqs_part(ssqs, r, fq); }
    __device__ __forceinline__ void operator()(int r, int col, int ct, int fq, f32x4 v, f32x2 pp) const {
        const float rs = ssqs_finish(pp);
        v = v * rs;
#pragma unroll
        for (int j = 0; j < 4; ++j) { const float q = fmaxf(v[j], 0.f); v[j] = q * q; }
        store_bf4(H + (size_t)(MP + r) * DFF + col, v);
    }
};
struct SkRes {
    const bf16_t* Xi; bf16_t* Xo; float* ssqs; const float* bias; const float* cscale;
    __device__ __forceinline__ f32x2 pre(int r, int col, int fq) const { const u32x2 xw = *(const u32x2*)(Xi + (size_t)r * DM + col); f32x2 o; o.x = __uint_as_float(xw.x); o.y = __uint_as_float(xw.y); return o; }
    __device__ __forceinline__ void operator()(int r, int col, int ct, int fq, f32x4 v, f32x2 pp) const {
        if (bias) v = (v + *(const f32x4*)(bias + col)) * *(const f32x4*)(cscale + col);
        bf16_t* xr = Xo + (size_t)r * DM + col;
        { const unsigned x0 = __float_as_uint(pp.x), x1 = __float_as_uint(pp.y); v[0] += bflo(x0); v[1] += bfhi(x0); v[2] += bflo(x1); v[3] += bfhi(x1); }
        store_bf4(xr, v);
        float sq = v[0] * v[0] + v[1] * v[1] + v[2] * v[2] + v[3] * v[3];
        sq += __shfl_xor(sq, 16); sq += __shfl_xor(sq, 32);
        if (fq == 0) ssqs[r * 64 + ct] = sq;
    }
};

__device__ void transpose_cvt(const float* __restrict__ src, bf16_t* __restrict__ dst, int K, int N, LAS float* sT, int G, int blk) {
    const int tid = opaque_tid();
    const int tk = K / 64, tn = N / 64, ntile = tk * tn;
    for (int t = blk; t < ntile; t += G) {
        const int k0 = (t / tn) * 64, n0 = (t % tn) * 64;
#pragma unroll
        for (int i = 0; i < 2; ++i) {
            const int k = (tid >> 4) + 32 * i, n4 = (tid & 15) * 4;
            const f32x4 v = *(const f32x4*)(src + (size_t)(k0 + k) * N + n0 + n4);
            sT[k * 65 + n4 + 0] = v[0]; sT[k * 65 + n4 + 1] = v[1]; sT[k * 65 + n4 + 2] = v[2]; sT[k * 65 + n4 + 3] = v[3];
        }
        __syncthreads();
        {
            const int n = tid >> 3, kk = (tid & 7) * 8;
            float f[8];
#pragma unroll
            for (int j = 0; j < 8; ++j) f[j] = sT[(kk + j) * 65 + n];
            u32x4 w; w.x = cvt_pk_bf16(f[0], f[1]); w.y = cvt_pk_bf16(f[2], f[3]); w.z = cvt_pk_bf16(f[4], f[5]); w.w = cvt_pk_bf16(f[6], f[7]);
            *(u32x4*)(dst + (size_t)(n0 + n) * K + k0 + kk) = w;
        }
        __syncthreads();
    }
}
__device__ void transpose_cvt_wide(const float* __restrict__ src, bf16_t* __restrict__ dst, int K, int N, int nmat, LAS float* sT, int G, int rot, const float* gk, int gstride) {
    const int tid = opaque_tid();
    const int tk = K / 64, tn = N / 256, per = tk * tn, ntile = per * nmat;
    int blk = (int)blockIdx.x + rot; if (blk >= G) blk -= G;
    for (int t = blk; t < ntile; t += G) {
        const int mat = t / per, tt = t - mat * per;
        const int k0 = (tt / tn) * 64, n0 = (tt % tn) * 256;
        const float* sp = src + (size_t)mat * K * N; bf16_t* dp = dst + (size_t)mat * K * N;
        f32x4 v[8];
#pragma unroll
        for (int i = 0; i < 8; ++i) v[i] = *(const f32x4*)(sp + (size_t)(k0 + (tid >> 6) + 8 * i) * N + n0 + (tid & 63) * 4);
        if (gk) {
#pragma unroll
            for (int i = 0; i < 8; ++i) v[i] = v[i] * gk[(size_t)mat * gstride + k0 + (tid >> 6) + 8 * i];
        }
#pragma unroll
        for (int i = 0; i < 8; ++i) {
            const int k = (tid >> 6) + 8 * i, n4 = (tid & 63) * 4;
            sT[k * 257 + n4 + 0] = v[i][0]; sT[k * 257 + n4 + 1] = v[i][1]; sT[k * 257 + n4 + 2] = v[i][2]; sT[k * 257 + n4 + 3] = v[i][3];
        }
        __syncthreads();
        {
            const int piece = tid & 7;
#pragma unroll
            for (int i = 0; i < 4; ++i) {
                const int n = (tid >> 3) + 64 * i;
                float f[8];
#pragma unroll
                for (int j = 0; j < 8; ++j) f[j] = sT[(piece * 8 + j) * 257 + n];
                u32x4 w; w.x = cvt_pk_bf16(f[0], f[1]); w.y = cvt_pk_bf16(f[2], f[3]); w.z = cvt_pk_bf16(f[4], f[5]); w.w = cvt_pk_bf16(f[6], f[7]);
                st_wt16(dp, (unsigned)(((n0 + n) * K + k0 + piece * 8) * 2), w);
            }
        }
        __syncthreads();
    }
}

__device__ void gap0_extras(const Params& p, LAS unsigned char* lds, int G) {
    LAS float* sT = (LAS float*)lds;
    unsigned char* ws = p.ws;
    transpose_cvt_wide(p.pool_w, (bf16_t*)(ws + WS_WP), 256, 256, 8, sT, G, 128, nullptr, 0);
    for (int m = (int)blockIdx.x - 192; m >= 0 && m < 32; m += G) {
        const int eh = m >> 1, gate = m & 1, e = eh >> 3, h = eh & 7;
        transpose_cvt((gate ? p.gate_x_w : p.gate_a_w) + (size_t)eh * 4096, (bf16_t*)(ws + WS_GW) + (size_t)((e * 2 + gate) * 8 + h) * 4096, 64, 64, sT, 1 << 30, 0);
    }
    const int tid0 = opaque_tid();
    const int gtid = blockIdx.x * NTHR + tid0, gthr = G * NTHR;
    {
        bf16_t* SW = (bf16_t*)(ws + WS_SW);
        for (int i = gtid; i < 2 * 8 * 128 * 128; i += gthr) { const int s = i & 127, t = (i >> 7) & 127; SW[i] = (s <= t) ? f2bf(p.sgu_w[i]) : (bf16_t)0; }
        float* SP = (float*)(ws + WS_SP);
        for (int i = gtid; i < 1024; i += gthr) { const float z = -p.lru_lambda[i]; SP[i] = fmaxf(z, 0.f) + log1pf(expf(-fabsf(z))); }
    }
    {
        u32x4* cgz = (u32x4*)(ws + WS_CG);
        const u32x4 z = (u32x4){0u, 0u, 0u, 0u};
        for (int i = gtid; i < (int)((size_t)2 * 1024 * 128 * 8 / 16); i += gthr) cgz[i] = z;
    }
}

__device__ void phase_prep(const Params& p, LAS unsigned char* lds, int G) {
    LAS float* sT = (LAS float*)lds;
    unsigned char* ws = p.ws;
    transpose_cvt_wide(p.w_in, (bf16_t*)(ws + WS_WIN), DM, DIN, 1, sT, G, 0, p.norm_mix, 2 * DM);
    const int tid0 = opaque_tid();
    {
        const int wave = tid0 >> 6, lane = tid0 & 63;
        bf16_t* XG = (bf16_t*)(ws + WS_XG); float* SSQ = (float*)(ws + WS_SSQ); float* SSQS = (float*)(ws + WS_SSQS);
        for (int row = blockIdx.x * 8 + wave; row < MR; row += G * 8) {
            float sq = 0.f;
            const float* xr = row < MP ? p.x_prompt + (size_t)row * DM : p.x_sample + (size_t)(row - MP) * DM;
#pragma unroll
            for (int q = 0; q < 4; ++q) {
                const int col = q * 256 + lane * 4;
                const f32x4 v = *(const f32x4*)(xr + col);
                sq += v[0] * v[0] + v[1] * v[1] + v[2] * v[2] + v[3] * v[3];
                { u32x2 w2; w2.x = cvt_pk_bf16(v[0], v[1]); w2.y = cvt_pk_bf16(v[2], v[3]); st_wt8(XG, (unsigned)((row * DM + col) * 2), w2); }
            }
#pragma unroll
            for (int o = 1; o < 64; o <<= 1) sq += __shfl_xor(sq, o);
            if (row < MP) { if (lane < 16) SSQ[(size_t)row * 16 + lane] = (lane == 0) ? sq : 0.f; }
            else SSQS[(size_t)(row - MP) * 64 + lane] = (lane == 0) ? sq : 0.f;
        }
    }
}

__device__ void sample_pool_pre(const Params& p, int G);
__device__ void gap_convert(const Params& p, int g, LAS unsigned char* lds, int G) {
    if (g > 9) return;
    unsigned char* ws = p.ws;
    const float* src; bf16_t* dst; int K, N, nmat = 1; const float* gk = nullptr;
    const int l = (g - 1) >> 1;
    if (g == 0) { src = p.w_out; dst = (bf16_t*)(ws + WS_WOUT); K = DM; N = DM; nmat = 2; }
    else if (g == 5) { src = p.w_in + (size_t)DM * DIN; dst = (bf16_t*)(ws + WS_WIN) + (size_t)DIN * DM; K = DM; N = DIN; gk = p.norm_mix + 2 * DM; }
    else {
        const int gg = g < 5 ? g - 1 : g - 2;
        const int layer = gg >> 1;
        if ((gg & 1) == 0) { src = p.ffn_w1 + (size_t)layer * DM * DFF; dst = (bf16_t*)(ws + WS_W1) + (size_t)layer * DFF * DM; K = DM; N = DFF; gk = p.norm_ffn + layer * DM; }
        else { src = p.ffn_w2 + (size_t)layer * DFF * DM; dst = (bf16_t*)(ws + WS_W2) + (size_t)layer * DM * DFF; K = DFF; N = DM; }
    }
    (void)l;
    transpose_cvt_wide(src, dst, K, N, nmat, (LAS float*)lds, G, 0, gk, 0);
    if (g == 3) sample_pool_pre(p, G);
}

constexpr int L_XC = 0;
constexpr int L_XF = 18432;
constexpr int PF = 68;
constexpr int L_A = L_XF + 128 * PF * 4;
constexpr int L_B = L_A + 128 * PF * 4;
constexpr int L_PE = L_B + 128 * PF * 4;
constexpr int L_HE = L_PE + 2048;
constexpr int L_CARRY = L_HE + 2048;
constexpr int L_GW = L_CARRY + 256;
constexpr int L_SC = L_GW + 2 * 64 * 72 * 2;
static_assert(L_SC + 768 <= LDS_BYTES - 16, "LDS map");

__device__ __forceinline__ void lru_gates(LAS unsigned char* lds) {
    const int tid = opaque_tid(), lane = tid & 63, w = tid >> 6, fr = lane & 15, fq = lane >> 4;
    const int t = 16 * w + fr;
    bf16x8 Af[2];
#pragma unroll
    for (int ks = 0; ks < 2; ++ks) Af[ks] = *(const LAS bf16x8*)(lds + L_XC + (t * 72 + ks * 32 + fq * 8) * 2);
#pragma unroll
    for (int nt = 0; nt < 4; ++nt) {
        f32x4 ra = (f32x4){0.f, 0.f, 0.f, 0.f}, rx = (f32x4){0.f, 0.f, 0.f, 0.f};
#pragma unroll
        for (int ks = 0; ks < 2; ++ks) {
            const bf16x8 Ba = *(const LAS bf16x8*)(lds + L_GW + ((nt * 16 + fr) * 72 + ks * 32 + fq * 8) * 2);
            const bf16x8 Bx = *(const LAS bf16x8*)(lds + L_GW + ((64 + nt * 16 + fr) * 72 + ks * 32 + fq * 8) * 2);
            ra = __builtin_amdgcn_mfma_f32_16x16x32_bf16(Ba, Af[ks], ra, 0, 0, 0);
            rx = __builtin_amdgcn_mfma_f32_16x16x32_bf16(Bx, Af[ks], rx, 0, 0, 0);
        }
        const int c = nt * 16 + fq * 4;
        const f32x4 bav = *(const LAS f32x4*)(lds + L_SC + c * 4), bxv = *(const LAS f32x4*)(lds + L_SC + 256 + c * 4), spv = *(const LAS f32x4*)(lds + L_SC + 512 + c * 4);
        const f32x4 xc = *(const LAS f32x4*)(lds + L_XF + (t * PF + c) * 4);
        f32x4 av, bv;
#pragma unroll
        for (int j = 0; j < 4; ++j) {
            const float r = sigmoid_f(ra[j] + bav[j]), ig = sigmoid_f(rx[j] + bxv[j]);
            const float la = -8.0f * r * spv[j];
            const float a = __builtin_amdgcn_exp2f(la * 1.442695041f);
            const float mult = __builtin_amdgcn_sqrtf(fmaxf(1.0f - a * a, 0.f));
            av[j] = a; bv[j] = mult * ig * xc[j];
        }
        *(LAS f32x4*)(lds + L_A + (t * PF + c) * 4) = av;
        *(LAS f32x4*)(lds + L_B + (t * PF + c) * 4) = bv;
    }
}

__device__ __forceinline__ u32x4 f32_to_bf8(f32x4 lo, f32x4 hi) {
    u32x4 w; w.x = cvt_pk_bf16(lo[0], lo[1]); w.y = cvt_pk_bf16(lo[2], lo[3]); w.z = cvt_pk_bf16(hi[0], hi[1]); w.w = cvt_pk_bf16(hi[2], hi[3]); return w;
}

__device__ void lru_item(const Params& p, int e, int item, LAS unsigned char* lds) {
    const int tid = opaque_tid(), lane = tid & 63, w = tid >> 6;
    const bool sample = item >= 1024;
    const int h = sample ? item - 1024 : (item & 7), b = sample ? 0 : ((item >> 3) & 7);
    const int ch0 = h * 64, ch = lane, tq = w;
    const int rr8 = tid >> 3, part = tid & 7;
    unsigned char* ws = p.ws;
    const bf16_t* XB = (const bf16_t*)(ws + WS_XB); const bf16_t* GG = (const bf16_t*)(ws + WS_GG); bf16_t* AB = (bf16_t*)(ws + WS_AB);
    const float* ba = p.gate_a_b + e * 512; const float* bx = p.gate_x_b + e * 512; const float* sp = (const float*)(ws + WS_SP) + e * 512;
    LAS float* sXF = (LAS float*)(lds + L_XF); LAS bf16_t* sXC = (LAS bf16_t*)(lds + L_XC);
    LAS float* sA = (LAS float*)(lds + L_A); LAS float* sB = (LAS float*)(lds + L_B); LAS float* sXR = (LAS float*)(lds + L_A);
    LAS float* sPE = (LAS float*)(lds + L_PE); LAS float* sHE = (LAS float*)(lds + L_HE);
    {
        const int g = tid >> 8, n = (tid >> 2) & 63, pt = tid & 3;
        const bf16_t* gw = (const bf16_t*)(ws + WS_GW) + (size_t)((e * 2 + g) * 8 + h) * 4096 + n * 64 + pt * 16;
        const u32x4 w0 = *(const u32x4*)gw, w1 = *(const u32x4*)(gw + 8);
        LAS unsigned char* d = lds + L_GW + ((g * 64 + n) * 72 + pt * 16) * 2;
        *(LAS u32x4*)d = w0; *(LAS u32x4*)(d + 16) = w1;
        if (tid < 48) {
            const int which = tid >> 4, c4 = (tid & 15) * 4;
            const float* src = which == 0 ? ba : (which == 1 ? bx : sp);
            *(LAS f32x4*)(lds + L_SC + which * 256 + c4 * 4) = *(const f32x4*)(src + ch0 + c4);
        }
    }

    if (sample) {
        const int cc = ch0 + part * 8;
        f32x4 cwl[4], cwh[4];
#pragma unroll
        for (int k = 0; k < 4; ++k) { cwl[k] = *(const f32x4*)(p.conv_w + (e * 4 + k) * 512 + cc); cwh[k] = *(const f32x4*)(p.conv_w + (e * 4 + k) * 512 + cc + 4); }
        const f32x4 cbl = *(const f32x4*)(p.conv_b + e * 512 + cc), cbh = *(const f32x4*)(p.conv_b + e * 512 + cc + 4);
#pragma unroll
        for (int i = 0; i < 2; ++i) {
            const int r = rr8 + 64 * i;
            const float* sc = p.state_conv + ((size_t)(e * 128 + r) * 3) * 512 + cc;
            const f32x4 s0l = *(const f32x4*)sc, s0h = *(const f32x4*)(sc + 4), s1l = *(const f32x4*)(sc + 512), s1h = *(const f32x4*)(sc + 516),
                        s2l = *(const f32x4*)(sc + 1024), s2h = *(const f32x4*)(sc + 1028);
            f32x4 xl, xh; bf8_to_f32(*(const u32x4*)(XB + (size_t)(MP + r) * 512 + cc), xl, xh);
            const f32x4 xcl = cbl + cwl[0] * s0l + cwl[1] * s1l + cwl[2] * s2l + cwl[3] * xl;
            const f32x4 xch = cbh + cwh[0] * s0h + cwh[1] * s1h + cwh[2] * s2h + cwh[3] * xh;
            *(LAS f32x4*)(sXF + r * PF + part * 8) = xcl; *(LAS f32x4*)(sXF + r * PF + part * 8 + 4) = xch;
            *(LAS u32x4*)(sXC + r * 72 + part * 8) = f32_to_bf8(xcl, xch);
            float* co = p.out + O_CONVS + ((size_t)(e * 128 + r) * 3) * 512 + cc;
            *(f32x4*)co = s1l; *(f32x4*)(co + 4) = s1h; *(f32x4*)(co + 512) = s2l; *(f32x4*)(co + 516) = s2h; *(f32x4*)(co + 1024) = xl; *(f32x4*)(co + 1028) = xh;
        }
        __syncthreads();
        lru_gates(lds);
        __syncthreads();
#pragma unroll
        for (int i = 0; i < 2; ++i) {
            const int r = rr8 + 64 * i;
            const float* hp = p.state_rglru + (size_t)(e * 128 + r) * 512 + cc;
            const f32x4 h0l = *(const f32x4*)hp, h0h = *(const f32x4*)(hp + 4);
            const f32x4 al = *(const LAS f32x4*)(sA + r * PF + part * 8), ah = *(const LAS f32x4*)(sA + r * PF + part * 8 + 4);
            const f32x4 bl = *(const LAS f32x4*)(sB + r * PF + part * 8), bh = *(const LAS f32x4*)(sB + r * PF + part * 8 + 4);
            const f32x4 hl = al * h0l + bl, hh = ah * h0h + bh;
            float* ho = p.out + O_HS + (size_t)(e * 128 + r) * 512 + cc;
            *(f32x4*)ho = hl; *(f32x4*)(ho + 4) = hh;
            f32x4 gl, gh; bf8_to_f32(*(const u32x4*)(GG + (size_t)(MP + r) * 512 + cc), gl, gh);
            *(u32x4*)(AB + (size_t)(MP + r) * DM + 512 + cc) = f32_to_bf8(hl * gl, hh * gh);
        }
        __syncthreads();
        return;
    }

}

constexpr int L_VT = 0;
__device__ void sgu_item(const Params& p, int e, int it, LAS unsigned char* lds) {
    const int tid = opaque_tid(), lane = tid & 63, w = tid >> 6, fr = lane & 15, fq = lane >> 4;
    unsigned char* ws = p.ws;
    const bf16_t* U = (const bf16_t*)(ws + WS_U); const bf16_t* VP = (const bf16_t*)(ws + WS_VP); bf16_t* AB = (bf16_t*)(ws + WS_AB);
    const float* VSSQ = (const float*)(ws + WS_VSSQ);
    if (it >= 1024) {
        float* vo = p.out + O_SGUV + (size_t)e * MS * 512;
        {
            const int r = (it - 1024) * 4 + (tid >> 7), c4 = (tid & 127) * 4, h = c4 >> 6;
            const float rsv = rsv_sample_full((const float*)(ws + WS_VSSQS), r);
            const u32x2 vw = *(const u32x2*)(VP + (size_t)(MP + r) * 512 + c4), uw = *(const u32x2*)(U + (size_t)(MP + r) * 512 + c4);
            const f32x4 vn = *(const f32x4*)(p.v_norm + e * 512 + c4);
            f32x4 v; v[0] = bflo(vw.x) * rsv * vn[0]; v[1] = bfhi(vw.x) * rsv * vn[1]; v[2] = bflo(vw.y) * rsv * vn[2]; v[3] = bfhi(vw.y) * rsv * vn[3];
            *(f32x4*)(vo + (size_t)r * 512 + c4) = v;
            const float w00 = p.sgu_w[(size_t)(e * 8 + h) * 16384], b0 = p.sgu_b[(e * 8 + h) * 128];
            f32x4 a; a[0] = bflo(uw.x) * (w00 * v[0] + b0); a[1] = bfhi(uw.x) * (w00 * v[1] + b0); a[2] = bflo(uw.y) * (w00 * v[2] + b0); a[3] = bfhi(uw.y) * (w00 * v[3] + b0);
            store_bf4(AB + (size_t)(MP + r) * DM + c4, a);
        }
        return;
    }
}

struct SguPre { bf16x8 wf[4]; u32x2 uw[4]; float bsv; u32x4 v0, v1; f32x4 q0, q1; f32x4 vn0, vn1, vn2, vn3; };
__device__ __forceinline__ void sgu_load(const Params& p, int e, int it, SguPre& R, int tid) {
    const int lane = tid & 63, w = tid >> 6, fr = lane & 15, fq = lane >> 4;
    unsigned char* ws = p.ws;
    const bf16_t* U = (const bf16_t*)(ws + WS_U); const bf16_t* VP = (const bf16_t*)(ws + WS_VP); const float* VSSQ = (const float*)(ws + WS_VSSQ);
    const int h = it & 7, row0 = (it >> 3) * 128, t = 16 * w + fr, nks = (16 * w + 15) / 32 + 1;
    const bf16_t* SW = (const bf16_t*)(ws + WS_SW) + (size_t)(e * 8 + h) * 16384;
#pragma unroll
    for (int ks = 0; ks < 4; ++ks) R.wf[ks] = (ks < nks) ? *(const bf16x8*)(SW + t * 128 + ks * 32 + fq * 8) : (bf16x8){0, 0, 0, 0, 0, 0, 0, 0};
#pragma unroll
    for (int nt = 0; nt < 4; ++nt) R.uw[nt] = *(const u32x2*)(U + (size_t)(row0 + t) * 512 + h * 64 + nt * 16 + fq * 4);
    R.bsv = p.sgu_b[(e * 8 + h) * 128 + t];
    const int s = tid >> 2, dq = (tid & 3) * 16;
    R.q0 = *(const f32x4*)(VSSQ + (size_t)(row0 + s) * 8); R.q1 = *(const f32x4*)(VSSQ + (size_t)(row0 + s) * 8 + 4);
    R.v0 = *(const u32x4*)(VP + (size_t)(row0 + s) * 512 + h * 64 + dq); R.v1 = *(const u32x4*)(VP + (size_t)(row0 + s) * 512 + h * 64 + dq + 8);
    const float* vn = p.v_norm + e * 512 + h * 64 + dq;
    R.vn0 = *(const f32x4*)(vn); R.vn1 = *(const f32x4*)(vn + 4); R.vn2 = *(const f32x4*)(vn + 8); R.vn3 = *(const f32x4*)(vn + 12);
}
__device__ __forceinline__ void sgu_compute(const Params& p, int it, const SguPre& R, LAS unsigned char* lds, int tid) {
    const int lane = tid & 63, w = tid >> 6, fr = lane & 15, fq = lane >> 4;
    bf16_t* AB = (bf16_t*)(p.ws + WS_AB);
    const int h = it & 7, row0 = (it >> 3) * 128, t = 16 * w + fr, nks = (16 * w + 15) / 32 + 1;
    LAS bf16_t* sVT = (LAS bf16_t*)(lds + L_VT);
    {
        const int s = tid >> 2, dq = (tid & 3) * 16;
        const float ssum = (R.q0[0] + R.q0[1] + R.q0[2] + R.q0[3]) + (R.q1[0] + R.q1[1] + R.q1[2] + R.q1[3]);
        const float rsv = __builtin_amdgcn_rsqf(ssum * (1.0f / 512.0f) + EPS);
        f32x4 f0, f1, f2, f3; bf8_to_f32(R.v0, f0, f1); bf8_to_f32(R.v1, f2, f3);
        f0 = f0 * R.vn0 * rsv; f1 = f1 * R.vn1 * rsv; f2 = f2 * R.vn2 * rsv; f3 = f3 * R.vn3 * rsv;
#pragma unroll
        for (int j = 0; j < 4; ++j) {
            sVT[(dq + j) * 136 + s] = f2bf(f0[j]); sVT[(dq + 4 + j) * 136 + s] = f2bf(f1[j]);
            sVT[(dq + 8 + j) * 136 + s] = f2bf(f2[j]); sVT[(dq + 12 + j) * 136 + s] = f2bf(f3[j]);
        }
    }
    __syncthreads();
    {
        f32x4 acc[4];
#pragma unroll
        for (int nt = 0; nt < 4; ++nt) acc[nt] = (f32x4){0.f, 0.f, 0.f, 0.f};
#pragma unroll
        for (int ks = 0; ks < 4; ++ks) {
            if (ks < nks) {
#pragma unroll
                for (int nt = 0; nt < 4; ++nt) {
                    const bf16x8 vf = *(const LAS bf16x8*)(lds + L_VT + ((nt * 16 + fr) * 136 + ks * 32 + fq * 8) * 2);
                    acc[nt] = __builtin_amdgcn_mfma_f32_16x16x32_bf16(vf, R.wf[ks], acc[nt], 0, 0, 0);
                }
            }
        }
#pragma unroll
        for (int nt = 0; nt < 4; ++nt) {
            const int c = h * 64 + nt * 16 + fq * 4;
            f32x4 o; o[0] = bflo(R.uw[nt].x) * (acc[nt][0] + R.bsv); o[1] = bfhi(R.uw[nt].x) * (acc[nt][1] + R.bsv); o[2] = bflo(R.uw[nt].y) * (acc[nt][2] + R.bsv); o[3] = bfhi(R.uw[nt].y) * (acc[nt][3] + R.bsv);
            store_bf4(AB + (size_t)(row0 + t) * DM + c, o);
        }
    }
    __syncthreads();
}

struct LruPre { u32x4 x[3]; u32x4 gg[2]; unsigned long long gq[2][2]; };
__device__ __forceinline__ void lru_load(const Params& p, int e, int item, LruPre& R, int tid) {
    const int lane = tid & 63, tq = tid >> 6, ch = lane, rr8 = tid >> 3, part = tid & 7;
    const int h = item & 7, b = (item >> 3) & 7, c = item >> 6, ch0 = h * 64, row0 = b * SEQ + c * 128;
    unsigned char* ws = p.ws;
    const bf16_t* XB = (const bf16_t*)(ws + WS_XB); const bf16_t* GG = (const bf16_t*)(ws + WS_GG);
    unsigned long long* CG = (unsigned long long*)(ws + WS_CG) + (size_t)e * 1024 * 128;
#pragma unroll
    for (int i = 0; i < 3; ++i) {
        const int rr = rr8 + 64 * i, tl = c * 128 - 3 + rr;
        R.x[i] = (rr < 131 && tl >= 0) ? *(const u32x4*)(XB + (size_t)(b * SEQ + tl) * 512 + ch0 + part * 8) : (u32x4){0u, 0u, 0u, 0u};
    }
#pragma unroll
    for (int i = 0; i < 2; ++i) R.gg[i] = *(const u32x4*)(GG + (size_t)(row0 + rr8 + 64 * i) * 512 + ch0 + part * 8);
#pragma unroll
    for (int q = 0; q < 2; ++q) {
        const int j = tq + 8 * q;
        R.gq[q][0] = 0ull; R.gq[q][1] = 0ull;
        if (j < c) { unsigned long long* g = CG + (size_t)(j * 64 + (item & 63)) * 128 + ch;
            R.gq[q][0] = __hip_atomic_load(g, __ATOMIC_RELAXED, __HIP_MEMORY_SCOPE_AGENT); R.gq[q][1] = __hip_atomic_load(g + 64, __ATOMIC_RELAXED, __HIP_MEMORY_SCOPE_AGENT); }
    }
}

__device__ void lru_prompt_loop(const Params& p, int e, LAS unsigned char* lds, int G) {
    const int tid = opaque_tid(), lane = tid & 63, w = tid >> 6;
    const int ch = lane, tq = w, rr8 = tid >> 3, part = tid & 7;
    unsigned char* ws = p.ws;
    bf16_t* AB = (bf16_t*)(ws + WS_AB);
    const float* ba = p.gate_a_b + e * 512; const float* bx = p.gate_x_b + e * 512; const float* sp = (const float*)(ws + WS_SP) + e * 512;
    LAS float* sXF = (LAS float*)(lds + L_XF); LAS bf16_t* sXC = (LAS bf16_t*)(lds + L_XC);
    LAS float* sA = (LAS float*)(lds + L_A); LAS float* sB = (LAS float*)(lds + L_B); LAS float* sXR = (LAS float*)(lds + L_A);
    LAS float* sPE = (LAS float*)(lds + L_PE); LAS float* sHE = (LAS float*)(lds + L_HE);
    LAS float* sCP = (LAS float*)(lds + L_A); LAS float* sCH = (LAS float*)(lds + L_A + 4096);
    unsigned long long* CG = (unsigned long long*)(ws + WS_CG) + (size_t)e * 1024 * 128;
    int item = blockIdx.x;
    if (item >= 1024) return;
    LruPre cur; lru_load(p, e, item, cur, tid);
    int cur_h = -1;
    float cw0 = 0.f, cw1 = 0.f, cw2 = 0.f, cw3 = 0.f, cb = 0.f;
    for (;;) {
        const int h = item & 7, b = (item >> 3) & 7, c = item >> 6, ch0 = h * 64, row0 = b * SEQ + c * 128;
        if (h != cur_h) {
            cur_h = h;
            const int g = tid >> 8, n = (tid >> 2) & 63, pt = tid & 3;
            const bf16_t* gw = (const bf16_t*)(ws + WS_GW) + (size_t)((e * 2 + g) * 8 + h) * 4096 + n * 64 + pt * 16;
            const u32x4 w0 = *(const u32x4*)gw, w1 = *(const u32x4*)(gw + 8);
            LAS unsigned char* d = lds + L_GW + ((g * 64 + n) * 72 + pt * 16) * 2;
            *(LAS u32x4*)d = w0; *(LAS u32x4*)(d + 16) = w1;
            if (tid < 48) {
                const int which = tid >> 4, c4 = (tid & 15) * 4;
                const float* src = which == 0 ? ba : (which == 1 ? bx : sp);
                *(LAS f32x4*)(lds + L_SC + which * 256 + c4 * 4) = *(const f32x4*)(src + ch0 + c4);
            }
            cw0 = p.conv_w[(e * 4 + 0) * 512 + ch0 + ch]; cw1 = p.conv_w[(e * 4 + 1) * 512 + ch0 + ch]; cw2 = p.conv_w[(e * 4 + 2) * 512 + ch0 + ch];
            cw3 = p.conv_w[(e * 4 + 3) * 512 + ch0 + ch]; cb = p.conv_b[e * 512 + ch0 + ch];
        }
#pragma unroll
        for (int i = 0; i < 3; ++i) {
            const int rr = rr8 + 64 * i;
            if (rr < 131) { f32x4 xl, xh; bf8_to_f32(cur.x[i], xl, xh);
                *(LAS f32x4*)(sXR + rr * 64 + part * 8) = xl; *(LAS f32x4*)(sXR + rr * 64 + part * 8 + 4) = xh; }
        }
        const int nitem = item + G; const bool has_next = nitem < 1024;
        LruPre nxt = cur;
        if (has_next) lru_load(p, e, nitem, nxt, tid);
        __syncthreads();
        {
            float xv[19];
#pragma unroll
            for (int j = 0; j < 19; ++j) xv[j] = sXR[(tq * 16 + j) * 64 + ch];
#pragma unroll
            for (int i = 0; i < 16; ++i) {
                const float xc = cb + cw0 * xv[i] + cw1 * xv[i + 1] + cw2 * xv[i + 2] + cw3 * xv[i + 3];
                const int t = tq * 16 + i;
                sXF[t * PF + ch] = xc; sXC[t * 72 + ch] = f2bf(xc);
            }
            if (c == 15 && tq == 7) {
                float* co = p.out + O_CONVP + ((size_t)(e * 8 + b) * 3) * 512 + ch0 + ch;
                co[0] = xv[16]; co[512] = xv[17]; co[1024] = xv[18];
            }
        }
        __syncthreads();
        lru_gates(lds);
        __syncthreads();
        {
            float Hl[16], Pc[16];
            float Hh = 0.f, Pp = 1.f;
#pragma unroll
            for (int i = 0; i < 16; ++i) {
                const float a = sA[(tq * 16 + i) * PF + ch], bb = sB[(tq * 16 + i) * PF + ch];
                Hh = a * Hh + bb; Pp = Pp * a; Hl[i] = Hh; Pc[i] = Pp;
            }
            sPE[tq * 64 + ch] = Pp; sHE[tq * 64 + ch] = Hh;
            __syncthreads();
            if (tq == 7 && c < 15) {
                float Pt = 1.f, Ht = 0.f;
#pragma unroll
                for (int s2 = 0; s2 < 8; ++s2) { const float pe = sPE[s2 * 64 + ch]; Ht = pe * Ht + sHE[s2 * 64 + ch]; Pt *= pe; }
                unsigned long long* g = CG + (size_t)item * 128 + ch;
                __hip_atomic_store(g, (1ull << 32) | (unsigned long long)__float_as_uint(Pt), __ATOMIC_RELAXED, __HIP_MEMORY_SCOPE_AGENT);
                __hip_atomic_store(g + 64, (1ull << 32) | (unsigned long long)__float_as_uint(Ht), __ATOMIC_RELAXED, __HIP_MEMORY_SCOPE_AGENT);
            }
#pragma unroll
            for (int q = 0; q < 2; ++q) {
                const int j = tq + 8 * q;
                if (j < c) {
                    unsigned long long* g = CG + (size_t)(j * 64 + (item & 63)) * 128 + ch;
                    unsigned long long gp = cur.gq[q][0], gh = cur.gq[q][1]; unsigned spin = 0;
                    while (!((gp >> 32) == 1ull && (gh >> 32) == 1ull) && ++spin < (1u << 24)) {
                        __builtin_amdgcn_s_sleep(1);
                        gp = __hip_atomic_load(g, __ATOMIC_RELAXED, __HIP_MEMORY_SCOPE_AGENT); gh = __hip_atomic_load(g + 64, __ATOMIC_RELAXED, __HIP_MEMORY_SCOPE_AGENT);
                    }
                    sCP[j * 64 + ch] = __uint_as_float((unsigned)gp); sCH[j * 64 + ch] = __uint_as_float((unsigned)gh);
                }
            }
            __syncthreads();
            float hin = 0.f;
            {
                float cp[15], chv[15], pe[7], he[7];
#pragma unroll
                for (int j = 0; j < 15; ++j) { cp[j] = sCP[j * 64 + ch]; chv[j] = sCH[j * 64 + ch]; }
#pragma unroll
                for (int s2 = 0; s2 < 7; ++s2) { pe[s2] = sPE[s2 * 64 + ch]; he[s2] = sHE[s2 * 64 + ch]; }
#pragma unroll
                for (int j = 0; j < 15; ++j) hin = (j < c) ? cp[j] * hin + chv[j] : hin;
#pragma unroll
                for (int s2 = 0; s2 < 7; ++s2) hin = (s2 < tq) ? pe[s2] * hin + he[s2] : hin;
            }
            float hlast = 0.f;
#pragma unroll
            for (int i = 0; i < 16; ++i) { const float hv = Hl[i] + Pc[i] * hin; hlast = hv; sXF[(tq * 16 + i) * PF + ch] = hv; }
            if (tq == 7 && c == 15) p.out[O_HP + (size_t)(e * 8 + b) * 512 + ch0 + ch] = hlast;
            __syncthreads();
        }
#pragma unroll
        for (int i = 0; i < 2; ++i) {
            const int t = rr8 + 64 * i;
            f32x4 gl, gh; bf8_to_f32(cur.gg[i], gl, gh);
            const f32x4 hl = *(const LAS f32x4*)(sXF + t * PF + part * 8), hh = *(const LAS f32x4*)(sXF + t * PF + part * 8 + 4);
            *(u32x4*)(AB + (size_t)(row0 + t) * DM + 512 + ch0 + part * 8) = f32_to_bf8(hl * gl, hh * gh);
        }
        if (!has_next) break;
        cur = nxt; item = nitem;
    }
    __syncthreads();
}

__device__ void phase_e2(const Params& p, int e, LAS unsigned char* lds, int G) {
    lru_prompt_loop(p, e, lds, G);
    constexpr int NLRU = 1032;
    int itg = blockIdx.x; while (itg < 1024) itg += G;
    for (; itg < NLRU; itg += G) lru_item(p, e, itg, lds);
    const int tid = opaque_tid();
    const int blk = blockIdx.x;
    const int j0 = blk >= 8 ? blk - 8 : 248 + blk;
    const int nit = blk < 8 ? 2 : ((blk >= 40 && blk < 56) ? 5 : 4);
#define SGU_IDX(k) ((k) < 4 ? j0 + 256 * (k) : 760 + ((blk - 40) & 7) + 256 * ((blk - 40) >> 3))
    {
        SguPre A, B; sgu_load(p, e, SGU_IDX(0), A, tid); B = A;
        int k = 0;
        for (;;) {
            if (k + 1 < nit) sgu_load(p, e, SGU_IDX(k + 1), B, tid);
            sgu_compute(p, SGU_IDX(k), A, lds, tid);
            if (++k >= nit) break;
            if (k + 1 < nit) sgu_load(p, e, SGU_IDX(k + 1), A, tid);
            sgu_compute(p, SGU_IDX(k), B, lds, tid);
            if (++k >= nit) break;
        }
    }
#undef SGU_IDX
    if (blk >= 8 && blk < 40) sgu_item(p, e, 1024 + blk - 8, lds);
}

template <int W>
__device__ __forceinline__ void pool_rows(const float (&v0)[31], const float (&v1)[31], int t0, bf16_t* pa) {
    float s0 = 0.f, s1 = 0.f;
#pragma unroll
    for (int q = 0; q < W; ++q) { s0 += v0[15 - q]; s1 += v1[15 - q]; }
#pragma unroll
    for (int i = 0; i < 16; ++i) {
        const int jj = 15 + i, t = t0 + i;
        if (i > 0) { s0 += v0[jj] - v0[jj - W]; s1 += v1[jj] - v1[jj - W]; }
        const float ic = (t + 1 < W) ? 1.0f / (float)(t + 1) : (1.0f / (float)W);
        *(unsigned*)(pa + (size_t)i * DM) = cvt_pk_bf16(s0 * ic - v0[jj], s1 * ic - v1[jj]);
    }
}

__device__ void sample_pool_pre(const Params& p, int G) {
    const int tid = opaque_tid();
    const int c = tid * 2, w = 2 << (c >> 8);
    float* SPS = (float*)(p.ws + WS_SPSUM);
    for (int it = blockIdx.x; it < 2 * MS; it += G) {
        const int o = it >> 7, r = it & 127;
        const float* sp = p.state_pool + ((size_t)(o * 128 + r) * 15) * DM + c;
        float* po = p.out + O_POOLS + ((size_t)(o * 128 + r) * 15) * DM + c;
        f32x2 z[15];
#pragma unroll
        for (int k = 0; k < 15; ++k) z[k] = *(const f32x2*)(sp + (size_t)k * DM);
        float s0 = 0.f, s1 = 0.f;
#pragma unroll
        for (int k = 14; k >= 0; --k) {
            if (14 - k < w - 1) { s0 += z[k].x; s1 += z[k].y; }
            if (k >= 1) *(f32x2*)(po + (size_t)(k - 1) * DM) = z[k];
        }
        f32x2 sv; sv.x = s0; sv.y = s1;
        *(f32x2*)(SPS + (size_t)(o * 128 + r) * DM + c) = sv;
    }
}

template <int W>
__device__ __forceinline__ void pool_tile_rows(const Params& p, int layer, int pm, int pn, LAS float* sRS, int tid) {
    const int o = layer >> 1, b = pm >> 3, tbase = (pm & 7) * 256;
    const bf16_t* X = (const bf16_t*)(p.ws + WS_XG); bf16_t* PA = (bf16_t*)(p.ws + WS_PA);
    const bf16_t* HALO = (const bf16_t*)(p.ws + WS_HALO);
    const int c = pn * 256 + (tid & 127) * 2;
    const f32x2 gmix = *(const f32x2*)(p.norm_mix + layer * DM + c);
    for (int s = tid >> 7; s < 16; s += 4) {
        const int t0 = tbase + s * 16;
        unsigned wv[31];
#pragma unroll
        for (int j = 0; j < 31; ++j) {
            const int tl = t0 - 15 + j;
            const bf16_t* src = (s == 0 && j < 15) ? HALO + (size_t)((pm - 1) * 16 + j + 1) * DM + c : X + (size_t)(b * SEQ + tl) * DM + c;
            wv[j] = (tl >= 0) ? *(const unsigned*)src : 0u;
        }
        float v0[31], v1[31];
#pragma unroll
        for (int j = 0; j < 31; ++j) { const float rs = sRS[s * 16 + j]; v0[j] = bflo(wv[j]) * rs * gmix.x; v1[j] = bfhi(wv[j]) * rs * gmix.y; }
        pool_rows<W>(v0, v1, t0, PA + (size_t)(b * SEQ + t0) * DM + c);
        if (t0 == SEQ - 16) {
#pragma unroll
            for (int k = 0; k < 15; ++k) { f32x2 z; z.x = v0[16 + k]; z.y = v1[16 + k]; *(f32x2*)(p.out + O_POOLP + ((size_t)(o * 8 + b) * 15 + k) * DM + c) = z; }
        }
    }
}
__device__ void pool_tile_prep(const Params& p, int layer, int pm, int pn, LAS unsigned char* lds) {
    const int tid = opaque_tid();
    const float* SSQ = (const float*)(p.ws + WS_SSQ);
    LAS float* sRS = (LAS float*)lds;
    const int b = pm >> 3, tbase = (pm & 7) * 256;
    if (tid < 271) { const int tl = tbase - 15 + tid; sRS[tid] = tl >= 0 ? row_rs16(SSQ, b * SEQ + tl) : 0.f; }
    __syncthreads();
    if (pn == 0) pool_tile_rows<2>(p, layer, pm, pn, sRS, tid); else if (pn == 1) pool_tile_rows<4>(p, layer, pm, pn, sRS, tid);
    else if (pn == 2) pool_tile_rows<8>(p, layer, pm, pn, sRS, tid); else pool_tile_rows<16>(p, layer, pm, pn, sRS, tid);
    asm volatile("s_waitcnt vmcnt(0)" ::: "memory");
    __syncthreads();
}

template <class Epi>
__device__ __forceinline__ void skinny_pool(const Params& p, int layer, const bf16_t* Bt, const Epi& E, int G, const bf16_t* Xs, const float* SSQS) {
    const int tid = opaque_tid(), wave = tid >> 6, lane = tid & 63, fr = lane & 15, fq = lane >> 4;
    const int o = layer >> 1;
    const float* SPS = (const float*)(p.ws + WS_SPSUM) + (size_t)o * MS * DM;
    for (int ct = blockIdx.x; ct < 64; ct += G) {
        const int r = wave * 16 + fr, grp = ct >> 4, w = 2 << grp;
        const float invw = 1.0f / (float)w;
        const f32x2 pp = E.pre(r, ct * 16 + fq * 4, fq);
        const f32x2 ssp = ssqs_part(SSQS, r, fq);
        u32x4 xw[8]; bf16x8 bfr[8];
#pragma unroll
        for (int j = 0; j < 8; ++j) {
            const int col = grp * 256 + j * 32 + fq * 8;
            xw[j] = *(const u32x4*)(Xs + (size_t)r * DM + col);
            bfr[j] = *(const bf16x8*)(Bt + (size_t)(ct * 16 + fr) * 256 + j * 32 + fq * 8);
        }
        const float rs = ssqs_finish(ssp);
        f32x4 acc = (f32x4){0.f, 0.f, 0.f, 0.f};
#pragma unroll
        for (int j = 0; j < 8; ++j) {
            const int col = grp * 256 + j * 32 + fq * 8;
            const f32x4 s0 = *(const f32x4*)(SPS + (size_t)r * DM + col), s1 = *(const f32x4*)(SPS + (size_t)r * DM + col + 4);
            const f32x4 g0 = *(const f32x4*)(p.norm_mix + layer * DM + col), g1 = *(const f32x4*)(p.norm_mix + layer * DM + col + 4);
            f32x4 x0, x1; bf8_to_f32(xw[j], x0, x1);
            x0 = x0 * g0 * rs; x1 = x1 * g1 * rs;
            if ((ct & 15) == 0) { float* po = p.out + O_POOLS + ((size_t)(o * 128 + r) * 15 + 14) * DM + col; *(f32x4*)po = x0; *(f32x4*)(po + 4) = x1; }
            const f32x4 p0 = (x0 + s0) * invw - x0, p1 = (x1 + s1) * invw - x1;
            const u32x4 pk = pack_bf8(p0, p1);
            bf16x8 af; __builtin_memcpy(&af, &pk, 16);
            acc = __builtin_amdgcn_mfma_f32_16x16x32_bf16(bfr[j], af, acc, 0, 0, 0);
        }
        E(r, ct * 16 + fq * 4, ct, fq, acc, pp);
    }
}

__device__ void phase_final(const Params& p, int G, const bf16_t* Xs, const float* SSQS) {
    const int tidf = opaque_tid();
    const int wave = tidf >> 6, lane = tidf & 63;
    const float* SSQ = (const float*)(p.ws + WS_SSQ);
    const bf16_t* X = (const bf16_t*)(p.ws + WS_XG);
    for (int row = blockIdx.x * 8 + wave; row < MR; row += G * 8) {
        const float rs = row < MP ? row_rs16(SSQ, row) : rs_sample_full(SSQS, row - MP);
        float* yr = p.out + (size_t)row * DM;
#pragma unroll
        for (int q = 0; q < 4; ++q) {
            const int col = q * 256 + lane * 4;
            const u32x2 xw = row < MP ? *(const u32x2*)(X + (size_t)row * DM + col) : *(const u32x2*)(Xs + (size_t)(row - MP) * DM + col);
            const f32x4 gv = *(const f32x4*)(p.norm_final + col);
            f32x4 v; v[0] = bflo(xw.x); v[1] = bfhi(xw.x); v[2] = bflo(xw.y); v[3] = bfhi(xw.y);
            *(f32x4*)(yr + col) = v * gv * rs;
        }
    }
}

__global__ void __launch_bounds__(NTHR, 2) fwd_megakernel(Params p) {
    extern __shared__ __attribute__((aligned(16))) unsigned char smem[];
    LAS unsigned char* lds = (LAS unsigned char*)smem;
    cg::grid_group grid = cg::this_grid();
    const int G = gridDim.x;
    unsigned char* ws = p.ws;
    bf16_t* XG = (bf16_t*)(ws + WS_XG); float* SSQ = (float*)(ws + WS_SSQ);

    volatile LAS unsigned* st = (volatile LAS unsigned*)(lds + LDS_BYTES - 16);
    if (threadIdx.x < 4) st[threadIdx.x] = 0u;
    __syncthreads();
    const XcdBarrier bar = xcd_barrier_post((unsigned*)(ws + WS_BAR), st);
    float* SSQ2 = (float*)(ws + WS_SSQ2); bf16_t* HALO = (bf16_t*)(ws + WS_HALO);
    bf16_t* Xs_cur = XG + (size_t)MP * DM; bf16_t* Xs_alt = (bf16_t*)(ws + WS_XS2);
    float* SSQS_cur = (float*)(ws + WS_SSQS); float* SSQS_alt = (float*)(ws + WS_SSQS2);

    if (p.ws == nullptr) grid.sync();
    phase_prep(p, lds, G);
    xcd_barrier_arrive(bar); gap_convert(p, 0, lds, G); gap0_extras(p, lds, G); xcd_barrier_wait(bar);

    for (int ph = 0; ph < 16; ++ph) {
        const int q = ph & 7, layer = (ph >> 3) * 2 + (q >= 5 ? 1 : 0);
        const int kind = q < 5 ? q : (q == 5 ? 6 : q - 3);
        if (kind == 0) {
            const int e = layer >> 1;
            const bf16_t* Wt = (const bf16_t*)(ws + WS_WIN) + (size_t)e * DIN * DM;
            pg8::Gemm g{XG, Wt, MP, DIN, DM, DM, DM, 0};
            pg8::StaticOrder S; S.init(MP, DIN, G, (int)blockIdx.x);
            pg8::Unit u0; const int pm0 = S.next(0, u0) ? u0.pm : -1;
            if (pm0 >= 0) fill_rs_table(lds, SSQ, pm0);
            EpiE1 E{SSQ, (bf16_t*)(ws + WS_U), (float*)(ws + WS_VSSQ), lds, pm0};
            pg8::gemm_phase<EpiE1>(lds, g, S, E);
            SkE1 Es{SSQS_cur, (bf16_t*)(ws + WS_U), (float*)(ws + WS_VSSQS)};
            skinny_gemm_k1024<SkE1>(lds, Xs_cur, DM, Wt, DM, DIN, Es, G);
        } else if (kind == 1) {
            phase_e2(p, layer >> 1, lds, G);
        } else if (kind == 2) {
            const int e = layer >> 1;
            const bf16_t* Wt = (const bf16_t*)(ws + WS_WOUT) + (size_t)e * DM * DM;
            pg8::Gemm g{(const bf16_t*)(ws + WS_AB), Wt, MP, DM, DM, DM, DM, 0};
            pg8::StaticOrder S; S.init(MP, DM, G, (int)blockIdx.x);
            EpiRes E{XG, SSQ, nullptr, nullptr, lds, nullptr};
            pg8::gemm_phase<EpiRes>(lds, g, S, E);
            SkRes Es{Xs_cur, Xs_cur, SSQS_cur, nullptr, nullptr};
            skinny_gemm<4, 8, SkRes>(lds, (const bf16_t*)(ws + WS_AB) + (size_t)MP * DM, DM, 0, Wt, DM, DM, DM, Es, G);
        } else if (kind == 6) {
            const int o = layer >> 1;
            const bf16_t* Wt = (const bf16_t*)(ws + WS_WP) + (size_t)o * DM * 256;
            pg8::Gemm g{(const bf16_t*)(ws + WS_PA), Wt, MP, DM, 256, DM, 256, 256};
            pg8::StaticOrder S; S.init(MP, DM, G, (int)blockIdx.x);
            { pg8::Unit u0; if (S.next(0, u0)) pool_tile_prep(p, layer, u0.pm, u0.pn, lds); }
            EpiRes E{XG, SSQ2, p.pool_b + o * DM, p.pool_scale + o * DM, lds, nullptr};
            pg8::gemm_phase<EpiRes>(lds, g, S, E);
            SkRes Es{Xs_cur, Xs_alt, SSQS_alt, p.pool_b + o * DM, p.pool_scale + o * DM};
            skinny_pool<SkRes>(p, layer, Wt, Es, G, Xs_cur, SSQS_cur);
            { bf16_t* tx = Xs_cur; Xs_cur = Xs_alt; Xs_alt = tx; float* ts = SSQS_cur; SSQS_cur = SSQS_alt; SSQS_alt = ts; }
        } else if (kind == 3) {
            const bf16_t* Wt = (const bf16_t*)(ws + WS_W1) + (size_t)layer * DFF * DM;
            pg8::Gemm g{XG, Wt, MP, DFF, DM, DM, DM, 0};
            pg8::StaticOrder S; S.init(MP, DFF, G, (int)blockIdx.x);
            pg8::Unit u0; const int pm0 = S.next(0, u0) ? u0.pm : -1;
            const float* ssq_in = (layer & 1) ? SSQ2 : SSQ;
            if (pm0 >= 0) fill_rs_table(lds, ssq_in, pm0);
            EpiF1 E{ssq_in, (bf16_t*)(ws + WS_H), lds, pm0};
            pg8::gemm_phase<EpiF1>(lds, g, S, E);
            SkF1 Es{SSQS_cur, (bf16_t*)(ws + WS_H)};
            skinny_gemm_k1024<SkF1>(lds, Xs_cur, DM, Wt, DM, DFF, Es, G);
        } else {
            const bf16_t* Wt = (const bf16_t*)(ws + WS_W2) + (size_t)layer * DM * DFF;
            pg8::Gemm g{(const bf16_t*)(ws + WS_H), Wt, MP, DM, DFF, DFF, DFF, 0};
            pg8::StaticOrder S; S.init(MP, DM, G, (int)blockIdx.x);
            EpiRes E{XG, SSQ, nullptr, nullptr, lds, (layer & 1) ? nullptr : HALO};
            pg8::gemm_phase<EpiRes>(lds, g, S, E);
            SkRes Es{Xs_cur, Xs_cur, SSQS_cur, nullptr, nullptr};
            skinny_gemm_k4096<SkRes>(lds, (const bf16_t*)(ws + WS_H) + (size_t)MP * DFF, DFF, Wt, DFF, DM, Es, G);
        }
        xcd_barrier_arrive(bar); gap_convert(p, ph + 1, lds, G); xcd_barrier_wait(bar);
    }
    phase_final(p, G, Xs_cur, SSQS_cur);
}

extern "C" void kernel_launch(void* const* d_in, const int* in_sizes, int n_in, void* d_out, int out_size, void* d_ws, size_t ws_size, hipStream_t stream) {
    static int grid_blocks = 0;
    if (grid_blocks == 0) {
        if (n_in != 25 || (size_t)out_size != O_END || ws_size < WS_END) {
            fprintf(stderr, "kernel_launch: unexpected shapes: n_in %d out %d (want %zu) ws %zu (need %zu)\n", n_in, out_size, (size_t)O_END, ws_size, (size_t)WS_END);
            grid_blocks = -1; return;
        }
        int dev = 0, cus = 0, per_cu = 0;
        hipGetDevice(&dev);
        hipDeviceGetAttribute(&cus, hipDeviceAttributeMultiprocessorCount, dev);
        if (hipFuncSetAttribute((const void*)fwd_megakernel, hipFuncAttributeMaxDynamicSharedMemorySize, LDS_BYTES) != hipSuccess) { fprintf(stderr, "kernel_launch: hipFuncSetAttribute failed\n"); grid_blocks = -1; return; }
        if (hipOccupancyMaxActiveBlocksPerMultiprocessor(&per_cu, (const void*)fwd_megakernel, NTHR, LDS_BYTES) != hipSuccess || per_cu < 1) { fprintf(stderr, "kernel_launch: occupancy query failed (%d)\n", per_cu); (void)hipGetLastError(); per_cu = 1; }
        grid_blocks = cus * 1;
        if (grid_blocks != 256) { fprintf(stderr, "kernel_launch: this kernel is laid out for 256 CUs, found %d\n", cus); grid_blocks = -1; return; }
    }
    if (grid_blocks < 0) return;
    Params p{};
    const float** pp = (const float**)&p;
    for (int i = 0; i < 25; ++i) pp[i] = (const float*)d_in[i];
    p.out = (float*)d_out; p.ws = (unsigned char*)d_ws;
    if (hipMemsetAsync((char*)d_ws + WS_BAR, 0, 16384, stream) != hipSuccess) { fprintf(stderr, "kernel_launch: memset failed\n"); return; }
    void* args[] = {&p};
    hipError_t e = hipLaunchCooperativeKernel((const void*)fwd_megakernel, dim3(grid_blocks), dim3(NTHR), args, LDS_BYTES, stream);
    if (e != hipSuccess) fprintf(stderr, "cooperative launch failed: %s (grid %d)\n", hipGetErrorString(e), grid_blocks);
}
```

```cpp
#include <hip/hip_runtime.h>
#include <hip/hip_cooperative_groups.h>
#include <cstdio>
namespace cg = cooperative_groups;

#define LAS __attribute__((address_space(3)))
typedef unsigned short bf16_t;
typedef short bf16x8 __attribute__((ext_vector_type(8)));
typedef float f32x4 __attribute__((ext_vector_type(4)));
typedef float f32x2 __attribute__((ext_vector_type(2)));
typedef unsigned u32x4 __attribute__((ext_vector_type(4)));
typedef unsigned u32x2 __attribute__((ext_vector_type(2)));

constexpr int DM = 1024, NBATCH = 8, SEQ = 2048, MP = NBATCH * SEQ, MS = 128, MR = MP + MS, MPAD = 16640;
constexpr int DFF = 4096, WA = 512, WB = 512, DIN = 2048;
constexpr float EPS = 1e-6f;
constexpr int NTHR = 512;
constexpr int LDS_BYTES = 148 * 1024;

constexpr size_t O_YP = 0, O_YS = O_YP + (size_t)MP * DM, O_SGUV = O_YS + (size_t)MS * DM, O_CONVP = O_SGUV + 2 * MS * WA,
                 O_CONVS = O_CONVP + 2 * NBATCH * 3 * WB, O_HP = O_CONVS + 2 * MS * 3 * WB, O_HS = O_HP + 2 * NBATCH * WB,
                 O_POOLP = O_HS + 2 * MS * WB, O_POOLS = O_POOLP + 2 * NBATCH * 15 * DM, O_END = O_POOLS + (size_t)2 * MS * 15 * DM;

constexpr size_t WS_WIN = 0;
constexpr size_t WS_WOUT = WS_WIN + (size_t)2 * DIN * DM * 2;
constexpr size_t WS_W1 = WS_WOUT + (size_t)2 * DM * DM * 2;
constexpr size_t WS_W2 = WS_W1 + (size_t)4 * DFF * DM * 2;
constexpr size_t WS_WP = WS_W2 + (size_t)4 * DFF * DM * 2;
constexpr size_t WS_GW = WS_WP + (size_t)2 * DM * 256 * 2;
constexpr size_t WS_SW = WS_GW + (size_t)2 * 2 * 8 * 64 * 64 * 2;
constexpr size_t WS_SP = WS_SW + (size_t)2 * 8 * 128 * 128 * 2;
constexpr size_t WS_SSQ = WS_SP + 4096;
constexpr size_t WS_VSSQ = WS_SSQ + (size_t)MPAD * 16 * 4;
constexpr size_t WS_XG = WS_VSSQ + (size_t)MPAD * 8 * 4;
constexpr size_t WS_H = WS_XG + (size_t)MPAD * DM * 2;
constexpr size_t WS_U = WS_H, WS_VP = WS_U + (size_t)MPAD * 512 * 2, WS_GG = WS_VP + (size_t)MPAD * 512 * 2, WS_XB = WS_GG + (size_t)MPAD * 512 * 2,
                 WS_AB = WS_XB + (size_t)MPAD * 512 * 2, WS_PA = WS_H;
constexpr size_t WS_SSQS = WS_H + (size_t)MPAD * DFF * 2;
constexpr size_t WS_VSSQS = WS_SSQS + (size_t)MS * 64 * 4;
constexpr size_t WS_CG = WS_VSSQS + (size_t)MS * 32 * 4;
constexpr size_t WS_BAR = WS_CG + (size_t)2 * 1024 * 128 * 8;
constexpr size_t WS_SPSUM = WS_BAR + 16384;
constexpr size_t WS_SSQ2 = WS_SPSUM + (size_t)2 * MS * DM * 4;
constexpr size_t WS_HALO = WS_SSQ2 + (size_t)MPAD * 16 * 4;
constexpr size_t WS_XS2 = WS_HALO + (size_t)64 * 16 * DM * 2;
constexpr size_t WS_SSQS2 = WS_XS2 + (size_t)MS * DM * 2;
constexpr size_t WS_END = WS_SSQS2 + (size_t)MS * 64 * 4;

struct Params {
    const float *x_prompt, *x_sample, *state_conv, *state_rglru, *state_pool;
    const float *norm_mix, *norm_ffn, *norm_final, *w_in, *w_out, *v_norm, *sgu_w, *sgu_b;
    const float *conv_w, *conv_b, *gate_a_w, *gate_a_b, *gate_x_w, *gate_x_b, *lru_lambda;
    const float *pool_w, *pool_b, *pool_scale, *ffn_w1, *ffn_w2;
    float* out;
    unsigned char* ws;
};

__device__ __forceinline__ int opaque_tid() { int t = threadIdx.x; asm volatile("" : "+v"(t)); return t; }
__device__ __forceinline__ unsigned cvt_pk_bf16(float lo, float hi) { unsigned r; asm volatile("v_cvt_pk_bf16_f32 %0, %1, %2" : "=v"(r) : "v"(lo), "v"(hi)); return r; }
__device__ __forceinline__ float bf2f(unsigned short b) { return __uint_as_float(((unsigned)b) << 16); }
__device__ __forceinline__ float bflo(unsigned w) { return __uint_as_float(w << 16); }
__device__ __forceinline__ float bfhi(unsigned w) { return __uint_as_float(w & 0xffff0000u); }
__device__ __forceinline__ unsigned short f2bf(float f) { return (unsigned short)(cvt_pk_bf16(f, 0.f) & 0xffffu); }
__device__ __forceinline__ void bf8_to_f32(u32x4 w, f32x4& lo, f32x4& hi) {
    lo[0] = bflo(w.x); lo[1] = bfhi(w.x); lo[2] = bflo(w.y); lo[3] = bfhi(w.y);
    hi[0] = bflo(w.z); hi[1] = bfhi(w.z); hi[2] = bflo(w.w); hi[3] = bfhi(w.w);
}
__device__ __forceinline__ void st_wt16(void* base, unsigned off, u32x4 v) { const __amdgpu_buffer_rsrc_t rs = __builtin_amdgcn_make_buffer_rsrc(base, 0, 0x7fffffff, 0x00020000); __builtin_amdgcn_raw_buffer_store_b128(v, rs, off, 0, 16); }
__device__ __forceinline__ void st_wt8(void* base, unsigned off, u32x2 v) { const __amdgpu_buffer_rsrc_t rs = __builtin_amdgcn_make_buffer_rsrc(base, 0, 0x7fffffff, 0x00020000); __builtin_amdgcn_raw_buffer_store_b64(v, rs, off, 0, 16); }
__device__ __forceinline__ float gelu_t(float x) {
    const float z = x * (0.7978845608f + 0.0356774081f * x * x);
    const float e = __builtin_amdgcn_exp2f(z * 2.885390082f);
    return x - x * __builtin_amdgcn_rcpf(e + 1.0f);
}
__device__ __forceinline__ f32x2 gelu_t2(f32x2 x) {
    const f32x2 t = x * x;
    const f32x2 u = t * 0.1029432397f + 2.302208198f;
    const f32x2 a = x * u;
    f32x2 e; e.x = __builtin_amdgcn_exp2f(a.x); e.y = __builtin_amdgcn_exp2f(a.y);
    const f32x2 d = e + 1.0f;
    f32x2 r; r.x = __builtin_amdgcn_rcpf(d.x); r.y = __builtin_amdgcn_rcpf(d.y);
    return x - x * r;
}
__device__ __forceinline__ float sigmoid_f(float x) { return __builtin_amdgcn_rcpf(1.0f + __builtin_amdgcn_exp2f(-1.442695041f * x)); }
__device__ __forceinline__ float row_rs16(const float* ssq, int row) {
    const f32x4* q = (const f32x4*)(ssq + (size_t)row * 16);
    const f32x4 a = q[0], b = q[1], c = q[2], d = q[3];
    const float s = (a[0] + a[1] + a[2] + a[3]) + (b[0] + b[1] + b[2] + b[3]) + (c[0] + c[1] + c[2] + c[3]) + (d[0] + d[1] + d[2] + d[3]);
    return __builtin_amdgcn_rsqf(s * (1.0f / 1024.0f) + EPS);
}
__device__ __forceinline__ float row_rs8(const float* vssq, int row) {
    const f32x4* q = (const f32x4*)(vssq + (size_t)row * 8);
    const f32x4 a = q[0], b = q[1];
    const float s = (a[0] + a[1] + a[2] + a[3]) + (b[0] + b[1] + b[2] + b[3]);
    return __builtin_amdgcn_rsqf(s * (1.0f / 512.0f) + EPS);
}


__device__ __forceinline__ float rs_sample_q(const float* ssqs, int r, int fq) {
    const f32x4* q = (const f32x4*)(ssqs + (size_t)r * 64 + fq * 16);
    const f32x4 a = q[0], b = q[1], c = q[2], d = q[3];
    float s = (a[0] + a[1] + a[2] + a[3]) + (b[0] + b[1] + b[2] + b[3]) + (c[0] + c[1] + c[2] + c[3]) + (d[0] + d[1] + d[2] + d[3]);
    s += __shfl_xor(s, 16); s += __shfl_xor(s, 32);
    return __builtin_amdgcn_rsqf(s * (1.0f / 1024.0f) + EPS);
}
__device__ __forceinline__ float rs_sample_full(const float* ssqs, int r) {
    float s = 0.f;
#pragma unroll
    for (int i = 0; i < 16; ++i) { const f32x4 a = *(const f32x4*)(ssqs + (size_t)r * 64 + i * 4); s += (a[0] + a[1]) + (a[2] + a[3]); }
    return __builtin_amdgcn_rsqf(s * (1.0f / 1024.0f) + EPS);
}
__device__ __forceinline__ float rsv_sample_full(const float* vssqs, int r) {
    float s = 0.f;
#pragma unroll
    for (int i = 0; i < 8; ++i) { const f32x4 a = *(const f32x4*)(vssqs + (size_t)r * 32 + i * 4); s += (a[0] + a[1]) + (a[2] + a[3]); }
    return __builtin_amdgcn_rsqf(s * (1.0f / 512.0f) + EPS);
}

#define XB_TMO      128
#define XB_XCNT(j)  (256  + 64 * (j))
#define XB_XSUB(j)  (1280 + 64 * (j))
#define XB_XGEN(j)  (2304 + 64 * (j))
#define XB_TOP      3328
#define XB_TOPGEN   3392
#define XCD_BAR_WORDS 3456
#define XB_SPIN_CAP (1u << 22)
__device__ __forceinline__ unsigned xb_ld(unsigned* p)              { return __hip_atomic_load(p, __ATOMIC_RELAXED, __HIP_MEMORY_SCOPE_AGENT); }
__device__ __forceinline__ unsigned xb_add(unsigned* p, unsigned v) { return __hip_atomic_fetch_add(p, v, __ATOMIC_RELAXED, __HIP_MEMORY_SCOPE_AGENT); }
__device__ __forceinline__ unsigned xb_xcc_id() { return (unsigned)__builtin_amdgcn_s_getreg((3 << 11) | 20) & 0xFu; }
#define XB_SPIN(cond, bar) do { unsigned _sp = 0; while (cond) { __builtin_amdgcn_s_sleep(1); \
    if ((++_sp & 255u) == 0u) { if (xb_ld(&(bar)[XB_TMO])) break; if (_sp > XB_SPIN_CAP) { atomicAdd(&(bar)[XB_TMO], 1u); break; } } } } while (0)
struct XcdBarrier { unsigned* bar; unsigned x; volatile LAS unsigned* st; };
__device__ __forceinline__ XcdBarrier xcd_barrier_post(unsigned* bar, volatile LAS unsigned* st) {
    XcdBarrier b; b.bar = bar; b.x = xb_xcc_id(); b.st = st;
    if (threadIdx.x == 0) (void)xb_add(&bar[XB_XCNT(b.x)], 1u);
    return b;
}
__device__ __forceinline__ void xcd_barrier_complete(unsigned* bar, unsigned x, unsigned& nloc, unsigned& nx) {
    const unsigned G = gridDim.x * gridDim.y * gridDim.z;
    unsigned sum, cnt, mine, sp = 0u;
    for (;;) {
        sum = 0u; cnt = 0u; mine = 0u;
#pragma unroll
        for (unsigned j = 0; j < 16; ++j) { const unsigned c = xb_ld(&bar[XB_XCNT(j)]); sum += c; cnt += (c > 0u) ? 1u : 0u; mine = (j == x) ? c : mine; }
        if (sum == G) break;
        __builtin_amdgcn_s_sleep(1);
        if ((++sp & 255u) == 0u) { if (xb_ld(&bar[XB_TMO])) break; if (sp > XB_SPIN_CAP) { atomicAdd(&bar[XB_TMO], 1u); break; } }
    }
    nloc = mine > 0u ? mine : 1u; nx = cnt > 0u ? cnt : 1u;
}
__device__ __forceinline__ void xcd_barrier_arrive(const XcdBarrier& b) {
    asm volatile("s_waitcnt vmcnt(0)" ::: "memory");
    __syncthreads();
    if (threadIdx.x == 0) {
        unsigned* bar = b.bar;
        __builtin_amdgcn_s_waitcnt(0);
        unsigned nloc = b.st[0], nx = b.st[1];
        if (nloc == 0u) { xcd_barrier_complete(bar, b.x, nloc, nx); b.st[0] = nloc; b.st[1] = nx; }
        const unsigned old = xb_add(&bar[XB_XSUB(b.x)], 1u);
        const unsigned gen = old / nloc;
        unsigned leader = 0u, tg = 0u, lastx = 0u;
        if (old + 1u == (gen + 1u) * nloc) {
            leader = 1u;
            __builtin_amdgcn_fence(__ATOMIC_RELEASE, "agent");
            asm volatile("s_waitcnt vmcnt(0)" ::: "memory");
            const unsigned og = xb_add(&bar[XB_TOP], 1u);
            tg = og / nx;
            if (og + 1u == (tg + 1u) * nx) { xb_add(&bar[XB_TOPGEN], 1u); lastx = 1u; }
        }
        b.st[2] = gen * 2u + leader; b.st[3] = tg * 2u + lastx;
    }
}
__device__ __forceinline__ void xcd_barrier_wait(const XcdBarrier& b) {
    if (threadIdx.x == 0) {
        unsigned* bar = b.bar;
        const unsigned s2 = b.st[2], s3 = b.st[3];
        const unsigned gen = s2 >> 1, leader = s2 & 1u, tg = s3 >> 1, lastx = s3 & 1u;
        if (leader) {
            if (!lastx) XB_SPIN(xb_ld(&bar[XB_TOPGEN]) == tg, bar);
            xb_add(&bar[XB_XGEN(b.x)], 1u);
            __builtin_amdgcn_fence(__ATOMIC_ACQUIRE, "agent");
            asm volatile("s_waitcnt vmcnt(0)" ::: "memory");
        } else {
            XB_SPIN(xb_ld(&bar[XB_XGEN(b.x)]) == gen, bar);
            __builtin_amdgcn_fence(__ATOMIC_ACQUIRE, "agent");
            asm volatile("s_waitcnt vmcnt(0)" ::: "memory");
        }
    }
    __syncthreads();
}

namespace pg8 {
constexpr int BM = 256, BK = 64, HALF = 128, HTB = HALF * BK * 2, STAGE_BYTES = 8 * HTB, NXCD = 8, WGM = 8;
__host__ __device__ __forceinline__ int lds_byte(int r, int c) { const int st = (r >> 4) * 2 + (c >> 5), rr = r & 15, cc = c & 31, ob = rr * 64 + cc * 2; return st * 1024 + (ob ^ (((ob >> 9) & 1) << 5)); }
__host__ __device__ __forceinline__ int perm32(int rho) { const int n = rho >> 4, i = rho & 15; return 8 * (i >> 2) + 4 * n + (i & 3); }
__host__ __device__ __forceinline__ void stage_rc(int b, int& R, int& C) { const int st = b / 1024, sb = b % 1024, swz = sb ^ (((sb >> 9) & 1) << 5); R = (st >> 1) * 16 + swz / 64; C = (st & 1) * 32 + (swz % 64) / 2; }

struct Unit { int pm, pn; };
struct Gemm { const bf16_t* A; const bf16_t* Bt; int M, N, K, lda, ldb, a_pn_koff; };

struct StaticOrder {
    int nM, nN, nwg, G, c;
    __device__ void init(int M, int N, int G_, int c_) { nM = M / BM; nN = N / BM; nwg = nM * nN; G = G_; c = c_; }
    __device__ bool next(int i, Unit& u) const {
        const long L = (long)i * G + c; if (L >= nwg) return false;
        int wgid = (int)L; { const int q = nwg / NXCD, r = nwg % NXCD, xcd = wgid % NXCD, off = wgid / NXCD; wgid = (xcd < r ? xcd * (q + 1) : r * (q + 1) + (xcd - r) * q) + off; }
        const int nig = WGM * nN, gid = wgid / nig, fm = gid * WGM, gsz = (nM - fm) < WGM ? (nM - fm) : WGM;
        u.pm = fm + ((wgid % nig) % gsz); u.pn = (wgid % nig) / gsz; return true;
    }
};

constexpr int RS_TAB_OFF = 131072, WT_OFF = 132096, WT_BYTES = 16 * 144;
constexpr int RS_TAB_OFF_UNUSED = 0;
__device__ __forceinline__ f32x4 zero4_b64() {
    f32x2 a, b; asm volatile("v_mov_b64 %0, 0" : "=v"(a)); asm volatile("v_mov_b64 %0, 0" : "=v"(b));
    return (f32x4){a.x, a.y, b.x, b.y};
}
template <class Epi>
__device__ __forceinline__ void gemm_phase(LAS unsigned char* lds, const Gemm g, const StaticOrder& S, const Epi& E) {
    const int tid = opaque_tid(), wid = __builtin_amdgcn_readfirstlane(tid >> 6), lane = tid & 63, wr = wid >> 2, wc = wid & 3, fr = lane & 15, fq = lane >> 4;
    const int K = g.K, nt = K / BK;
    unsigned voffA[2], voffB[2];
#pragma unroll
    for (int i = 0; i < 2; ++i) { int R, C; stage_rc(tid * 16 + i * 8192, R, C);
        const int Rb = 64 * (R >> 5) + 16 * ((R >> 2) & 3) + 4 * ((R >> 4) & 1) + (R & 3);
        voffA[i] = (unsigned)(R * g.lda + C) * 2u; voffB[i] = (unsigned)(Rb * g.ldb + C) * 2u; }
    const size_t kstep = (size_t)(BK * 2);
    const size_t hstepA = (size_t)HALF * g.lda * 2, hstepB = (size_t)8 * g.ldb * 2;
    const size_t tstepA = 2 * hstepA, tstepB = (size_t)BM * g.ldb * 2;
    const size_t pnoffA = (size_t)g.a_pn_koff * 2;
    const unsigned ldsw = (unsigned)wid * 1024u;
    const int aoff = lds_byte(wr * 64 + fr, fq * 8), boff = lds_byte(wc * 32 + fr, fq * 8);
#define PG8_SA(b, h) (((b) * 2 + (h)) * HTB)
#define PG8_SB(b, h) ((4 + (b) * 2 + (h)) * HTB)
#define PG8_STAGE(bufoff, gbase, voff) do { _Pragma("unroll") for (int _i = 0; _i < 2; ++_i) \
        __builtin_amdgcn_global_load_lds((const unsigned*)((const char*)(gbase) + (voff)[_i]), (LAS unsigned*)(lds + (bufoff) + ldsw + _i * 8192), 16, 0, 0); } while (0)
#define PG8_LDA(dst, b, h) do { _Pragma("unroll") for (int m = 0; m < 4; ++m) _Pragma("unroll") for (int k = 0; k < 2; ++k) dst[m][k] = *(const LAS bf16x8*)(lds + PG8_SA(b, h) + aoff + m * 2048 + k * 1024); } while (0)
#define PG8_LDB(dst, b, h) do { _Pragma("unroll") for (int n = 0; n < 2; ++n) _Pragma("unroll") for (int k = 0; k < 2; ++k) dst[n][k] = *(const LAS bf16x8*)(lds + PG8_SB(b, h) + boff + n * 2048 + k * 1024); } while (0)
#define PG8_MMA(ai, bj, At, Bt) do { __builtin_amdgcn_s_setprio(1); _Pragma("unroll") for (int m = 0; m < 4; ++m) _Pragma("unroll") for (int n = 0; n < 2; ++n) _Pragma("unroll") for (int k = 0; k < 2; ++k) \
        acc[ai][bj][m][n] = __builtin_amdgcn_mfma_f32_16x16x32_bf16(Bt[n][k], At[m][k], acc[ai][bj][m][n], 0, 0, 0); __builtin_amdgcn_s_setprio(0); } while (0)
#define PG8_WAIT_V(n) asm volatile("s_waitcnt vmcnt(" #n ")" ::: "memory")
#define PG8_WAIT_L(n) asm volatile("s_waitcnt lgkmcnt(" #n ")" ::: "memory")
#define PG8_BAR __builtin_amdgcn_s_barrier()
#define PG8_SCHED __builtin_amdgcn_sched_barrier(0)
    Unit cur, nxt; int ui = 0;
    if (!S.next(0, cur)) return;
    f32x4 acc[2][2][4][2];
#pragma unroll
    for (int a = 0; a < 2; ++a)
#pragma unroll
        for (int b = 0; b < 2; ++b)
#pragma unroll
            for (int m = 0; m < 4; ++m)
#pragma unroll
                for (int n = 0; n < 2; ++n) acc[a][b][m][n] = zero4_b64();
    bf16x8 At[4][2], B0[2][2], B1[2][2];
    const char* cA = (const char*)g.A + (size_t)cur.pm * tstepA + (size_t)cur.pn * pnoffA; const char* cB = (const char*)g.Bt + (size_t)cur.pn * tstepB;
    PG8_STAGE(PG8_SB(0, 0), cB, voffB); PG8_STAGE(PG8_SA(0, 0), cA, voffA); PG8_STAGE(PG8_SB(0, 1), cB + hstepB, voffB); PG8_STAGE(PG8_SA(0, 1), cA + hstepA, voffA);
    if (wr == 1) PG8_BAR;
    PG8_WAIT_V(4); PG8_BAR;
    PG8_STAGE(PG8_SB(1, 0), cB + kstep, voffB); PG8_STAGE(PG8_SA(1, 0), cA + kstep, voffA); PG8_STAGE(PG8_SB(1, 1), cB + hstepB + kstep, voffB);
    PG8_WAIT_V(6); PG8_BAR;
    for (;;) {
        const bool has_next = S.next(ui + 1, nxt);
        const char* nA = has_next ? (const char*)g.A + (size_t)nxt.pm * tstepA + (size_t)nxt.pn * pnoffA : cA; const char* nB = has_next ? (const char*)g.Bt + (size_t)nxt.pn * tstepB : cB;
        for (int t = 0; t < nt; t += 2) {
            const bool last = (t == nt - 2);
            const char* a1 = cA + (size_t)(t + 1) * kstep;
            const char* a2 = last ? nA : cA + (size_t)(t + 2) * kstep; const char* b2 = last ? nB : cB + (size_t)(t + 2) * kstep;
            const char* a3 = a2 + kstep; const char* b3 = b2 + kstep;
            PG8_LDB(B0, 0, 0); PG8_SCHED; PG8_LDA(At, 0, 0); PG8_STAGE(PG8_SA(1, 1), a1 + hstepA, voffA);
            PG8_WAIT_L(8); PG8_BAR; PG8_WAIT_L(0); PG8_MMA(0, 0, At, B0); PG8_BAR; PG8_SCHED;
            PG8_LDB(B1, 0, 1); PG8_STAGE(PG8_SB(0, 0), b2, voffB);
            PG8_BAR; PG8_WAIT_L(0); PG8_MMA(0, 1, At, B1); PG8_BAR;
            PG8_LDA(At, 0, 1); PG8_STAGE(PG8_SA(0, 0), a2, voffA);
            PG8_BAR; PG8_WAIT_L(0); PG8_MMA(1, 0, At, B0); PG8_BAR; PG8_SCHED;
            PG8_STAGE(PG8_SB(0, 1), b2 + hstepB, voffB);
            PG8_WAIT_V(6); PG8_BAR; PG8_MMA(1, 1, At, B1); PG8_BAR;
            PG8_LDB(B0, 1, 0); PG8_SCHED; PG8_LDA(At, 1, 0); PG8_STAGE(PG8_SA(0, 1), a2 + hstepA, voffA);
            PG8_WAIT_L(8); PG8_BAR; PG8_WAIT_L(0); PG8_MMA(0, 0, At, B0); PG8_BAR; PG8_SCHED;
            PG8_LDB(B1, 1, 1); PG8_STAGE(PG8_SB(1, 0), b3, voffB);
            PG8_BAR; PG8_WAIT_L(0); PG8_MMA(0, 1, At, B1); PG8_BAR;
            PG8_LDA(At, 1, 1); PG8_STAGE(PG8_SA(1, 0), a3, voffA);
            PG8_BAR; PG8_WAIT_L(0); PG8_MMA(1, 0, At, B0); PG8_BAR; PG8_SCHED;
            PG8_STAGE(PG8_SB(1, 1), b3 + hstepB, voffB);
            PG8_WAIT_V(6); PG8_BAR; PG8_MMA(1, 1, At, B1); PG8_BAR;
        }
        E(acc, cur, wr, wc, fr, fq);
        if (!has_next) break;
#pragma unroll
        for (int a = 0; a < 2; ++a)
#pragma unroll
            for (int b = 0; b < 2; ++b)
#pragma unroll
                for (int m = 0; m < 4; ++m)
#pragma unroll
                    for (int n = 0; n < 2; ++n) acc[a][b][m][n] = zero4_b64();
        cur = nxt; cA = nA; cB = nB; ++ui;
    }
    PG8_WAIT_V(0);
    if (wr == 0) PG8_BAR;
    PG8_BAR;
#undef PG8_SA
#undef PG8_SB
#undef PG8_STAGE
#undef PG8_LDA
#undef PG8_LDB
#undef PG8_MMA
#undef PG8_WAIT_V
#undef PG8_WAIT_L
#undef PG8_BAR
#undef PG8_SCHED
}
}

__device__ __forceinline__ void store_bf4(bf16_t* p, f32x4 v) { u32x2 w; w.x = cvt_pk_bf16(v[0], v[1]); w.y = cvt_pk_bf16(v[2], v[3]); *(u32x2*)p = w; }
__device__ __forceinline__ u32x4 pack_bf8(f32x4 a, f32x4 b) { u32x4 w; w.x = cvt_pk_bf16(a[0], a[1]); w.y = cvt_pk_bf16(a[2], a[3]); w.z = cvt_pk_bf16(b[0], b[1]); w.w = cvt_pk_bf16(b[2], b[3]); return w; }
__device__ __forceinline__ void wave_store_lines(LAS unsigned char* wbuf, bf16_t* g0, size_t ld, u32x4 w0, u32x4 w1, int lane) {
    const int fr = lane & 15, fq = lane >> 4;
    *(LAS u32x4*)(wbuf + fr * 144 + fq * 32) = w0; *(LAS u32x4*)(wbuf + fr * 144 + fq * 32 + 16) = w1;
    asm volatile("s_waitcnt lgkmcnt(0)" ::: "memory");
#pragma unroll
    for (int i = 0; i < 2; ++i) { const int row = 8 * i + (lane >> 3); const u32x4 t = *(const LAS u32x4*)(wbuf + row * 144 + (lane & 7) * 16); *(u32x4*)(g0 + (size_t)row * ld + (lane & 7) * 8) = t; }
    asm volatile("" ::: "memory");
}
__device__ __forceinline__ void wave_load_lines(LAS unsigned char* wbuf, const bf16_t* g0, size_t ld, u32x4& w0, u32x4& w1, int lane) {
    const int fr = lane & 15, fq = lane >> 4;
    u32x4 t[2];
#pragma unroll
    for (int i = 0; i < 2; ++i) t[i] = *(const u32x4*)(g0 + (size_t)(8 * i + (lane >> 3)) * ld + (lane & 7) * 8);
#pragma unroll
    for (int i = 0; i < 2; ++i) *(LAS u32x4*)(wbuf + (8 * i + (lane >> 3)) * 144 + (lane & 7) * 16) = t[i];
    asm volatile("s_waitcnt lgkmcnt(0)" ::: "memory");
    w0 = *(const LAS u32x4*)(wbuf + fr * 144 + fq * 32); w1 = *(const LAS u32x4*)(wbuf + fr * 144 + fq * 32 + 16);
    asm volatile("s_waitcnt lgkmcnt(0)" ::: "memory");
}
__device__ __forceinline__ void wave_store_lines_u(LAS unsigned char* wl, LAS unsigned char* rl, char* gbase, unsigned off0, unsigned off1, u32x4 w0, u32x4 w1) {
    *(LAS u32x4*)(wl) = w0; *(LAS u32x4*)(wl + 16) = w1;
    asm volatile("" ::: "memory");
    const u32x4 t0 = *(const LAS u32x4*)(rl), t1 = *(const LAS u32x4*)(rl + 8 * 144);
    asm volatile("" ::: "memory");
    {
        const __amdgpu_buffer_rsrc_t rs = __builtin_amdgcn_make_buffer_rsrc((void*)gbase, 0, 0x7fffffff, 0x00020000);
        __builtin_amdgcn_raw_buffer_store_b128(t0, rs, off0, 0, 16);
        __builtin_amdgcn_raw_buffer_store_b128(t1, rs, off1, 0, 16);
    }
}
__device__ __forceinline__ float unit_rs(LAS unsigned char* lds, const float* ssq, int pm0, int pm, int lr) {
    return *(const LAS float*)(lds + pg8::RS_TAB_OFF + lr * 4);
}
__device__ __forceinline__ void fill_rs_table(LAS unsigned char* lds, const float* ssq, int pm0) {
    const int t = opaque_tid();
    if (t < 256) *(LAS float*)(lds + pg8::RS_TAB_OFF + t * 4) = row_rs16(ssq, pm0 * 256 + t);
    __syncthreads();
}

struct EpiE1 {
    const float* ssq; bf16_t* U; float* vssq; LAS unsigned char* lds; int pm0;
    __device__ __forceinline__ void operator()(const f32x4 (&acc)[2][2][4][2], const pg8::Unit& u, int wr, int wc, int fr_, int fq_) const {
        int lane_o = fq_ * 16 + fr_; asm volatile("" : "+v"(lane_o));
        const int fr = lane_o & 15, fq = lane_o >> 4;
        const int sec = u.pn >> 1, lane = lane_o;
        bf16_t* dst = U + (size_t)sec * ((size_t)MPAD * 512) + (u.pn & 1) * 256 + wc * 64;
        LAS unsigned char* wbuf = lds + pg8::WT_OFF + (wr * 4 + wc) * pg8::WT_BYTES;
        LAS unsigned char* wl = wbuf + fr * 144 + fq * 32; LAS unsigned char* rl = wbuf + (lane >> 3) * 144 + (lane & 7) * 16;
        const unsigned off0 = (unsigned)(lane >> 3) * (512 * 2) + (lane & 7) * 16, off1 = off0 + 8u * (512 * 2);
#pragma unroll
        for (int ai = 0; ai < 2; ++ai) {
#pragma unroll
            for (int m = 0; m < 4; ++m) {
                const int lr = ai * 128 + wr * 64 + m * 16 + fr, row = u.pm * 256 + lr;
                const float rs = unit_rs(lds, ssq, pm0, u.pm, lr);
                float sq = 0.f;
                u32x4 w[2];
#pragma unroll
                for (int bj = 0; bj < 2; ++bj) {
                    f32x4 v0 = acc[ai][bj][m][0] * rs, v1 = acc[ai][bj][m][1] * rs;
                    if (sec != 3) {
                        const f32x2 g0 = gelu_t2((f32x2){v0[0], v0[1]}), g1 = gelu_t2((f32x2){v0[2], v0[3]}), g2 = gelu_t2((f32x2){v1[0], v1[1]}), g3 = gelu_t2((f32x2){v1[2], v1[3]});
                        v0 = (f32x4){g0.x, g0.y, g1.x, g1.y}; v1 = (f32x4){g2.x, g2.y, g3.x, g3.y};
                    }
                    sq += v0[0] * v0[0] + v0[1] * v0[1] + v0[2] * v0[2] + v0[3] * v0[3] + v1[0] * v1[0] + v1[1] * v1[1] + v1[2] * v1[2] + v1[3] * v1[3];
                    w[bj] = pack_bf8(v0, v1);
                }
                wave_store_lines_u(wl, rl, (char*)(dst + (size_t)(u.pm * 256 + ai * 128 + wr * 64 + m * 16) * 512), off0, off1, w[0], w[1]);
                if (sec == 1) {
                    sq += __shfl_xor(sq, 16); sq += __shfl_xor(sq, 32);
                    if (fq == 0) vssq[(size_t)row * 8 + (u.pn & 1) * 4 + wc] = sq;
                }
            }
        }
    }
};

struct EpiF1 {
    const float* ssq; bf16_t* H; LAS unsigned char* lds; int pm0;
    __device__ __forceinline__ void operator()(const f32x4 (&acc)[2][2][4][2], const pg8::Unit& u, int wr, int wc, int fr_, int fq_) const {
        int lane_o = fq_ * 16 + fr_; asm volatile("" : "+v"(lane_o));
        const int fr = lane_o & 15, fq = lane_o >> 4;
        const int lane = lane_o;
        bf16_t* dst = H + u.pn * 256 + wc * 64;
        LAS unsigned char* wbuf = lds + pg8::WT_OFF + (wr * 4 + wc) * pg8::WT_BYTES;
        LAS unsigned char* wl = wbuf + fr * 144 + fq * 32; LAS unsigned char* rl = wbuf + (lane >> 3) * 144 + (lane & 7) * 16;
        const unsigned off0 = (unsigned)(lane >> 3) * (DFF * 2) + (lane & 7) * 16, off1 = off0 + 8u * (DFF * 2);
#pragma unroll
        for (int ai = 0; ai < 2; ++ai) {
#pragma unroll
            for (int m = 0; m < 4; ++m) {
                const int lr = ai * 128 + wr * 64 + m * 16 + fr;
                const float rs = unit_rs(lds, ssq, pm0, u.pm, lr);
                u32x4 w[2];
#pragma unroll
                for (int bj = 0; bj < 2; ++bj) {
                    f32x4 v0 = acc[ai][bj][m][0] * rs, v1 = acc[ai][bj][m][1] * rs;
#pragma unroll
                    for (int j = 0; j < 4; ++j) { v0[j] = fmaxf(v0[j], 0.f); v1[j] = fmaxf(v1[j], 0.f); }
                    v0 = v0 * v0; v1 = v1 * v1;
                    w[bj] = pack_bf8(v0, v1);
                }
                wave_store_lines_u(wl, rl, (char*)(dst + (size_t)(u.pm * 256 + ai * 128 + wr * 64 + m * 16) * DFF), off0, off1, w[0], w[1]);
            }
        }
    }
};

struct EpiRes {
    bf16_t* X; float* ssq; const float* bias; const float* cscale; LAS unsigned char* lds; bf16_t* halo;
    __device__ __forceinline__ void operator()(const f32x4 (&acc)[2][2][4][2], const pg8::Unit& u, int wr, int wc, int fr_, int fq_) const {
        int lane_o = fq_ * 16 + fr_; asm volatile("" : "+v"(lane_o));
        const int fr = lane_o & 15, fq = lane_o >> 4;
        const int lane = lane_o;
        const int colw = u.pn * 256 + wc * 64;
        LAS unsigned char* wbuf = lds + pg8::WT_OFF + (wr * 4 + wc) * pg8::WT_BYTES;
        LAS unsigned char* wl = wbuf + fr * 144 + fq * 32; LAS unsigned char* rl = wbuf + (lane >> 3) * 144 + (lane & 7) * 16;
        const unsigned off0 = (unsigned)(lane >> 3) * (DM * 2) + (lane & 7) * 16, off1 = off0 + 8u * (DM * 2);
        f32x4 bv[2][2], cv[2][2];
#pragma unroll
        for (int bj = 0; bj < 2; ++bj)
#pragma unroll
            for (int hh = 0; hh < 2; ++hh) {
                const int col = colw + 16 * fq + 8 * bj + 4 * hh;
                bv[bj][hh] = bias ? *(const f32x4*)(bias + col) : (f32x4){0.f, 0.f, 0.f, 0.f};
                cv[bj][hh] = bias ? *(const f32x4*)(cscale + col) : (f32x4){1.f, 1.f, 1.f, 1.f};
            }
#pragma unroll
        for (int ai = 0; ai < 2; ++ai) {
            u32x4 t[4][2];
#pragma unroll
            for (int m = 0; m < 4; ++m) {
                const char* xg0 = (const char*)(X + (size_t)(u.pm * 256 + ai * 128 + wr * 64 + m * 16) * DM + colw);
                t[m][0] = *(const u32x4*)(xg0 + off0); t[m][1] = *(const u32x4*)(xg0 + off1);
            }
#pragma unroll
            for (int m = 0; m < 4; ++m) {
                const int row = u.pm * 256 + ai * 128 + wr * 64 + m * 16 + fr;
                char* xg0 = (char*)(X + (size_t)(u.pm * 256 + ai * 128 + wr * 64 + m * 16) * DM + colw);
                u32x4 xw[2];
                *(LAS u32x4*)(rl) = t[m][0]; *(LAS u32x4*)(rl + 8 * 144) = t[m][1];
                asm volatile("" ::: "memory");
                xw[0] = *(const LAS u32x4*)(wl); xw[1] = *(const LAS u32x4*)(wl + 16);
                asm volatile("" ::: "memory");
                float sq = 0.f;
                u32x4 w[2];
#pragma unroll
                for (int bj = 0; bj < 2; ++bj) {
                    const int col = colw + 16 * fq + 8 * bj;
                    f32x4 v0 = acc[ai][bj][m][0], v1 = acc[ai][bj][m][1];
                    if (bias) { v0 = (v0 + bv[bj][0]) * cv[bj][0]; v1 = (v1 + bv[bj][1]) * cv[bj][1]; }
                    f32x4 x0, x1; bf8_to_f32(xw[bj], x0, x1);
                    v0 = v0 + x0; v1 = v1 + x1;
                    sq += v0[0] * v0[0] + v0[1] * v0[1] + v0[2] * v0[2] + v0[3] * v0[3] + v1[0] * v1[0] + v1[1] * v1[1] + v1[2] * v1[2] + v1[3] * v1[3];
                    w[bj] = pack_bf8(v0, v1);
                }
                wave_store_lines_u(wl, rl, xg0, off0, off1, w[0], w[1]);
                if (halo && ai == 1 && m == 3 && wr == 1) wave_store_lines_u(wl, rl, (char*)(halo + (size_t)(u.pm * 16) * DM + colw), off0, off1, w[0], w[1]);
                sq += __shfl_xor(sq, 16); sq += __shfl_xor(sq, 32);
                if (fq == 0) ssq[(size_t)row * 16 + u.pn * 4 + wc] = sq;
            }
        }
    }
};

template <int KSPLIT, int STEPS, class Epi>
__device__ __forceinline__ void skinny_gemm(LAS unsigned char* lds, const bf16_t* A, int lda, int a_grp_koff, const bf16_t* Bt, int ldb, int N, int K, const Epi& E, int G) {
    const int tid = opaque_tid(), wave = tid >> 6, lane = tid & 63, fr = lane & 15, fq = lane >> 4;
    const int ntile = 8 * (N >> 4);
    constexpr int TPB = 8 / KSPLIT;
    const int klen = K / KSPLIT;
    for (int t0 = blockIdx.x * TPB; t0 < ntile; t0 += G * TPB) {
        const int tile = t0 + wave / KSPLIT, ks = wave % KSPLIT;
        const int rt = tile & 7, ct = tile >> 3;
        const bf16_t* ap = A + (size_t)(rt * 16 + fr) * lda + (ct >> 4) * a_grp_koff + ks * klen + fq * 8;
        const bf16_t* bp = Bt + (size_t)(ct * 16 + fr) * ldb + ks * klen + fq * 8;
        f32x2 pp = (f32x2){0.f, 0.f};
        if (ks == 0) pp = E.pre(rt * 16 + fr, ct * 16 + fq * 4, fq);
        f32x4 acc = (f32x4){0.f, 0.f, 0.f, 0.f};
        const int krot = (int)(((unsigned)(wave * 5 + (int)blockIdx.x * 3) * 32u) % (unsigned)klen);
        for (int k = 0; k < klen; k += STEPS * 32) {
            bf16x8 a[STEPS], b[STEPS];
#pragma unroll
            for (int j = 0; j < STEPS; ++j) { int kk = k + j * 32 + krot; kk = kk >= klen ? kk - klen : kk; a[j] = *(const bf16x8*)(ap + kk); b[j] = *(const bf16x8*)(bp + kk); }
#pragma unroll
            for (int j = 0; j < STEPS; ++j) acc = __builtin_amdgcn_mfma_f32_16x16x32_bf16(b[j], a[j], acc, 0, 0, 0);
        }
        if (KSPLIT > 1) {
            *(LAS f32x4*)(lds + (wave * 64 + lane) * 16) = acc;
            __syncthreads();
            if (ks == 0) {
#pragma unroll
                for (int j = 1; j < KSPLIT; ++j) acc = acc + *(const LAS f32x4*)(lds + ((wave + j) * 64 + lane) * 16);
                E(rt * 16 + fr, ct * 16 + fq * 4, ct, fq, acc, pp);
            }
            __syncthreads();
        } else {
            E(rt * 16 + fr, ct * 16 + fq * 4, ct, fq, acc, pp);
        }
    }
}

template <class Epi>
__device__ __forceinline__ void skinny_gemm_k1024(LAS unsigned char* lds, const bf16_t* A, int lda, const bf16_t* Bt, int ldb, int N, const Epi& E, int G) {
    const int tid = opaque_tid(), wave = tid >> 6, lane = tid & 63, fr = lane & 15, fq = lane >> 4;
    const int nct = N >> 4;
    for (int ct = blockIdx.x; ct < nct; ct += G) {
        const bf16_t* ap = A + (size_t)(wave * 16 + fr) * lda + fq * 8;
        const bf16_t* bp = Bt + (size_t)(ct * 16 + fr) * ldb + (4 * wave) * 32 + fq * 8;
        const f32x2 pp = E.pre(wave * 16 + fr, ct * 16 + fq * 4, fq);
        bf16x8 a[32], bl[4];
#pragma unroll
        for (int q = 0; q < 4; ++q) bl[q] = *(const bf16x8*)(bp + q * 32);
#pragma unroll
        for (int j = 0; j < 32; ++j) a[j] = *(const bf16x8*)(ap + j * 32);
#pragma unroll
        for (int q = 0; q < 4; ++q) *(LAS bf16x8*)(lds + ((4 * wave + q) * 64 + lane) * 16) = bl[q];
        __syncthreads();
        f32x4 acc0 = (f32x4){0.f, 0.f, 0.f, 0.f}, acc1 = acc0;
#pragma unroll
        for (int j = 0; j < 32; j += 2) {
            const bf16x8 b0 = *(const LAS bf16x8*)(lds + (j * 64 + lane) * 16), b1 = *(const LAS bf16x8*)(lds + ((j + 1) * 64 + lane) * 16);
            acc0 = __builtin_amdgcn_mfma_f32_16x16x32_bf16(b0, a[j], acc0, 0, 0, 0);
            acc1 = __builtin_amdgcn_mfma_f32_16x16x32_bf16(b1, a[j + 1], acc1, 0, 0, 0);
        }
        E(wave * 16 + fr, ct * 16 + fq * 4, ct, fq, acc0 + acc1, pp);
        __syncthreads();
    }
}

template <class Epi>
__device__ __forceinline__ void skinny_gemm_k4096(LAS unsigned char* lds, const bf16_t* A, int lda, const bf16_t* Bt, int ldb, int N, const Epi& E, int G) {
    const int tid = opaque_tid(), wave = tid >> 6, lane = tid & 63, fr = lane & 15, fq = lane >> 4;
    const int npair = 4 * (N >> 4);
    for (int pr = blockIdx.x; pr < npair; pr += G) {
        const int ct = pr >> 2, rt0 = (pr & 3) * 2;
        const bf16_t* ap0 = A + (size_t)(rt0 * 16 + fr) * lda + wave * 512 + fq * 8;
        const bf16_t* ap1 = ap0 + (size_t)16 * lda;
        const bf16_t* bp = Bt + (size_t)(ct * 16 + fr) * ldb + wave * 512 + fq * 8;
        f32x2 pp = (f32x2){0.f, 0.f};
        if (wave < 2) pp = E.pre((rt0 + wave) * 16 + fr, ct * 16 + fq * 4, fq);
        bf16x8 b[16], a0[16], a1[16];
#pragma unroll
        for (int j = 0; j < 16; ++j) { b[j] = *(const bf16x8*)(bp + j * 32); a0[j] = *(const bf16x8*)(ap0 + j * 32); a1[j] = *(const bf16x8*)(ap1 + j * 32); }
        f32x4 acc0 = (f32x4){0.f, 0.f, 0.f, 0.f}, acc1 = acc0;
#pragma unroll
        for (int j = 0; j < 16; ++j) {
            acc0 = __builtin_amdgcn_mfma_f32_16x16x32_bf16(b[j], a0[j], acc0, 0, 0, 0);
            acc1 = __builtin_amdgcn_mfma_f32_16x16x32_bf16(b[j], a1[j], acc1, 0, 0, 0);
        }
        *(LAS f32x4*)(lds + ((wave * 2 + 0) * 64 + lane) * 16) = acc0;
        *(LAS f32x4*)(lds + ((wave * 2 + 1) * 64 + lane) * 16) = acc1;
        __syncthreads();
        if (wave < 2) {
            f32x4 acc = *(const LAS f32x4*)(lds + ((0 * 2 + wave) * 64 + lane) * 16);
#pragma unroll
            for (int j = 1; j < 8; ++j) acc = acc + *(const LAS f32x4*)(lds + ((j * 2 + wave) * 64 + lane) * 16);
            E((rt0 + wave) * 16 + fr, ct * 16 + fq * 4, ct, fq, acc, pp);
        }
        __syncthreads();
    }
}

__device__ __forceinline__ f32x2 ssqs_part(const float* ssqs, int r, int fq) {
    const f32x4* q = (const f32x4*)(ssqs + (size_t)r * 64 + fq * 16);
    const f32x4 a = q[0], b = q[1], c = q[2], d = q[3];
    f32x2 o; o.x = (a[0] + a[1] + a[2] + a[3]) + (b[0] + b[1] + b[2] + b[3]); o.y = (c[0] + c[1] + c[2] + c[3]) + (d[0] + d[1] + d[2] + d[3]); return o;
}
__device__ __forceinline__ float ssqs_finish(f32x2 pp) {
    float s = pp.x + pp.y; s += __shfl_xor(s, 16); s += __shfl_xor(s, 32);
    return __builtin_amdgcn_rsqf(s * (1.0f / 1024.0f) + EPS);
}
struct SkE1 {
    const float* ssqs; bf16_t* U; float* vssqs;
    __device__ __forceinline__ f32x2 pre(int r, int col, int fq) const { return ssqs_part(ssqs, r, fq); }
    __device__ __forceinline__ void operator()(int r, int col, int ct, int fq, f32x4 v, f32x2 pp) const {
        const float rs = ssqs_finish(pp);
        const int sec = col >> 9, cc = col & 511;
        v = v * rs;
        if (sec != 3) { v[0] = gelu_t(v[0]); v[1] = gelu_t(v[1]); v[2] = gelu_t(v[2]); v[3] = gelu_t(v[3]); }
        store_bf4(U + (size_t)sec * ((size_t)MPAD * 512) + (size_t)(MP + r) * 512 + cc, v);
        float sq = v[0] * v[0] + v[1] * v[1] + v[2] * v[2] + v[3] * v[3];
        sq += __shfl_xor(sq, 16); sq += __shfl_xor(sq, 32);
        if (sec == 1 && fq == 0) vssqs[r * 32 + (cc >> 4)] = sq;
    }
};
struct SkF1 {
    const float* ssqs; bf16_t* H;
    __device__ __forceinline__ f32x2 pre(int r, int col, int fq) const { return ssqs_part(ssqs, r, fq); }
    __device__ __forceinline__ void operator()(int r, int col, int ct, int fq, f32x4 v, f32x2 pp) const {
        const float rs = ssqs_finish(pp);
        v = v * rs;
#pragma unroll
        for (int j = 0; j < 4; ++j) { const float q = fmaxf(v[j], 0.f); v[j] = q * q; }
        store_bf4(H + (size_t)(MP + r) * DFF + col, v);
    }
};
struct SkRes {
    const bf16_t* Xi; bf16_t* Xo; float* ssqs; const float* bias; const float* cscale;
    __device__ __forceinline__ f32x2 pre(int r, int col, int fq) const { const u32x2 xw = *(const u32x2*)(Xi + (size_t)r * DM + col); f32x2 o; o.x = __uint_as_float(xw.x); o.y = __uint_as_float(xw.y); return o; }
    __device__ __forceinline__ void operator()(int r, int col, int ct, int fq, f32x4 v, f32x2 pp) const {
        if (bias) v = (v + *(const f32x4*)(bias + col)) * *(const f32x4*)(cscale + col);
        bf16_t* xr = Xo + (size_t)r * DM + col;
        { const unsigned x0 = __float_as_uint(pp.x), x1 = __float_as_uint(pp.y); v[0] += bflo(x0); v[1] += bfhi(x0); v[2] += bflo(x1); v[3] += bfhi(x1); }
        store_bf4(xr, v);
        float sq = v[0] * v[0] + v[1] * v[1] + v[2] * v[2] + v[3] * v[3];
        sq += __shfl_xor(sq, 16); sq += __shfl_xor(sq, 32);
        if (fq == 0) ssqs[r * 64 + ct] = sq;
    }
};

__device__ void transpose_cvt(const float* __restrict__ src, bf16_t* __restrict__ dst, int K, int N, LAS float* sT, int G, int blk) {
    const int tid = opaque_tid();
    const int tk = K / 64, tn = N / 64, ntile = tk * tn;
    for (int t = blk; t < ntile; t += G) {
        const int k0 = (t / tn) * 64, n0 = (t % tn) * 64;
#pragma unroll
        for (int i = 0; i < 2; ++i) {
            const int k = (tid >> 4) + 32 * i, n4 = (tid & 15) * 4;
            const f32x4 v = *(const f32x4*)(src + (size_t)(k0 + k) * N + n0 + n4);
            sT[k * 65 + n4 + 0] = v[0]; sT[k * 65 + n4 + 1] = v[1]; sT[k * 65 + n4 + 2] = v[2]; sT[k * 65 + n4 + 3] = v[3];
        }
        __syncthreads();
        {
            const int n = tid >> 3, kk = (tid & 7) * 8;
            float f[8];
#pragma unroll
            for (int j = 0; j < 8; ++j) f[j] = sT[(kk + j) * 65 + n];
            u32x4 w; w.x = cvt_pk_bf16(f[0], f[1]); w.y = cvt_pk_bf16(f[2], f[3]); w.z = cvt_pk_bf16(f[4], f[5]); w.w = cvt_pk_bf16(f[6], f[7]);
            *(u32x4*)(dst + (size_t)(n0 + n) * K + k0 + kk) = w;
        }
        __syncthreads();
    }
}
__device__ void transpose_cvt_wide(const float* __restrict__ src, bf16_t* __restrict__ dst, int K, int N, int nmat, LAS float* sT, int G, int rot, const float* gk, int gstride) {
    const int tid = opaque_tid();
    const int tk = K / 64, tn = N / 256, per = tk * tn, ntile = per * nmat;
    int blk = (int)blockIdx.x + rot; if (blk >= G) blk -= G;
    for (int t = blk; t < ntile; t += G) {
        const int mat = t / per, tt = t - mat * per;
        const int k0 = (tt / tn) * 64, n0 = (tt % tn) * 256;
        const float* sp = src + (size_t)mat * K * N; bf16_t* dp = dst + (size_t)mat * K * N;
        f32x4 v[8];
#pragma unroll
        for (int i = 0; i < 8; ++i) v[i] = *(const f32x4*)(sp + (size_t)(k0 + (tid >> 6) + 8 * i) * N + n0 + (tid & 63) * 4);
        if (gk) {
#pragma unroll
            for (int i = 0; i < 8; ++i) v[i] = v[i] * gk[(size_t)mat * gstride + k0 + (tid >> 6) + 8 * i];
        }
#pragma unroll
        for (int i = 0; i < 8; ++i) {
            const int k = (tid >> 6) + 8 * i, n4 = (tid & 63) * 4;
            sT[k * 257 + n4 + 0] = v[i][0]; sT[k * 257 + n4 + 1] = v[i][1]; sT[k * 257 + n4 + 2] = v[i][2]; sT[k * 257 + n4 + 3] = v[i][3];
        }
        __syncthreads();
        {
            const int piece = tid & 7;
#pragma unroll
            for (int i = 0; i < 4; ++i) {
                const int n = (tid >> 3) + 64 * i;
                float f[8];
#pragma unroll
                for (int j = 0; j < 8; ++j) f[j] = sT[(piece * 8 + j) * 257 + n];
                u32x4 w; w.x = cvt_pk_bf16(f[0], f[1]); w.y = cvt_pk_bf16(f[2], f[3]); w.z = cvt_pk_bf16(f[4], f[5]); w.w = cvt_pk_bf16(f[6], f[7]);
                st_wt16(dp, (unsigned)(((n0 + n) * K + k0 + piece * 8) * 2), w);
            }
        }
        __syncthreads();
    }
}

__device__ void gap0_extras(const Params& p, LAS unsigned char* lds, int G) {
    LAS float* sT = (LAS float*)lds;
    unsigned char* ws = p.ws;
    transpose_cvt_wide(p.pool_w, (bf16_t*)(ws + WS_WP), 256, 256, 8, sT, G, 128, nullptr, 0);
    for (int m = (int)blockIdx.x - 192; m >= 0 && m < 32; m += G) {
        const int eh = m >> 1, gate = m & 1, e = eh >> 3, h = eh & 7;
        transpose_cvt((gate ? p.gate_x_w : p.gate_a_w) + (size_t)eh * 4096, (bf16_t*)(ws + WS_GW) + (size_t)((e * 2 + gate) * 8 + h) * 4096, 64, 64, sT, 1 << 30, 0);
    }
    const int tid0 = opaque_tid();
    const int gtid = blockIdx.x * NTHR + tid0, gthr = G * NTHR;
    {
        bf16_t* SW = (bf16_t*)(ws + WS_SW);
        for (int i = gtid; i < 2 * 8 * 128 * 128; i += gthr) { const int s = i & 127, t = (i >> 7) & 127; SW[i] = (s <= t) ? f2bf(p.sgu_w[i]) : (bf16_t)0; }
        float* SP = (float*)(ws + WS_SP);
        for (int i = gtid; i < 1024; i += gthr) { const float z = -p.lru_lambda[i]; SP[i] = fmaxf(z, 0.f) + log1pf(expf(-fabsf(z))); }
    }
    {
        u32x4* cgz = (u32x4*)(ws + WS_CG);
        const u32x4 z = (u32x4){0u, 0u, 0u, 0u};
        for (int i = gtid; i < (int)((size_t)2 * 1024 * 128 * 8 / 16); i += gthr) cgz[i] = z;
    }
}

__device__ void phase_prep(const Params& p, LAS unsigned char* lds, int G) {
    LAS float* sT = (LAS float*)lds;
    unsigned char* ws = p.ws;
    transpose_cvt_wide(p.w_in, (bf16_t*)(ws + WS_WIN), DM, DIN, 1, sT, G, 0, p.norm_mix, 2 * DM);
    const int tid0 = opaque_tid();
    {
        const int wave = tid0 >> 6, lane = tid0 & 63;
        bf16_t* XG = (bf16_t*)(ws + WS_XG); float* SSQ = (float*)(ws + WS_SSQ); float* SSQS = (float*)(ws + WS_SSQS);
        for (int row = blockIdx.x * 8 + wave; row < MR; row += G * 8) {
            float sq = 0.f;
            const float* xr = row < MP ? p.x_prompt + (size_t)row * DM : p.x_sample + (size_t)(row - MP) * DM;
#pragma unroll
            for (int q = 0; q < 4; ++q) {
                const int col = q * 256 + lane * 4;
                const f32x4 v = *(const f32x4*)(xr + col);
                sq += v[0] * v[0] + v[1] * v[1] + v[2] * v[2] + v[3] * v[3];
                { u32x2 w2; w2.x = cvt_pk_bf16(v[0], v[1]); w2.y = cvt_pk_bf16(v[2], v[3]); st_wt8(XG, (unsigned)((row * DM + col) * 2), w2); }
            }
#pragma unroll
            for (int o = 1; o < 64; o <<= 1) sq += __shfl_xor(sq, o);
            if (row < MP) { if (lane < 16) SSQ[(size_t)row * 16 + lane] = (lane == 0) ? sq : 0.f; }
            else SSQS[(size_t)(row - MP) * 64 + lane] = (lane == 0) ? sq : 0.f;
        }
    }
}

__device__ void sample_pool_pre(const Params& p, int G);
__device__ void gap_convert(const Params& p, int g, LAS unsigned char* lds, int G) {
    if (g > 9) return;
    unsigned char* ws = p.ws;
    const float* src; bf16_t* dst; int K, N, nmat = 1; const float* gk = nullptr;
    const int l = (g - 1) >> 1;
    if (g == 0) { src = p.w_out; dst = (bf16_t*)(ws + WS_WOUT); K = DM; N = DM; nmat = 2; }
    else if (g == 5) { src = p.w_in + (size_t)DM * DIN; dst = (bf16_t*)(ws + WS_WIN) + (size_t)DIN * DM; K = DM; N = DIN; gk = p.norm_mix + 2 * DM; }
    else {
        const int gg = g < 5 ? g - 1 : g - 2;
        const int layer = gg >> 1;
        if ((gg & 1) == 0) { src = p.ffn_w1 + (size_t)layer * DM * DFF; dst = (bf16_t*)(ws + WS_W1) + (size_t)layer * DFF * DM; K = DM; N = DFF; gk = p.norm_ffn + layer * DM; }
        else { src = p.ffn_w2 + (size_t)layer * DFF * DM; dst = (bf16_t*)(ws + WS_W2) + (size_t)layer * DM * DFF; K = DFF; N = DM; }
    }
    (void)l;
    transpose_cvt_wide(src, dst, K, N, nmat, (LAS float*)lds, G, 0, gk, 0);
    if (g == 3) sample_pool_pre(p, G);
}

constexpr int L_XC = 0;
constexpr int L_XF = 18432;
constexpr int PF = 68;
constexpr int L_A = L_XF + 128 * PF * 4;
constexpr int L_B = L_A + 128 * PF * 4;
constexpr int L_PE = L_B + 128 * PF * 4;
constexpr int L_HE = L_PE + 2048;
constexpr int L_CARRY = L_HE + 2048;
constexpr int L_GW = L_CARRY + 256;
constexpr int L_SC = L_GW + 2 * 64 * 72 * 2;
static_assert(L_SC + 768 <= LDS_BYTES - 16, "LDS map");

__device__ __forceinline__ void lru_gates(LAS unsigned char* lds) {
    const int tid = opaque_tid(), lane = tid & 63, w = tid >> 6, fr = lane & 15, fq = lane >> 4;
    const int t = 16 * w + fr;
    bf16x8 Af[2];
#pragma unroll
    for (int ks = 0; ks < 2; ++ks) Af[ks] = *(const LAS bf16x8*)(lds + L_XC + (t * 72 + ks * 32 + fq * 8) * 2);
#pragma unroll
    for (int nt = 0; nt < 4; ++nt) {
        f32x4 ra = (f32x4){0.f, 0.f, 0.f, 0.f}, rx = (f32x4){0.f, 0.f, 0.f, 0.f};
#pragma unroll
        for (int ks = 0; ks < 2; ++ks) {
            const bf16x8 Ba = *(const LAS bf16x8*)(lds + L_GW + ((nt * 16 + fr) * 72 + ks * 32 + fq * 8) * 2);
            const bf16x8 Bx = *(const LAS bf16x8*)(lds + L_GW + ((64 + nt * 16 + fr) * 72 + ks * 32 + fq * 8) * 2);
            ra = __builtin_amdgcn_mfma_f32_16x16x32_bf16(Ba, Af[ks], ra, 0, 0, 0);
            rx = __builtin_amdgcn_mfma_f32_16x16x32_bf16(Bx, Af[ks], rx, 0, 0, 0);
        }
        const int c = nt * 16 + fq * 4;
        const f32x4 bav = *(const LAS f32x4*)(lds + L_SC + c * 4), bxv = *(const LAS f32x4*)(lds + L_SC + 256 + c * 4), spv = *(const LAS f32x4*)(lds + L_SC + 512 + c * 4);
        const f32x4 xc = *(const LAS f32x4*)(lds + L_XF + (t * PF + c) * 4);
        f32x4 av, bv;
#pragma unroll
        for (int j = 0; j < 4; ++j) {
            const float r = sigmoid_f(ra[j] + bav[j]), ig = sigmoid_f(rx[j] + bxv[j]);
            const float la = -8.0f * r * spv[j];
            const float a = __builtin_amdgcn_exp2f(la * 1.442695041f);
            const float mult = __builtin_amdgcn_sqrtf(fmaxf(1.0f - a * a, 0.f));
            av[j] = a; bv[j] = mult * ig * xc[j];
        }
        *(LAS f32x4*)(lds + L_A + (t * PF + c) * 4) = av;
        *(LAS f32x4*)(lds + L_B + (t * PF + c) * 4) = bv;
    }
}

__device__ __forceinline__ u32x4 f32_to_bf8(f32x4 lo, f32x4 hi) {
    u32x4 w; w.x = cvt_pk_bf16(lo[0], lo[1]); w.y = cvt_pk_bf16(lo[2], lo[3]); w.z = cvt_pk_bf16(hi[0], hi[1]); w.w = cvt_pk_bf16(hi[2], hi[3]); return w;
}

__device__ void lru_item(const Params& p, int e, int item, LAS unsigned char* lds) {
    const int tid = opaque_tid(), lane = tid & 63, w = tid >> 6;
    const bool sample = item >= 1024;
    const int h = sample ? item - 1024 : (item & 7), b = sample ? 0 : ((item >> 3) & 7);
    const int ch0 = h * 64, ch = lane, tq = w;
    const int rr8 = tid >> 3, part = tid & 7;
    unsigned char* ws = p.ws;
    const bf16_t* XB = (const bf16_t*)(ws + WS_XB); const bf16_t* GG = (const bf16_t*)(ws + WS_GG); bf16_t* AB = (bf16_t*)(ws + WS_AB);
    const float* ba = p.gate_a_b + e * 512; const float* bx = p.gate_x_b + e * 512; const float* sp = (const float*)(ws + WS_SP) + e * 512;
    LAS float* sXF = (LAS float*)(lds + L_XF); LAS bf16_t* sXC = (LAS bf16_t*)(lds + L_XC);
    LAS float* sA = (LAS float*)(lds + L_A); LAS float* sB = (LAS float*)(lds + L_B); LAS float* sXR = (LAS float*)(lds + L_A);
    LAS float* sPE = (LAS float*)(lds + L_PE); LAS float* sHE = (LAS float*)(lds + L_HE);
    {
        const int g = tid >> 8, n = (tid >> 2) & 63, pt = tid & 3;
        const bf16_t* gw = (const bf16_t*)(ws + WS_GW) + (size_t)((e * 2 + g) * 8 + h) * 4096 + n * 64 + pt * 16;
        const u32x4 w0 = *(const u32x4*)gw, w1 = *(const u32x4*)(gw + 8);
        LAS unsigned char* d = lds + L_GW + ((g * 64 + n) * 72 + pt * 16) * 2;
        *(LAS u32x4*)d = w0; *(LAS u32x4*)(d + 16) = w1;
        if (tid < 48) {
            const int which = tid >> 4, c4 = (tid & 15) * 4;
            const float* src = which == 0 ? ba : (which == 1 ? bx : sp);
            *(LAS f32x4*)(lds + L_SC + which * 256 + c4 * 4) = *(const f32x4*)(src + ch0 + c4);
        }
    }

    if (sample) {
        const int cc = ch0 + part * 8;
        f32x4 cwl[4], cwh[4];
#pragma unroll
        for (int k = 0; k < 4; ++k) { cwl[k] = *(const f32x4*)(p.conv_w + (e * 4 + k) * 512 + cc); cwh[k] = *(const f32x4*)(p.conv_w + (e * 4 + k) * 512 + cc + 4); }
        const f32x4 cbl = *(const f32x4*)(p.conv_b + e * 512 + cc), cbh = *(const f32x4*)(p.conv_b + e * 512 + cc + 4);
#pragma unroll
        for (int i = 0; i < 2; ++i) {
            const int r = rr8 + 64 * i;
            const float* sc = p.state_conv + ((size_t)(e * 128 + r) * 3) * 512 + cc;
            const f32x4 s0l = *(const f32x4*)sc, s0h = *(const f32x4*)(sc + 4), s1l = *(const f32x4*)(sc + 512), s1h = *(const f32x4*)(sc + 516),
                        s2l = *(const f32x4*)(sc + 1024), s2h = *(const f32x4*)(sc + 1028);
            f32x4 xl, xh; bf8_to_f32(*(const u32x4*)(XB + (size_t)(MP + r) * 512 + cc), xl, xh);
            const f32x4 xcl = cbl + cwl[0] * s0l + cwl[1] * s1l + cwl[2] * s2l + cwl[3] * xl;
            const f32x4 xch = cbh + cwh[0] * s0h + cwh[1] * s1h + cwh[2] * s2h + cwh[3] * xh;
            *(LAS f32x4*)(sXF + r * PF + part * 8) = xcl; *(LAS f32x4*)(sXF + r * PF + part * 8 + 4) = xch;
            *(LAS u32x4*)(sXC + r * 72 + part * 8) = f32_to_bf8(xcl, xch);
            float* co = p.out + O_CONVS + ((size_t)(e * 128 + r) * 3) * 512 + cc;
            *(f32x4*)co = s1l; *(f32x4*)(co + 4) = s1h; *(f32x4*)(co + 512) = s2l; *(f32x4*)(co + 516) = s2h; *(f32x4*)(co + 1024) = xl; *(f32x4*)(co + 1028) = xh;
        }
        __syncthreads();
        lru_gates(lds);
        __syncthreads();
#pragma unroll
        for (int i = 0; i < 2; ++i) {
            const int r = rr8 + 64 * i;
            const float* hp = p.state_rglru + (size_t)(e * 128 + r) * 512 + cc;
            const f32x4 h0l = *(const f32x4*)hp, h0h = *(const f32x4*)(hp + 4);
            const f32x4 al = *(const LAS f32x4*)(sA + r * PF + part * 8), ah = *(const LAS f32x4*)(sA + r * PF + part * 8 + 4);
            const f32x4 bl = *(const LAS f32x4*)(sB + r * PF + part * 8), bh = *(const LAS f32x4*)(sB + r * PF + part * 8 + 4);
            const f32x4 hl = al * h0l + bl, hh = ah * h0h + bh;
            float* ho = p.out + O_HS + (size_t)(e * 128 + r) * 512 + cc;
            *(f32x4*)ho = hl; *(f32x4*)(ho + 4) = hh;
            f32x4 gl, gh; bf8_to_f32(*(const u32x4*)(GG + (size_t)(MP + r) * 512 + cc), gl, gh);
            *(u32x4*)(AB + (size_t)(MP + r) * DM + 512 + cc) = f32_to_bf8(hl * gl, hh * gh);
        }
        __syncthreads();
        return;
    }

}

constexpr int L_VT = 0;
__device__ void sgu_item(const Params& p, int e, int it, LAS unsigned char* lds) {
    const int tid = opaque_tid(), lane = tid & 63, w = tid >> 6, fr = lane & 15, fq = lane >> 4;
    unsigned char* ws = p.ws;
    const bf16_t* U = (const bf16_t*)(ws + WS_U); const bf16_t* VP = (const bf16_t*)(ws + WS_VP); bf16_t* AB = (bf16_t*)(ws + WS_AB);
    const float* VSSQ = (const float*)(ws + WS_VSSQ);
    if (it >= 1024) {
        float* vo = p.out + O_SGUV + (size_t)e * MS * 512;
        {
            const int r = (it - 1024) * 4 + (tid >> 7), c4 = (tid & 127) * 4, h = c4 >> 6;
            const float rsv = rsv_sample_full((const float*)(ws + WS_VSSQS), r);
            const u32x2 vw = *(const u32x2*)(VP + (size_t)(MP + r) * 512 + c4), uw = *(const u32x2*)(U + (size_t)(MP + r) * 512 + c4);
            const f32x4 vn = *(const f32x4*)(p.v_norm + e * 512 + c4);
            f32x4 v; v[0] = bflo(vw.x) * rsv * vn[0]; v[1] = bfhi(vw.x) * rsv * vn[1]; v[2] = bflo(vw.y) * rsv * vn[2]; v[3] = bfhi(vw.y) * rsv * vn[3];
            *(f32x4*)(vo + (size_t)r * 512 + c4) = v;
            const float w00 = p.sgu_w[(size_t)(e * 8 + h) * 16384], b0 = p.sgu_b[(e * 8 + h) * 128];
            f32x4 a; a[0] = bflo(uw.x) * (w00 * v[0] + b0); a[1] = bfhi(uw.x) * (w00 * v[1] + b0); a[2] = bflo(uw.y) * (w00 * v[2] + b0); a[3] = bfhi(uw.y) * (w00 * v[3] + b0);
            store_bf4(AB + (size_t)(MP + r) * DM + c4, a);
        }
        return;
    }
}

struct SguPre { bf16x8 wf[4]; u32x2 uw[4]; float bsv; u32x4 v0, v1; f32x4 q0, q1; f32x4 vn0, vn1, vn2, vn3; };
__device__ __forceinline__ void sgu_load(const Params& p, int e, int it, SguPre& R, int tid) {
    const int lane = tid & 63, w = tid >> 6, fr = lane & 15, fq = lane >> 4;
    unsigned char* ws = p.ws;
    const bf16_t* U = (const bf16_t*)(ws + WS_U); const bf16_t* VP = (const bf16_t*)(ws + WS_VP); const float* VSSQ = (const float*)(ws + WS_VSSQ);
    const int h = it & 7, row0 = (it >> 3) * 128, t = 16 * w + fr, nks = (16 * w + 15) / 32 + 1;
    const bf16_t* SW = (const bf16_t*)(ws + WS_SW) + (size_t)(e * 8 + h) * 16384;
#pragma unroll
    for (int ks = 0; ks < 4; ++ks) R.wf[ks] = (ks < nks) ? *(const bf16x8*)(SW + t * 128 + ks * 32 + fq * 8) : (bf16x8){0, 0, 0, 0, 0, 0, 0, 0};
#pragma unroll
    for (int nt = 0; nt < 4; ++nt) R.uw[nt] = *(const u32x2*)(U + (size_t)(row0 + t) * 512 + h * 64 + nt * 16 + fq * 4);
    R.bsv = p.sgu_b[(e * 8 + h) * 128 + t];
    const int s = tid >> 2, dq = (tid & 3) * 16;
    R.q0 = *(const f32x4*)(VSSQ + (size_t)(row0 + s) * 8); R.q1 = *(const f32x4*)(VSSQ + (size_t)(row0 + s) * 8 + 4);
    R.v0 = *(const u32x4*)(VP + (size_t)(row0 + s) * 512 + h * 64 + dq); R.v1 = *(const u32x4*)(VP + (size_t)(row0 + s) * 512 + h * 64 + dq + 8);
    const float* vn = p.v_norm + e * 512 + h * 64 + dq;
    R.vn0 = *(const f32x4*)(vn); R.vn1 = *(const f32x4*)(vn + 4); R.vn2 = *(const f32x4*)(vn + 8); R.vn3 = *(const f32x4*)(vn + 12);
}
__device__ __forceinline__ void sgu_compute(const Params& p, int it, const SguPre& R, LAS unsigned char* lds, int tid) {
    const int lane = tid & 63, w = tid >> 6, fr = lane & 15, fq = lane >> 4;
    bf16_t* AB = (bf16_t*)(p.ws + WS_AB);
    const int h = it & 7, row0 = (it >> 3) * 128, t = 16 * w + fr, nks = (16 * w + 15) / 32 + 1;
    LAS bf16_t* sVT = (LAS bf16_t*)(lds + L_VT);
    {
        const int s = tid >> 2, dq = (tid & 3) * 16;
        const float ssum = (R.q0[0] + R.q0[1] + R.q0[2] + R.q0[3]) + (R.q1[0] + R.q1[1] + R.q1[2] + R.q1[3]);
        const float rsv = __builtin_amdgcn_rsqf(ssum * (1.0f / 512.0f) + EPS);
        f32x4 f0, f1, f2, f3; bf8_to_f32(R.v0, f0, f1); bf8_to_f32(R.v1, f2, f3);
        f0 = f0 * R.vn0 * rsv; f1 = f1 * R.vn1 * rsv; f2 = f2 * R.vn2 * rsv; f3 = f3 * R.vn3 * rsv;
#pragma unroll
        for (int j = 0; j < 4; ++j) {
            sVT[(dq + j) * 136 + s] = f2bf(f0[j]); sVT[(dq + 4 + j) * 136 + s] = f2bf(f1[j]);
            sVT[(dq + 8 + j) * 136 + s] = f2bf(f2[j]); sVT[(dq + 12 + j) * 136 + s] = f2bf(f3[j]);
        }
    }
    __syncthreads();
    {
        f32x4 acc[4];
#pragma unroll
        for (int nt = 0; nt < 4; ++nt) acc[nt] = (f32x4){0.f, 0.f, 0.f, 0.f};
#pragma unroll
        for (int ks = 0; ks < 4; ++ks) {
            if (ks < nks) {
#pragma unroll
                for (int nt = 0; nt < 4; ++nt) {
                    const bf16x8 vf = *(const LAS bf16x8*)(lds + L_VT + ((nt * 16 + fr) * 136 + ks * 32 + fq * 8) * 2);
                    acc[nt] = __builtin_amdgcn_mfma_f32_16x16x32_bf16(vf, R.wf[ks], acc[nt], 0, 0, 0);
                }
            }
        }
#pragma unroll
        for (int nt = 0; nt < 4; ++nt) {
            const int c = h * 64 + nt * 16 + fq * 4;
            f32x4 o; o[0] = bflo(R.uw[nt].x) * (acc[nt][0] + R.bsv); o[1] = bfhi(R.uw[nt].x) * (acc[nt][1] + R.bsv); o[2] = bflo(R.uw[nt].y) * (acc[nt][2] + R.bsv); o[3] = bfhi(R.uw[nt].y) * (acc[nt][3] + R.bsv);
            store_bf4(AB + (size_t)(row0 + t) * DM + c, o);
        }
    }
    __syncthreads();
}

struct LruPre { u32x4 x[3]; u32x4 gg[2]; unsigned long long gq[2][2]; };
__device__ __forceinline__ void lru_load(const Params& p, int e, int item, LruPre& R, int tid) {
    const int lane = tid & 63, tq = tid >> 6, ch = lane, rr8 = tid >> 3, part = tid & 7;
    const int h = item & 7, b = (item >> 3) & 7, c = item >> 6, ch0 = h * 64, row0 = b * SEQ + c * 128;
    unsigned char* ws = p.ws;
    const bf16_t* XB = (const bf16_t*)(ws + WS_XB); const bf16_t* GG = (const bf16_t*)(ws + WS_GG);
    unsigned long long* CG = (unsigned long long*)(ws + WS_CG) + (size_t)e * 1024 * 128;
#pragma unroll
    for (int i = 0; i < 3; ++i) {
        const int rr = rr8 + 64 * i, tl = c * 128 - 3 + rr;
        R.x[i] = (rr < 131 && tl >= 0) ? *(const u32x4*)(XB + (size_t)(b * SEQ + tl) * 512 + ch0 + part * 8) : (u32x4){0u, 0u, 0u, 0u};
    }
#pragma unroll
    for (int i = 0; i < 2; ++i) R.gg[i] = *(const u32x4*)(GG + (size_t)(row0 + rr8 + 64 * i) * 512 + ch0 + part * 8);
#pragma unroll
    for (int q = 0; q < 2; ++q) {
        const int j = tq + 8 * q;
        R.gq[q][0] = 0ull; R.gq[q][1] = 0ull;
        if (j < c) { unsigned long long* g = CG + (size_t)(j * 64 + (item & 63)) * 128 + ch;
            R.gq[q][0] = __hip_atomic_load(g, __ATOMIC_RELAXED, __HIP_MEMORY_SCOPE_AGENT); R.gq[q][1] = __hip_atomic_load(g + 64, __ATOMIC_RELAXED, __HIP_MEMORY_SCOPE_AGENT); }
    }
}

__device__ void lru_prompt_loop(const Params& p, int e, LAS unsigned char* lds, int G) {
    const int tid = opaque_tid(), lane = tid & 63, w = tid >> 6;
    const int ch = lane, tq = w, rr8 = tid >> 3, part = tid & 7;
    unsigned char* ws = p.ws;
    bf16_t* AB = (bf16_t*)(ws + WS_AB);
    const float* ba = p.gate_a_b + e * 512; const float* bx = p.gate_x_b + e * 512; const float* sp = (const float*)(ws + WS_SP) + e * 512;
    LAS float* sXF = (LAS float*)(lds + L_XF); LAS bf16_t* sXC = (LAS bf16_t*)(lds + L_XC);
    LAS float* sA = (LAS float*)(lds + L_A); LAS float* sB = (LAS float*)(lds + L_B); LAS float* sXR = (LAS float*)(lds + L_A);
    LAS float* sPE = (LAS float*)(lds + L_PE); LAS float* sHE = (LAS float*)(lds + L_HE);
    LAS float* sCP = (LAS float*)(lds + L_A); LAS float* sCH = (LAS float*)(lds + L_A + 4096);
    unsigned long long* CG = (unsigned long long*)(ws + WS_CG) + (size_t)e * 1024 * 128;
    int item = blockIdx.x;
    if (item >= 1024) return;
    LruPre cur; lru_load(p, e, item, cur, tid);
    int cur_h = -1;
    float cw0 = 0.f, cw1 = 0.f, cw2 = 0.f, cw3 = 0.f, cb = 0.f;
    for (;;) {
        const int h = item & 7, b = (item >> 3) & 7, c = item >> 6, ch0 = h * 64, row0 = b * SEQ + c * 128;
        if (h != cur_h) {
            cur_h = h;
            const int g = tid >> 8, n = (tid >> 2) & 63, pt = tid & 3;
            const bf16_t* gw = (const bf16_t*)(ws + WS_GW) + (size_t)((e * 2 + g) * 8 + h) * 4096 + n * 64 + pt * 16;
            const u32x4 w0 = *(const u32x4*)gw, w1 = *(const u32x4*)(gw + 8);
            LAS unsigned char* d = lds + L_GW + ((g * 64 + n) * 72 + pt * 16) * 2;
            *(LAS u32x4*)d = w0; *(LAS u32x4*)(d + 16) = w1;
            if (tid < 48) {
                const int which = tid >> 4, c4 = (tid & 15) * 4;
                const float* src = which == 0 ? ba : (which == 1 ? bx : sp);
                *(LAS f32x4*)(lds + L_SC + which * 256 + c4 * 4) = *(const f32x4*)(src + ch0 + c4);
            }
            cw0 = p.conv_w[(e * 4 + 0) * 512 + ch0 + ch]; cw1 = p.conv_w[(e * 4 + 1) * 512 + ch0 + ch]; cw2 = p.conv_w[(e * 4 + 2) * 512 + ch0 + ch];
            cw3 = p.conv_w[(e * 4 + 3) * 512 + ch0 + ch]; cb = p.conv_b[e * 512 + ch0 + ch];
        }
#pragma unroll
        for (int i = 0; i < 3; ++i) {
            const int rr = rr8 + 64 * i;
            if (rr < 131) { f32x4 xl, xh; bf8_to_f32(cur.x[i], xl, xh);
                *(LAS f32x4*)(sXR + rr * 64 + part * 8) = xl; *(LAS f32x4*)(sXR + rr * 64 + part * 8 + 4) = xh; }
        }
        const int nitem = item + G; const bool has_next = nitem < 1024;
        LruPre nxt = cur;
        if (has_next) lru_load(p, e, nitem, nxt, tid);
        __syncthreads();
        {
            float xv[19];
#pragma unroll
            for (int j = 0; j < 19; ++j) xv[j] = sXR[(tq * 16 + j) * 64 + ch];
#pragma unroll
            for (int i = 0; i < 16; ++i) {
                const float xc = cb + cw0 * xv[i] + cw1 * xv[i + 1] + cw2 * xv[i + 2] + cw3 * xv[i + 3];
                const int t = tq * 16 + i;
                sXF[t * PF + ch] = xc; sXC[t * 72 + ch] = f2bf(xc);
            }
            if (c == 15 && tq == 7) {
                float* co = p.out + O_CONVP + ((size_t)(e * 8 + b) * 3) * 512 + ch0 + ch;
                co[0] = xv[16]; co[512] = xv[17]; co[1024] = xv[18];
            }
        }
        __syncthreads();
        lru_gates(lds);
        __syncthreads();
        {
            float Hl[16], Pc[16];
            float Hh = 0.f, Pp = 1.f;
#pragma unroll
            for (int i = 0; i < 16; ++i) {
                const float a = sA[(tq * 16 + i) * PF + ch], bb = sB[(tq * 16 + i) * PF + ch];
                Hh = a * Hh + bb; Pp = Pp * a; Hl[i] = Hh; Pc[i] = Pp;
            }
            sPE[tq * 64 + ch] = Pp; sHE[tq * 64 + ch] = Hh;
            __syncthreads();
            if (tq == 7 && c < 15) {
                float Pt = 1.f, Ht = 0.f;
#pragma unroll
                for (int s2 = 0; s2 < 8; ++s2) { const float pe = sPE[s2 * 64 + ch]; Ht = pe * Ht + sHE[s2 * 64 + ch]; Pt *= pe; }
                unsigned long long* g = CG + (size_t)item * 128 + ch;
                __hip_atomic_store(g, (1ull << 32) | (unsigned long long)__float_as_uint(Pt), __ATOMIC_RELAXED, __HIP_MEMORY_SCOPE_AGENT);
                __hip_atomic_store(g + 64, (1ull << 32) | (unsigned long long)__float_as_uint(Ht), __ATOMIC_RELAXED, __HIP_MEMORY_SCOPE_AGENT);
            }
#pragma unroll
            for (int q = 0; q < 2; ++q) {
                const int j = tq + 8 * q;
                if (j < c) {
                    unsigned long long* g = CG + (size_t)(j * 64 + (item & 63)) * 128 + ch;
                    unsigned long long gp = cur.gq[q][0], gh = cur.gq[q][1]; unsigned spin = 0;
                    while (!((gp >> 32) == 1ull && (gh >> 32) == 1ull) && ++spin < (1u << 24)) {
                        __builtin_amdgcn_s_sleep(1);
                        gp = __hip_atomic_load(g, __ATOMIC_RELAXED, __HIP_MEMORY_SCOPE_AGENT); gh = __hip_atomic_load(g + 64, __ATOMIC_RELAXED, __HIP_MEMORY_SCOPE_AGENT);
                    }
                    sCP[j * 64 + ch] = __uint_as_float((unsigned)gp); sCH[j * 64 + ch] = __uint_as_float((unsigned)gh);
                }
            }
            __syncthreads();
            float hin = 0.f;
            {
                float cp[15], chv[15], pe[7], he[7];
#pragma unroll
                for (int j = 0; j < 15; ++j) { cp[j] = sCP[j * 64 + ch]; chv[j] = sCH[j * 64 + ch]; }
#pragma unroll
                for (int s2 = 0; s2 < 7; ++s2) { pe[s2] = sPE[s2 * 64 + ch]; he[s2] = sHE[s2 * 64 + ch]; }
#pragma unroll
                for (int j = 0; j < 15; ++j) hin = (j < c) ? cp[j] * hin + chv[j] : hin;
#pragma unroll
                for (int s2 = 0; s2 < 7; ++s2) hin = (s2 < tq) ? pe[s2] * hin + he[s2] : hin;
            }
            float hlast = 0.f;
#pragma unroll
            for (int i = 0; i < 16; ++i) { const float hv = Hl[i] + Pc[i] * hin; hlast = hv; sXF[(tq * 16 + i) * PF + ch] = hv; }
            if (tq == 7 && c == 15) p.out[O_HP + (size_t)(e * 8 + b) * 512 + ch0 + ch] = hlast;
            __syncthreads();
        }
#pragma unroll
        for (int i = 0; i < 2; ++i) {
            const int t = rr8 + 64 * i;
            f32x4 gl, gh; bf8_to_f32(cur.gg[i], gl, gh);
            const f32x4 hl = *(const LAS f32x4*)(sXF + t * PF + part * 8), hh = *(const LAS f32x4*)(sXF + t * PF + part * 8 + 4);
            *(u32x4*)(AB + (size_t)(row0 + t) * DM + 512 + ch0 + part * 8) = f32_to_bf8(hl * gl, hh * gh);
        }
        if (!has_next) break;
        cur = nxt; item = nitem;
    }
    __syncthreads();
}

__device__ void phase_e2(const Params& p, int e, LAS unsigned char* lds, int G) {
    lru_prompt_loop(p, e, lds, G);
    constexpr int NLRU = 1032;
    int itg = blockIdx.x; while (itg < 1024) itg += G;
    for (; itg < NLRU; itg += G) lru_item(p, e, itg, lds);
    const int tid = opaque_tid();
    const int blk = blockIdx.x;
    const int j0 = blk >= 8 ? blk - 8 : 248 + blk;
    const int nit = blk < 8 ? 2 : ((blk >= 40 && blk < 56) ? 5 : 4);
#define SGU_IDX(k) ((k) < 4 ? j0 + 256 * (k) : 760 + ((blk - 40) & 7) + 256 * ((blk - 40) >> 3))
    {
        SguPre A, B; sgu_load(p, e, SGU_IDX(0), A, tid); B = A;
        int k = 0;
        for (;;) {
            if (k + 1 < nit) sgu_load(p, e, SGU_IDX(k + 1), B, tid);
            sgu_compute(p, SGU_IDX(k), A, lds, tid);
            if (++k >= nit) break;
            if (k + 1 < nit) sgu_load(p, e, SGU_IDX(k + 1), A, tid);
            sgu_compute(p, SGU_IDX(k), B, lds, tid);
            if (++k >= nit) break;
        }
    }
#undef SGU_IDX
    if (blk >= 8 && blk < 40) sgu_item(p, e, 1024 + blk - 8, lds);
}

template <int W>
__device__ __forceinline__ void pool_rows(const float (&v0)[31], const float (&v1)[31], int t0, bf16_t* pa) {
    float s0 = 0.f, s1 = 0.f;
#pragma unroll
    for (int q = 0; q < W; ++q) { s0 += v0[15 - q]; s1 += v1[15 - q]; }
#pragma unroll
    for (int i = 0; i < 16; ++i) {
        const int jj = 15 + i, t = t0 + i;
        if (i > 0) { s0 += v0[jj] - v0[jj - W]; s1 += v1[jj] - v1[jj - W]; }
        const float ic = (t + 1 < W) ? 1.0f / (float)(t + 1) : (1.0f / (float)W);
        *(unsigned*)(pa + (size_t)i * DM) = cvt_pk_bf16(s0 * ic - v0[jj], s1 * ic - v1[jj]);
    }
}

__device__ void sample_pool_pre(const Params& p, int G) {
    const int tid = opaque_tid();
    const int c = tid * 2, w = 2 << (c >> 8);
    float* SPS = (float*)(p.ws + WS_SPSUM);
    for (int it = blockIdx.x; it < 2 * MS; it += G) {
        const int o = it >> 7, r = it & 127;
        const float* sp = p.state_pool + ((size_t)(o * 128 + r) * 15) * DM + c;
        float* po = p.out + O_POOLS + ((size_t)(o * 128 + r) * 15) * DM + c;
        f32x2 z[15];
#pragma unroll
        for (int k = 0; k < 15; ++k) z[k] = *(const f32x2*)(sp + (size_t)k * DM);
        float s0 = 0.f, s1 = 0.f;
#pragma unroll
        for (int k = 14; k >= 0; --k) {
            if (14 - k < w - 1) { s0 += z[k].x; s1 += z[k].y; }
            if (k >= 1) *(f32x2*)(po + (size_t)(k - 1) * DM) = z[k];
        }
        f32x2 sv; sv.x = s0; sv.y = s1;
        *(f32x2*)(SPS + (size_t)(o * 128 + r) * DM + c) = sv;
    }
}

template <int W>
__device__ __forceinline__ void pool_tile_rows(const Params& p, int layer, int pm, int pn, LAS float* sRS, int tid) {
    const int o = layer >> 1, b = pm >> 3, tbase = (pm & 7) * 256;
    const bf16_t* X = (const bf16_t*)(p.ws + WS_XG); bf16_t* PA = (bf16_t*)(p.ws + WS_PA);
    const bf16_t* HALO = (const bf16_t*)(p.ws + WS_HALO);
    const int c = pn * 256 + (tid & 127) * 2;
    const f32x2 gmix = *(const f32x2*)(p.norm_mix + layer * DM + c);
    for (int s = tid >> 7; s < 16; s += 4) {
        const int t0 = tbase + s * 16;
        unsigned wv[31];
#pragma unroll
        for (int j = 0; j < 31; ++j) {
            const int tl = t0 - 15 + j;
            const bf16_t* src = (s == 0 && j < 15) ? HALO + (size_t)((pm - 1) * 16 + j + 1) * DM + c : X + (size_t)(b * SEQ + tl) * DM + c;
            wv[j] = (tl >= 0) ? *(const unsigned*)src : 0u;
        }
        float v0[31], v1[31];
#pragma unroll
        for (int j = 0; j < 31; ++j) { const float rs = sRS[s * 16 + j]; v0[j] = bflo(wv[j]) * rs * gmix.x; v1[j] = bfhi(wv[j]) * rs * gmix.y; }
        pool_rows<W>(v0, v1, t0, PA + (size_t)(b * SEQ + t0) * DM + c);
        if (t0 == SEQ - 16) {
#pragma unroll
            for (int k = 0; k < 15; ++k) { f32x2 z; z.x = v0[16 + k]; z.y = v1[16 + k]; *(f32x2*)(p.out + O_POOLP + ((size_t)(o * 8 + b) * 15 + k) * DM + c) = z; }
        }
    }
}
__device__ void pool_tile_prep(const Params& p, int layer, int pm, int pn, LAS unsigned char* lds) {
    const int tid = opaque_tid();
    const float* SSQ = (const float*)(p.ws + WS_SSQ);
    LAS float* sRS = (LAS float*)lds;
    const int b = pm >> 3, tbase = (pm & 7) * 256;
    if (tid < 271) { const int tl = tbase - 15 + tid; sRS[tid] = tl >= 0 ? row_rs16(SSQ, b * SEQ + tl) : 0.f; }
    __syncthreads();
    if (pn == 0) pool_tile_rows<2>(p, layer, pm, pn, sRS, tid); else if (pn == 1) pool_tile_rows<4>(p, layer, pm, pn, sRS, tid);
    else if (pn == 2) pool_tile_rows<8>(p, layer, pm, pn, sRS, tid); else pool_tile_rows<16>(p, layer, pm, pn, sRS, tid);
    asm volatile("s_waitcnt vmcnt(0)" ::: "memory");
    __syncthreads();
}

template <class Epi>
__device__ __forceinline__ void skinny_pool(const Params& p, int layer, const bf16_t* Bt, const Epi& E, int G, const bf16_t* Xs, const float* SSQS) {
    const int tid = opaque_tid(), wave = tid >> 6, lane = tid & 63, fr = lane & 15, fq = lane >> 4;
    const int o = layer >> 1;
    const float* SPS = (const float*)(p.ws + WS_SPSUM) + (size_t)o * MS * DM;
    for (int ct = blockIdx.x; ct < 64; ct += G) {
        const int r = wave * 16 + fr, grp = ct >> 4, w = 2 << grp;
        const float invw = 1.0f / (float)w;
        const f32x2 pp = E.pre(r, ct * 16 + fq * 4, fq);
        const f32x2 ssp = ssqs_part(SSQS, r, fq);
        u32x4 xw[8]; bf16x8 bfr[8];
#pragma unroll
        for (int j = 0; j < 8; ++j) {
            const int col = grp * 256 + j * 32 + fq * 8;
            xw[j] = *(const u32x4*)(Xs + (size_t)r * DM + col);
            bfr[j] = *(const bf16x8*)(Bt + (size_t)(ct * 16 + fr) * 256 + j * 32 + fq * 8);
        }
        const float rs = ssqs_finish(ssp);
        f32x4 acc = (f32x4){0.f, 0.f, 0.f, 0.f};
#pragma unroll
        for (int j = 0; j < 8; ++j) {
            const int col = grp * 256 + j * 32 + fq * 8;
            const f32x4 s0 = *(const f32x4*)(SPS + (size_t)r * DM + col), s1 = *(const f32x4*)(SPS + (size_t)r * DM + col + 4);
            const f32x4 g0 = *(const f32x4*)(p.norm_mix + layer * DM + col), g1 = *(const f32x4*)(p.norm_mix + layer * DM + col + 4);
            f32x4 x0, x1; bf8_to_f32(xw[j], x0, x1);
            x0 = x0 * g0 * rs; x1 = x1 * g1 * rs;
            if ((ct & 15) == 0) { float* po = p.out + O_POOLS + ((size_t)(o * 128 + r) * 15 + 14) * DM + col; *(f32x4*)po = x0; *(f32x4*)(po + 4) = x1; }
            const f32x4 p0 = (x0 + s0) * invw - x0, p1 = (x1 + s1) * invw - x1;
            const u32x4 pk = pack_bf8(p0, p1);
            bf16x8 af; __builtin_memcpy(&af, &pk, 16);
            acc = __builtin_amdgcn_mfma_f32_16x16x32_bf16(bfr[j], af, acc, 0, 0, 0);
        }
        E(r, ct * 16 + fq * 4, ct, fq, acc, pp);
    }
}

__device__ void phase_final(const Params& p, int G, const bf16_t* Xs, const float* SSQS) {
    const int tidf = opaque_tid();
    const int wave = tidf >> 6, lane = tidf & 63;
    const float* SSQ = (const float*)(p.ws + WS_SSQ);
    const bf16_t* X = (const bf16_t*)(p.ws + WS_XG);
    for (int row = blockIdx.x * 8 + wave; row < MR; row += G * 8) {
        const float rs = row < MP ? row_rs16(SSQ, row) : rs_sample_full(SSQS, row - MP);
        float* yr = p.out + (size_t)row * DM;
#pragma unroll
        for (int q = 0; q < 4; ++q) {
            const int col = q * 256 + lane * 4;
            const u32x2 xw = row < MP ? *(const u32x2*)(X + (size_t)row * DM + col) : *(const u32x2*)(Xs + (size_t)(row - MP) * DM + col);
            const f32x4 gv = *(const f32x4*)(p.norm_final + col);
            f32x4 v; v[0] = bflo(xw.x); v[1] = bfhi(xw.x); v[2] = bflo(xw.y); v[3] = bfhi(xw.y);
            *(f32x4*)(yr + col) = v * gv * rs;
        }
    }
}

__global__ void __launch_bounds__(NTHR, 2) fwd_megakernel(Params p) {
    extern __shared__ __attribute__((aligned(16))) unsigned char smem[];
    LAS unsigned char* lds = (LAS unsigned char*)smem;
    cg::grid_group grid = cg::this_grid();
    const int G = gridDim.x;
    unsigned char* ws = p.ws;
    bf16_t* XG = (bf16_t*)(ws + WS_XG); float* SSQ = (float*)(ws + WS_SSQ);

    volatile LAS unsigned* st = (volatile LAS unsigned*)(lds + LDS_BYTES - 16);
    if (threadIdx.x < 4) st[threadIdx.x] = 0u;
    __syncthreads();
    const XcdBarrier bar = xcd_barrier_post((unsigned*)(ws + WS_BAR), st);
    float* SSQ2 = (float*)(ws + WS_SSQ2); bf16_t* HALO = (bf16_t*)(ws + WS_HALO);
    bf16_t* Xs_cur = XG + (size_t)MP * DM; bf16_t* Xs_alt = (bf16_t*)(ws + WS_XS2);
    float* SSQS_cur = (float*)(ws + WS_SSQS); float* SSQS_alt = (float*)(ws + WS_SSQS2);

    if (p.ws == nullptr) grid.sync();
    phase_prep(p, lds, G);
    xcd_barrier_arrive(bar); gap_convert(p, 0, lds, G); gap0_extras(p, lds, G); xcd_barrier_wait(bar);

    for (int ph = 0; ph < 16; ++ph) {
        const int q = ph & 7, layer = (ph >> 3) * 2 + (q >= 5 ? 1 : 0);
        const int kind = q < 5 ? q : (q == 5 ? 6 : q - 3);
        if (kind == 0) {
            const int e = layer >> 1;
            const bf16_t* Wt = (const bf16_t*)(ws + WS_WIN) + (size_t)e * DIN * DM;
            pg8::Gemm g{XG, Wt, MP, DIN, DM, DM, DM, 0};
            pg8::StaticOrder S; S.init(MP, DIN, G, (int)blockIdx.x);
            pg8::Unit u0; const int pm0 = S.next(0, u0) ? u0.pm : -1;
            if (pm0 >= 0) fill_rs_table(lds, SSQ, pm0);
            EpiE1 E{SSQ, (bf16_t*)(ws + WS_U), (float*)(ws + WS_VSSQ), lds, pm0};
            pg8::gemm_phase<EpiE1>(lds, g, S, E);
            SkE1 Es{SSQS_cur, (bf16_t*)(ws + WS_U), (float*)(ws + WS_VSSQS)};
            skinny_gemm_k1024<SkE1>(lds, Xs_cur, DM, Wt, DM, DIN, Es, G);
        } else if (kind == 1) {
            phase_e2(p, layer >> 1, lds, G);
        } else if (kind == 2) {
            const int e = layer >> 1;
            const bf16_t* Wt = (const bf16_t*)(ws + WS_WOUT) + (size_t)e * DM * DM;
            pg8::Gemm g{(const bf16_t*)(ws + WS_AB), Wt, MP, DM, DM, DM, DM, 0};
            pg8::StaticOrder S; S.init(MP, DM, G, (int)blockIdx.x);
            EpiRes E{XG, SSQ, nullptr, nullptr, lds, nullptr};
            pg8::gemm_phase<EpiRes>(lds, g, S, E);
            SkRes Es{Xs_cur, Xs_cur, SSQS_cur, nullptr, nullptr};
            skinny_gemm<4, 8, SkRes>(lds, (const bf16_t*)(ws + WS_AB) + (size_t)MP * DM, DM, 0, Wt, DM, DM, DM, Es, G);
        } else if (kind == 6) {
            const int o = layer >> 1;
            const bf16_t* Wt = (const bf16_t*)(ws + WS_WP) + (size_t)o * DM * 256;
            pg8::Gemm g{(const bf16_t*)(ws + WS_PA), Wt, MP, DM, 256, DM, 256, 256};
            pg8::StaticOrder S; S.init(MP, DM, G, (int)blockIdx.x);
            { pg8::Unit u0; if (S.next(0, u0)) pool_tile_prep(p, layer, u0.pm, u0.pn, lds); }
            EpiRes E{XG, SSQ2, p.pool_b + o * DM, p.pool_scale + o * DM, lds, nullptr};
            pg8::gemm_phase<EpiRes>(lds, g, S, E);
            SkRes Es{Xs_cur, Xs_alt, SSQS_alt, p.pool_b + o * DM, p.pool_scale + o * DM};
            skinny_pool<SkRes>(p, layer, Wt, Es, G, Xs_cur, SSQS_cur);
            { bf16_t* tx = Xs_cur; Xs_cur = Xs_alt; Xs_alt = tx; float* ts = SSQS_cur; SSQS_cur = SSQS_alt; SSQS_alt = ts; }
        } else if (kind == 3) {
            const bf16_t* Wt = (const bf16_t*)(ws + WS_W1) + (size_t)layer * DFF * DM;
            pg8::Gemm g{XG, Wt, MP, DFF, DM, DM, DM, 0};
            pg8::StaticOrder S; S.init(MP, DFF, G, (int)blockIdx.x);
            pg8::Unit u0; const int pm0 = S.next(0, u0) ? u0.pm : -1;
            const float* ssq_in = (layer & 1) ? SSQ2 : SSQ;
            if (pm0 >= 0) fill_rs_table(lds, ssq_in, pm0);
            EpiF1 E{ssq_in, (bf16_t*)(ws + WS_H), lds, pm0};
            pg8::gemm_phase<EpiF1>(lds, g, S, E);
            SkF1 Es{SSQS_cur, (bf16_t*)(ws + WS_H)};
            skinny_gemm_k1024<SkF1>(lds, Xs_cur, DM, Wt, DM, DFF, Es, G);
        } else {
            const bf16_t* Wt = (const bf16_t*)(ws + WS_W2) + (size_t)layer * DM * DFF;
            pg8::Gemm g{(const bf16_t*)(ws + WS_H), Wt, MP, DM, DFF, DFF, DFF, 0};
            pg8::StaticOrder S; S.init(MP, DM, G, (int)blockIdx.x);
            EpiRes E{XG, SSQ, nullptr, nullptr, lds, (layer & 1) ? nullptr : HALO};
            pg8::gemm_phase<EpiRes>(lds, g, S, E);
            SkRes Es{Xs_cur, Xs_cur, SSQS_cur, nullptr, nullptr};
            skinny_gemm_k4096<SkRes>(lds, (const bf16_t*)(ws + WS_H) + (size_t)MP * DFF, DFF, Wt, DFF, DM, Es, G);
        }
        xcd_barrier_arrive(bar); gap_convert(p, ph + 1, lds, G); xcd_barrier_wait(bar);
    }
    phase_final(p, G, Xs_cur, SSQS_cur);
}

extern "C" void kernel_launch(void* const* d_in, const int* in_sizes, int n_in, void* d_out, int out_size, void* d_ws, size_t ws_size, hipStream_t stream) {
    static int grid_blocks = 0;
    if (grid_blocks == 0) {
        if (n_in != 25 || (size_t)out_size != O_END || ws_size < WS_END) {
            fprintf(stderr, "kernel_launch: unexpected shapes: n_in %d out %d (want %zu) ws %zu (need %zu)\n", n_in, out_size, (size_t)O_END, ws_size, (size_t)WS_END);
            grid_blocks = -1; return;
        }
        int dev = 0, cus = 0, per_cu = 0;
        hipGetDevice(&dev);
        hipDeviceGetAttribute(&cus, hipDeviceAttributeMultiprocessorCount, dev);
        if (hipFuncSetAttribute((const void*)fwd_megakernel, hipFuncAttributeMaxDynamicSharedMemorySize, LDS_BYTES) != hipSuccess) { fprintf(stderr, "kernel_launch: hipFuncSetAttribute failed\n"); grid_blocks = -1; return; }
        if (hipOccupancyMaxActiveBlocksPerMultiprocessor(&per_cu, (const void*)fwd_megakernel, NTHR, LDS_BYTES) != hipSuccess || per_cu < 1) { fprintf(stderr, "kernel_launch: occupancy query failed (%d)\n", per_cu); (void)hipGetLastError(); per_cu = 1; }
        grid_blocks = cus * 1;
        if (grid_blocks != 256) { fprintf(stderr, "kernel_launch: this kernel is laid out for 256 CUs, found %d\n", cus); grid_blocks = -1; return; }
    }
    if (grid_blocks < 0) return;
    Params p{};
    const float** pp = (const float**)&p;
    for (int i = 0; i < 25; ++i) pp[i] = (const float*)d_in[i];
    p.out = (float*)d_out; p.ws = (unsigned char*)d_ws;
    if (hipMemsetAsync((char*)d_ws + WS_BAR, 0, 16384, stream) != hipSuccess) { fprintf(stderr, "kernel_launch: memset failed\n"); return; }
    void* args[] = {&p};
    hipError_t e = hipLaunchCooperativeKernel((const void*)fwd_megakernel, dim3(grid_blocks), dim3(NTHR), args, LDS_BYTES, stream);
    if (e != hipSuccess) fprintf(stderr, "cooperative launch failed: %s (grid %d)\n", hipGetErrorString(e), grid_blocks);
}
```

```cpp
#include <hip/hip_runtime.h>
#include <hip/hip_cooperative_groups.h>
#include <cstdio>
namespace cg = cooperative_groups;

#define LAS __attribute__((address_space(3)))
typedef unsigned short bf16_t;
typedef short bf16x8 __attribute__((ext_vector_type(8)));
typedef float f32x4 __attribute__((ext_vector_type(4)));
typedef float f32x2 __attribute__((ext_vector_type(2)));
typedef unsigned u32x4 __attribute__((ext_vector_type(4)));
typedef unsigned u32x2 __attribute__((ext_vector_type(2)));

constexpr int DM = 1024, NBATCH = 8, SEQ = 2048, MP = NBATCH * SEQ, MS = 128, MR = MP + MS, MPAD = 16640;
constexpr int DFF = 4096, WA = 512, WB = 512, DIN = 2048;
constexpr float EPS = 1e-6f;
constexpr int NTHR = 512;
constexpr int LDS_BYTES = 148 * 1024;

constexpr size_t O_YP = 0, O_YS = O_YP + (size_t)MP * DM, O_SGUV = O_YS + (size_t)MS * DM, O_CONVP = O_SGUV + 2 * MS * WA,
                 O_CONVS = O_CONVP + 2 * NBATCH * 3 * WB, O_HP = O_CONVS + 2 * MS * 3 * WB, O_HS = O_HP + 2 * NBATCH * WB,
                 O_POOLP = O_HS + 2 * MS * WB, O_POOLS = O_POOLP + 2 * NBATCH * 15 * DM, O_END = O_POOLS + (size_t)2 * MS * 15 * DM;

constexpr size_t WS_WIN = 0;
constexpr size_t WS_WOUT = WS_WIN + (size_t)2 * DIN * DM * 2;
constexpr size_t WS_W1 = WS_WOUT + (size_t)2 * DM * DM * 2;
constexpr size_t WS_W2 = WS_W1 + (size_t)4 * DFF * DM * 2;
constexpr size_t WS_WP = WS_W2 + (size_t)4 * DFF * DM * 2;
constexpr size_t WS_GW = WS_WP + (size_t)2 * DM * 256 * 2;
constexpr size_t WS_SW = WS_GW + (size_t)2 * 2 * 8 * 64 * 64 * 2;
constexpr size_t WS_SP = WS_SW + (size_t)2 * 8 * 128 * 128 * 2;
constexpr size_t WS_SSQ = WS_SP + 4096;
constexpr size_t WS_VSSQ = WS_SSQ + (size_t)MPAD * 16 * 4;
constexpr size_t WS_XG = WS_VSSQ + (size_t)MPAD * 8 * 4;
constexpr size_t WS_H = WS_XG + (size_t)MPAD * DM * 2;
constexpr size_t WS_U = WS_H, WS_VP = WS_U + (size_t)MPAD * 512 * 2, WS_GG = WS_VP + (size_t)MPAD * 512 * 2, WS_XB = WS_GG + (size_t)MPAD * 512 * 2,
                 WS_AB = WS_XB + (size_t)MPAD * 512 * 2, WS_PA = WS_H;
constexpr size_t WS_SSQS = WS_H + (size_t)MPAD * DFF * 2;
constexpr size_t WS_VSSQS = WS_SSQS + (size_t)MS * 64 * 4;
constexpr size_t WS_CG = WS_VSSQS + (size_t)MS * 32 * 4;
constexpr size_t WS_BAR = WS_CG + (size_t)2 * 1024 * 128 * 8;
constexpr size_t WS_SPSUM = WS_BAR + 16384;
constexpr size_t WS_SSQ2 = WS_SPSUM + (size_t)2 * MS * DM * 4;
constexpr size_t WS_HALO = WS_SSQ2 + (size_t)MPAD * 16 * 4;
constexpr size_t WS_XS2 = WS_HALO + (size_t)64 * 16 * DM * 2;
constexpr size_t WS_SSQS2 = WS_XS2 + (size_t)MS * DM * 2;
constexpr size_t WS_END = WS_SSQS2 + (size_t)MS * 64 * 4;

struct Params {
    const float *x_prompt, *x_sample, *state_conv, *state_rglru, *state_pool;
    const float *norm_mix, *norm_ffn, *norm_final, *w_in, *w_out, *v_norm, *sgu_w, *sgu_b;
    const float *conv_w, *conv_b, *gate_a_w, *gate_a_b, *gate_x_w, *gate_x_b, *lru_lambda;
    const float *pool_w, *pool_b, *pool_scale, *ffn_w1, *ffn_w2;
    float* out;
    unsigned char* ws;
};

__device__ __forceinline__ int opaque_tid() { int t = threadIdx.x; asm volatile("" : "+v"(t)); return t; }
__device__ __forceinline__ unsigned cvt_pk_bf16(float lo, float hi) { unsigned r; asm volatile("v_cvt_pk_bf16_f32 %0, %1, %2" : "=v"(r) : "v"(lo), "v"(hi)); return r; }
__device__ __forceinline__ float bf2f(unsigned short b) { return __uint_as_float(((unsigned)b) << 16); }
__device__ __forceinline__ float bflo(unsigned w) { return __uint_as_float(w << 16); }
__device__ __forceinline__ float bfhi(unsigned w) { return __uint_as_float(w & 0xffff0000u); }
__device__ __forceinline__ unsigned short f2bf(float f) { return (unsigned short)(cvt_pk_bf16(f, 0.f) & 0xffffu); }
__device__ __forceinline__ void bf8_to_f32(u32x4 w, f32x4& lo, f32x4& hi) {
    lo[0] = bflo(w.x); lo[1] = bfhi(w.x); lo[2] = bflo(w.y); lo[3] = bfhi(w.y);
    hi[0] = bflo(w.z); hi[1] = bfhi(w.z); hi[2] = bflo(w.w); hi[3] = bfhi(w.w);
}
__device__ __forceinline__ void st_wt16(void* base, unsigned off, u32x4 v) { const __amdgpu_buffer_rsrc_t rs = __builtin_amdgcn_make_buffer_rsrc(base, 0, 0x7fffffff, 0x00020000); __builtin_amdgcn_raw_buffer_store_b128(v, rs, off, 0, 16); }
__device__ __forceinline__ void st_wt8(void* base, unsigned off, u32x2 v) { const __amdgpu_buffer_rsrc_t rs = __builtin_amdgcn_make_buffer_rsrc(base, 0, 0x7fffffff, 0x00020000); __builtin_amdgcn_raw_buffer_store_b64(v, rs, off, 0, 16); }
__device__ __forceinline__ float gelu_t(float x) {
    const float z = x * (0.7978845608f + 0.0356774081f * x * x);
    const float e = __builtin_amdgcn_exp2f(z * 2.885390082f);
    return x - x * __builtin_amdgcn_rcpf(e + 1.0f);
}
__device__ __forceinline__ f32x2 gelu_t2(f32x2 x) {
    const f32x2 t = x * x;
    const f32x2 u = t * 0.1029432397f + 2.302208198f;
    const f32x2 a = x * u;
    f32x2 e; e.x = __builtin_amdgcn_exp2f(a.x); e.y = __builtin_amdgcn_exp2f(a.y);
    const f32x2 d = e + 1.0f;
    f32x2 r; r.x = __builtin_amdgcn_rcpf(d.x); r.y = __builtin_amdgcn_rcpf(d.y);
    return x - x * r;
}
__device__ __forceinline__ float sigmoid_f(float x) { return __builtin_amdgcn_rcpf(1.0f + __builtin_amdgcn_exp2f(-1.442695041f * x)); }
__device__ __forceinline__ float row_rs16(const float* ssq, int row) {
    const f32x4* q = (const f32x4*)(ssq + (size_t)row * 16);
    const f32x4 a = q[0], b = q[1], c = q[2], d = q[3];
    const float s = (a[0] + a[1] + a[2] + a[3]) + (b[0] + b[1] + b[2] + b[3]) + (c[0] + c[1] + c[2] + c[3]) + (d[0] + d[1] + d[2] + d[3]);
    return __builtin_amdgcn_rsqf(s * (1.0f / 1024.0f) + EPS);
}
__device__ __forceinline__ float row_rs8(const float* vssq, int row) {
    const f32x4* q = (const f32x4*)(vssq + (size_t)row * 8);
    const f32x4 a = q[0], b = q[1];
    const float s = (a[0] + a[1] + a[2] + a[3]) + (b[0] + b[1] + b[2] + b[3]);
    return __builtin_amdgcn_rsqf(s * (1.0f / 512.0f) + EPS);
}


__device__ __forceinline__ float rs_sample_q(const float* ssqs, int r, int fq) {
    const f32x4* q = (const f32x4*)(ssqs + (size_t)r * 64 + fq * 16);
    const f32x4 a = q[0], b = q[1], c = q[2], d = q[3];
    float s = (a[0] + a[1] + a[2] + a[3]) + (b[0] + b[1] + b[2] + b[3]) + (c[0] + c[1] + c[2] + c[3]) + (d[0] + d[1] + d[2] + d[3]);
    s += __shfl_xor(s, 16); s += __shfl_xor(s, 32);
    return __builtin_amdgcn_rsqf(s * (1.0f / 1024.0f) + EPS);
}
__device__ __forceinline__ float rs_sample_full(const float* ssqs, int r) {
    float s = 0.f;
#pragma unroll
    for (int i = 0; i < 16; ++i) { const f32x4 a = *(const f32x4*)(ssqs + (size_t)r * 64 + i * 4); s += (a[0] + a[1]) + (a[2] + a[3]); }
    return __builtin_amdgcn_rsqf(s * (1.0f / 1024.0f) + EPS);
}
__device__ __forceinline__ float rsv_sample_full(const float* vssqs, int r) {
    float s = 0.f;
#pragma unroll
    for (int i = 0; i < 8; ++i) { const f32x4 a = *(const f32x4*)(vssqs + (size_t)r * 32 + i * 4); s += (a[0] + a[1]) + (a[2] + a[3]); }
    return __builtin_amdgcn_rsqf(s * (1.0f / 512.0f) + EPS);
}

#define XB_TMO      128
#define XB_XCNT(j)  (256  + 64 * (j))
#define XB_XSUB(j)  (1280 + 64 * (j))
#define XB_XGEN(j)  (2304 + 64 * (j))
#define XB_TOP      3328
#define XB_TOPGEN   3392
#define XCD_BAR_WORDS 3456
#define XB_SPIN_CAP (1u << 22)
__device__ __forceinline__ unsigned xb_ld(unsigned* p)              { return __hip_atomic_load(p, __ATOMIC_RELAXED, __HIP_MEMORY_SCOPE_AGENT); }
__device__ __forceinline__ unsigned xb_add(unsigned* p, unsigned v) { return __hip_atomic_fetch_add(p, v, __ATOMIC_RELAXED, __HIP_MEMORY_SCOPE_AGENT); }
__device__ __forceinline__ unsigned xb_xcc_id() { return (unsigned)__builtin_amdgcn_s_getreg((3 << 11) | 20) & 0xFu; }
#define XB_SPIN(cond, bar) do { unsigned _sp = 0; while (cond) { __builtin_amdgcn_s_sleep(1); \
    if ((++_sp & 255u) == 0u) { if (xb_ld(&(bar)[XB_TMO])) break; if (_sp > XB_SPIN_CAP) { atomicAdd(&(bar)[XB_TMO], 1u); break; } } } } while (0)
struct XcdBarrier { unsigned* bar; unsigned x; volatile LAS unsigned* st; };
__device__ __forceinline__ XcdBarrier xcd_barrier_post(unsigned* bar, volatile LAS unsigned* st) {
    XcdBarrier b; b.bar = bar; b.x = xb_xcc_id(); b.st = st;
    if (threadIdx.x == 0) (void)xb_add(&bar[XB_XCNT(b.x)], 1u);
    return b;
}
__device__ __forceinline__ void xcd_barrier_complete(unsigned* bar, unsigned x, unsigned& nloc, unsigned& nx) {
    const unsigned G = gridDim.x * gridDim.y * gridDim.z;
    unsigned sum, cnt, mine, sp = 0u;
    for (;;) {
        sum = 0u; cnt = 0u; mine = 0u;
#pragma unroll
        for (unsigned j = 0; j < 16; ++j) { const unsigned c = xb_ld(&bar[XB_XCNT(j)]); sum += c; cnt += (c > 0u) ? 1u : 0u; mine = (j == x) ? c : mine; }
        if (sum == G) break;
        __builtin_amdgcn_s_sleep(1);
        if ((++sp & 255u) == 0u) { if (xb_ld(&bar[XB_TMO])) break; if (sp > XB_SPIN_CAP) { atomicAdd(&bar[XB_TMO], 1u); break; } }
    }
    nloc = mine > 0u ? mine : 1u; nx = cnt > 0u ? cnt : 1u;
}
__device__ __forceinline__ void xcd_barrier_arrive(const XcdBarrier& b) {
    asm volatile("s_waitcnt vmcnt(0)" ::: "memory");
    __syncthreads();
    if (threadIdx.x == 0) {
        unsigned* bar = b.bar;
        __builtin_amdgcn_s_waitcnt(0);
        unsigned nloc = b.st[0], nx = b.st[1];
        if (nloc == 0u) { xcd_barrier_complete(bar, b.x, nloc, nx); b.st[0] = nloc; b.st[1] = nx; }
        const unsigned old = xb_add(&bar[XB_XSUB(b.x)], 1u);
        const unsigned gen = old / nloc;
        unsigned leader = 0u, tg = 0u, lastx = 0u;
        if (old + 1u == (gen + 1u) * nloc) {
            leader = 1u;
            __builtin_amdgcn_fence(__ATOMIC_RELEASE, "agent");
            asm volatile("s_waitcnt vmcnt(0)" ::: "memory");
            const unsigned og = xb_add(&bar[XB_TOP], 1u);
            tg = og / nx;
            if (og + 1u == (tg + 1u) * nx) { xb_add(&bar[XB_TOPGEN], 1u); lastx = 1u; }
        }
        b.st[2] = gen * 2u + leader; b.st[3] = tg * 2u + lastx;
    }
}
__device__ __forceinline__ void xcd_barrier_wait(const XcdBarrier& b) {
    if (threadIdx.x == 0) {
        unsigned* bar = b.bar;
        const unsigned s2 = b.st[2], s3 = b.st[3];
        const unsigned gen = s2 >> 1, leader = s2 & 1u, tg = s3 >> 1, lastx = s3 & 1u;
        if (leader) {
            if (!lastx) XB_SPIN(xb_ld(&bar[XB_TOPGEN]) == tg, bar);
            xb_add(&bar[XB_XGEN(b.x)], 1u);
            __builtin_amdgcn_fence(__ATOMIC_ACQUIRE, "agent");
            asm volatile("s_waitcnt vmcnt(0)" ::: "memory");
        } else {
            XB_SPIN(xb_ld(&bar[XB_TOPGEN]) == gen, bar);
            __builtin_amdgcn_fence(__ATOMIC_ACQUIRE, "agent");
            asm volatile("s_waitcnt vmcnt(0)" ::: "memory");
        }
    }
    __syncthreads();
}

namespace pg8 {
constexpr int BM = 256, BK = 64, HALF = 128, HTB = HALF * BK * 2, STAGE_BYTES = 8 * HTB, NXCD = 8, WGM = 8;
__host__ __device__ __forceinline__ int lds_byte(int r, int c) { const int st = (r >> 4) * 2 + (c >> 5), rr = r & 15, cc = c & 31, ob = rr * 64 + cc * 2; return st * 1024 + (ob ^ (((ob >> 9) & 1) << 5)); }
__host__ __device__ __forceinline__ int perm32(int rho) { const int n = rho >> 4, i = rho & 15; return 8 * (i >> 2) + 4 * n + (i & 3); }
__host__ __device__ __forceinline__ void stage_rc(int b, int& R, int& C) { const int st = b / 1024, sb = b % 1024, swz = sb ^ (((sb >> 9) & 1) << 5); R = (st >> 1) * 16 + swz / 64; C = (st & 1) * 32 + (swz % 64) / 2; }

struct Unit { int pm, pn; };
struct Gemm { const bf16_t* A; const bf16_t* Bt; int M, N, K, lda, ldb, a_pn_koff; };

struct StaticOrder {
    int nM, nN, nwg, G, c;
    __device__ void init(int M, int N, int G_, int c_) { nM = M / BM; nN = N / BM; nwg = nM * nN; G = G_; c = c_; }
    __device__ bool next(int i, Unit& u) const {
        const long L = (long)i * G + c; if (L >= nwg) return false;
        int wgid = (int)L; { const int q = nwg / NXCD, r = nwg % NXCD, xcd = wgid % NXCD, off = wgid / NXCD; wgid = (xcd < r ? xcd * (q + 1) : r * (q + 1) + (xcd - r) * q) + off; }
        const int nig = WGM * nN, gid = wgid / nig, fm = gid * WGM, gsz = (nM - fm) < WGM ? (nM - fm) : WGM;
        u.pm = fm + ((wgid % nig) % gsz); u.pn = (wgid % nig) / gsz; return true;
    }
};

constexpr int RS_TAB_OFF = 131072, WT_OFF = 132096, WT_BYTES = 16 * 144;
constexpr int RS_TAB_OFF_UNUSED = 0;
__device__ __forceinline__ f32x4 zero4_b64() {
    f32x2 a, b; asm volatile("v_mov_b64 %0, 0" : "=v"(a)); asm volatile("v_mov_b64 %0, 0" : "=v"(b));
    return (f32x4){a.x, a.y, b.x, b.y};
}
template <class Epi>
__device__ __forceinline__ void gemm_phase(LAS unsigned char* lds, const Gemm g, const StaticOrder& S, const Epi& E) {
    const int tid = opaque_tid(), wid = __builtin_amdgcn_readfirstlane(tid >> 6), lane = tid & 63, wr = wid >> 2, wc = wid & 3, fr = lane & 15, fq = lane >> 4;
    const int K = g.K, nt = K / BK;
    unsigned voffA[2], voffB[2];
#pragma unroll
    for (int i = 0; i < 2; ++i) { int R, C; stage_rc(tid * 16 + i * 8192, R, C);
        const int Rb = 64 * (R >> 5) + 16 * ((R >> 2) & 3) + 4 * ((R >> 4) & 1) + (R & 3);
        voffA[i] = (unsigned)(R * g.lda + C) * 2u; voffB[i] = (unsigned)(Rb * g.ldb + C) * 2u; }
    const size_t kstep = (size_t)(BK * 2);
    const size_t hstepA = (size_t)HALF * g.lda * 2, hstepB = (size_t)8 * g.ldb * 2;
    const size_t tstepA = 2 * hstepA, tstepB = (size_t)BM * g.ldb * 2;
    const size_t pnoffA = (size_t)g.a_pn_koff * 2;
    const unsigned ldsw = (unsigned)wid * 1024u;
    const int aoff = lds_byte(wr * 64 + fr, fq * 8), boff = lds_byte(wc * 32 + fr, fq * 8);
#define PG8_SA(b, h) (((b) * 2 + (h)) * HTB)
#define PG8_SB(b, h) ((4 + (b) * 2 + (h)) * HTB)
#define PG8_STAGE(bufoff, gbase, voff) do { _Pragma("unroll") for (int _i = 0; _i < 2; ++_i) \
        __builtin_amdgcn_global_load_lds((const unsigned*)((const char*)(gbase) + (voff)[_i]), (LAS unsigned*)(lds + (bufoff) + ldsw + _i * 8192), 16, 0, 0); } while (0)
#define PG8_LDA(dst, b, h) do { _Pragma("unroll") for (int m = 0; m < 4; ++m) _Pragma("unroll") for (int k = 0; k < 2; ++k) dst[m][k] = *(const LAS bf16x8*)(lds + PG8_SA(b, h) + aoff + m * 2048 + k * 1024); } while (0)
#define PG8_LDB(dst, b, h) do { _Pragma("unroll") for (int n = 0; n < 2; ++n) _Pragma("unroll") for (int k = 0; k < 2; ++k) dst[n][k] = *(const LAS bf16x8*)(lds + PG8_SB(b, h) + boff + n * 2048 + k * 1024); } while (0)
#define PG8_MMA(ai, bj, At, Bt) do { __builtin_amdgcn_s_setprio(1); _Pragma("unroll") for (int m = 0; m < 4; ++m) _Pragma("unroll") for (int n = 0; n < 2; ++n) _Pragma("unroll") for (int k = 0; k < 2; ++k) \
        acc[ai][bj][m][n] = __builtin_amdgcn_mfma_f32_16x16x32_bf16(Bt[n][k], At[m][k], acc[ai][bj][m][n], 0, 0, 0); __builtin_amdgcn_s_setprio(0); } while (0)
#define PG8_WAIT_V(n) asm volatile("s_waitcnt vmcnt(" #n ")" ::: "memory")
#define PG8_WAIT_L(n) asm volatile("s_waitcnt lgkmcnt(" #n ")" ::: "memory")
#define PG8_BAR __builtin_amdgcn_s_barrier()
#define PG8_SCHED __builtin_amdgcn_sched_barrier(0)
    Unit cur, nxt; int ui = 0;
    if (!S.next(0, cur)) return;
    f32x4 acc[2][2][4][2];
#pragma unroll
    for (int a = 0; a < 2; ++a)
#pragma unroll
        for (int b = 0; b < 2; ++b)
#pragma unroll
            for (int m = 0; m < 4; ++m)
#pragma unroll
                for (int n = 0; n < 2; ++n) acc[a][b][m][n] = zero4_b64();
    bf16x8 At[4][2], B0[2][2], B1[2][2];
    const char* cA = (const char*)g.A + (size_t)cur.pm * tstepA + (size_t)cur.pn * pnoffA; const char* cB = (const char*)g.Bt + (size_t)cur.pn * tstepB;
    PG8_STAGE(PG8_SB(0, 0), cB, voffB); PG8_STAGE(PG8_SA(0, 0), cA, voffA); PG8_STAGE(PG8_SB(0, 1), cB + hstepB, voffB); PG8_STAGE(PG8_SA(0, 1), cA + hstepA, voffA);
    if (wr == 1) PG8_BAR;
    PG8_WAIT_V(4); PG8_BAR;
    PG8_STAGE(PG8_SB(1, 0), cB + kstep, voffB); PG8_STAGE(PG8_SA(1, 0), cA + kstep, voffA); PG8_STAGE(PG8_SB(1, 1), cB + hstepB + kstep, voffB);
    PG8_WAIT_V(6); PG8_BAR;
    for (;;) {
        const bool has_next = S.next(ui + 1, nxt);
        const char* nA = has_next ? (const char*)g.A + (size_t)nxt.pm * tstepA + (size_t)nxt.pn * pnoffA : cA; const char* nB = has_next ? (const char*)g.Bt + (size_t)nxt.pn * tstepB : cB;
        for (int t = 0; t < nt; t += 2) {
            const bool last = (t == nt - 2);
            const char* a1 = cA + (size_t)(t + 1) * kstep;
            const char* a2 = last ? nA : cA + (size_t)(t + 2) * kstep; const char* b2 = last ? nB : cB + (size_t)(t + 2) * kstep;
            const char* a3 = a2 + kstep; const char* b3 = b2 + kstep;
            PG8_LDB(B0, 0, 0); PG8_SCHED; PG8_LDA(At, 0, 0); PG8_STAGE(PG8_SA(1, 1), a1 + hstepA, voffA);
            PG8_WAIT_L(8); PG8_BAR; PG8_WAIT_L(0); PG8_MMA(0, 0, At, B0); PG8_BAR; PG8_SCHED;
            PG8_LDB(B1, 0, 1); PG8_STAGE(PG8_SB(0, 0), b2, voffB);
            PG8_BAR; PG8_WAIT_L(0); PG8_MMA(0, 1, At, B1); PG8_BAR;
            PG8_LDA(At, 0, 1); PG8_STAGE(PG8_SA(0, 0), a2, voffA);
            PG8_BAR; PG8_WAIT_L(0); PG8_MMA(1, 0, At, B0); PG8_BAR; PG8_SCHED;
            PG8_STAGE(PG8_SB(0, 1), b2 + hstepB, voffB);
            PG8_WAIT_V(6); PG8_BAR; PG8_MMA(1, 1, At, B1); PG8_BAR;
            PG8_LDB(B0, 1, 0); PG8_SCHED; PG8_LDA(At, 1, 0); PG8_STAGE(PG8_SA(0, 1), a2 + hstepA, voffA);
            PG8_WAIT_L(8); PG8_BAR; PG8_WAIT_L(0); PG8_MMA(0, 0, At, B0); PG8_BAR; PG8_SCHED;
            PG8_LDB(B1, 1, 1); PG8_STAGE(PG8_SB(1, 0), b3, voffB);
            PG8_BAR; PG8_WAIT_L(0); PG8_MMA(0, 1, At, B1); PG8_BAR;
            PG8_LDA(At, 1, 1); PG8_STAGE(PG8_SA(1, 0), a3, voffA);
            PG8_BAR; PG8_WAIT_L(0); PG8_MMA(1, 0, At, B0); PG8_BAR; PG8_SCHED;
            PG8_STAGE(PG8_SB(1, 1), b3 + hstepB, voffB);
            PG8_WAIT_V(6); PG8_BAR; PG8_MMA(1, 1, At, B1); PG8_BAR;
        }
        E(acc, cur, wr, wc, fr, fq);
        if (!has_next) break;
#pragma unroll
        for (int a = 0; a < 2; ++a)
#pragma unroll
            for (int b = 0; b < 2; ++b)
#pragma unroll
                for (int m = 0; m < 4; ++m)
#pragma unroll
                    for (int n = 0; n < 2; ++n) acc[a][b][m][n] = zero4_b64();
        cur = nxt; cA = nA; cB = nB; ++ui;
    }
    PG8_WAIT_V(0);
    if (wr == 0) PG8_BAR;
    PG8_BAR;
#undef PG8_SA
#undef PG8_SB
#undef PG8_STAGE
#undef PG8_LDA
#undef PG8_LDB
#undef PG8_MMA
#undef PG8_WAIT_V
#undef PG8_WAIT_L
#undef PG8_BAR
#undef PG8_SCHED
}
}

__device__ __forceinline__ void store_bf4(bf16_t* p, f32x4 v) { u32x2 w; w.x = cvt_pk_bf16(v[0], v[1]); w.y = cvt_pk_bf16(v[2], v[3]); *(u32x2*)p = w; }
__device__ __forceinline__ u32x4 pack_bf8(f32x4 a, f32x4 b) { u32x4 w; w.x = cvt_pk_bf16(a[0], a[1]); w.y = cvt_pk_bf16(a[2], a[3]); w.z = cvt_pk_bf16(b[0], b[1]); w.w = cvt_pk_bf16(b[2], b[3]); return w; }
__device__ __forceinline__ void wave_store_lines(LAS unsigned char* wbuf, bf16_t* g0, size_t ld, u32x4 w0, u32x4 w1, int lane) {
    const int fr = lane & 15, fq = lane >> 4;
    *(LAS u32x4*)(wbuf + fr * 144 + fq * 32) = w0; *(LAS u32x4*)(wbuf + fr * 144 + fq * 32 + 16) = w1;
    asm volatile("s_waitcnt lgkmcnt(0)" ::: "memory");
#pragma unroll
    for (int i = 0; i < 2; ++i) { const int row = 8 * i + (lane >> 3); const u32x4 t = *(const LAS u32x4*)(wbuf + row * 144 + (lane & 7) * 16); *(u32x4*)(g0 + (size_t)row * ld + (lane & 7) * 8) = t; }
    asm volatile("" ::: "memory");
}
__device__ __forceinline__ void wave_load_lines(LAS unsigned char* wbuf, const bf16_t* g0, size_t ld, u32x4& w0, u32x4& w1, int lane) {
    const int fr = lane & 15, fq = lane >> 4;
    u32x4 t[2];
#pragma unroll
    for (int i = 0; i < 2; ++i) t[i] = *(const u32x4*)(g0 + (size_t)(8 * i + (lane >> 3)) * ld + (lane & 7) * 8);
#pragma unroll
    for (int i = 0; i < 2; ++i) *(LAS u32x4*)(wbuf + (8 * i + (lane >> 3)) * 144 + (lane & 7) * 16) = t[i];
    asm volatile("s_waitcnt lgkmcnt(0)" ::: "memory");
    w0 = *(const LAS u32x4*)(wbuf + fr * 144 + fq * 32); w1 = *(const LAS u32x4*)(wbuf + fr * 144 + fq * 32 + 16);
    asm volatile("s_waitcnt lgkmcnt(0)" ::: "memory");
}
__device__ __forceinline__ void wave_store_lines_u(LAS unsigned char* wl, LAS unsigned char* rl, char* gbase, unsigned off0, unsigned off1, u32x4 w0, u32x4 w1) {
    *(LAS u32x4*)(wl) = w0; *(LAS u32x4*)(wl + 16) = w1;
    asm volatile("" ::: "memory");
    const u32x4 t0 = *(const LAS u32x4*)(rl), t1 = *(const LAS u32x4*)(rl + 8 * 144);
    asm volatile("" ::: "memory");
    {
        const __amdgpu_buffer_rsrc_t rs = __builtin_amdgcn_make_buffer_rsrc((void*)gbase, 0, 0x7fffffff, 0x00020000);
        __builtin_amdgcn_raw_buffer_store_b128(t0, rs, off0, 0, 16);
        __builtin_amdgcn_raw_buffer_store_b128(t1, rs, off1, 0, 16);
    }
}
__device__ __forceinline__ float unit_rs(LAS unsigned char* lds, const float* ssq, int pm0, int pm, int lr) {
    return *(const LAS float*)(lds + pg8::RS_TAB_OFF + lr * 4);
}
__device__ __forceinline__ void fill_rs_table(LAS unsigned char* lds, const float* ssq, int pm0) {
    const int t = opaque_tid();
    if (t < 256) *(LAS float*)(lds + pg8::RS_TAB_OFF + t * 4) = row_rs16(ssq, pm0 * 256 + t);
    __syncthreads();
}

struct EpiE1 {
    const float* ssq; bf16_t* U; float* vssq; LAS unsigned char* lds; int pm0;
    __device__ __forceinline__ void operator()(const f32x4 (&acc)[2][2][4][2], const pg8::Unit& u, int wr, int wc, int fr_, int fq_) const {
        int lane_o = fq_ * 16 + fr_; asm volatile("" : "+v"(lane_o));
        const int fr = lane_o & 15, fq = lane_o >> 4;
        const int sec = u.pn >> 1, lane = lane_o;
        bf16_t* dst = U + (size_t)sec * ((size_t)MPAD * 512) + (u.pn & 1) * 256 + wc * 64;
        LAS unsigned char* wbuf = lds + pg8::WT_OFF + (wr * 4 + wc) * pg8::WT_BYTES;
        LAS unsigned char* wl = wbuf + fr * 144 + fq * 32; LAS unsigned char* rl = wbuf + (lane >> 3) * 144 + (lane & 7) * 16;
        const unsigned off0 = (unsigned)(lane >> 3) * (512 * 2) + (lane & 7) * 16, off1 = off0 + 8u * (512 * 2);
#pragma unroll
        for (int ai = 0; ai < 2; ++ai) {
#pragma unroll
            for (int m = 0; m < 4; ++m) {
                const int lr = ai * 128 + wr * 64 + m * 16 + fr, row = u.pm * 256 + lr;
                const float rs = unit_rs(lds, ssq, pm0, u.pm, lr);
                float sq = 0.f;
                u32x4 w[2];
#pragma unroll
                for (int bj = 0; bj < 2; ++bj) {
                    f32x4 v0 = acc[ai][bj][m][0] * rs, v1 = acc[ai][bj][m][1] * rs;
                    if (sec != 3) {
                        const f32x2 g0 = gelu_t2((f32x2){v0[0], v0[1]}), g1 = gelu_t2((f32x2){v0[2], v0[3]}), g2 = gelu_t2((f32x2){v1[0], v1[1]}), g3 = gelu_t2((f32x2){v1[2], v1[3]});
                        v0 = (f32x4){g0.x, g0.y, g1.x, g1.y}; v1 = (f32x4){g2.x, g2.y, g3.x, g3.y};
                    }
                    sq += v0[0] * v0[0] + v0[1] * v0[1] + v0[2] * v0[2] + v0[3] * v0[3] + v1[0] * v1[0] + v1[1] * v1[1] + v1[2] * v1[2] + v1[3] * v1[3];
                    w[bj] = pack_bf8(v0, v1);
                }
                wave_store_lines_u(wl, rl, (char*)(dst + (size_t)(u.pm * 256 + ai * 128 + wr * 64 + m * 16) * 512), off0, off1, w[0], w[1]);
                if (sec == 1) {
                    sq += __shfl_xor(sq, 16); sq += __shfl_xor(sq, 32);
                    if (fq == 0) vssq[(size_t)row * 8 + (u.pn & 1) * 4 + wc] = sq;
                }
            }
        }
    }
};

struct EpiF1 {
    const float* ssq; bf16_t* H; LAS unsigned char* lds; int pm0;
    __device__ __forceinline__ void operator()(const f32x4 (&acc)[2][2][4][2], const pg8::Unit& u, int wr, int wc, int fr_, int fq_) const {
        int lane_o = fq_ * 16 + fr_; asm volatile("" : "+v"(lane_o));
        const int fr = lane_o & 15, fq = lane_o >> 4;
        const int lane = lane_o;
        bf16_t* dst = H + u.pn * 256 + wc * 64;
        LAS unsigned char* wbuf = lds + pg8::WT_OFF + (wr * 4 + wc) * pg8::WT_BYTES;
        LAS unsigned char* wl = wbuf + fr * 144 + fq * 32; LAS unsigned char* rl = wbuf + (lane >> 3) * 144 + (lane & 7) * 16;
        const unsigned off0 = (unsigned)(lane >> 3) * (DFF * 2) + (lane & 7) * 16, off1 = off0 + 8u * (DFF * 2);
#pragma unroll
        for (int ai = 0; ai < 2; ++ai) {
#pragma unroll
            for (int m = 0; m < 4; ++m) {
                const int lr = ai * 128 + wr * 64 + m * 16 + fr;
                const float rs = unit_rs(lds, ssq, pm0, u.pm, lr);
                u32x4 w[2];
#pragma unroll
                for (int bj = 0; bj < 2; ++bj) {
                    f32x4 v0 = acc[ai][bj][m][0] * rs, v1 = acc[ai][bj][m][1] * rs;
#pragma unroll
                    for (int j = 0; j < 4; ++j) { v0[j] = fmaxf(v0[j], 0.f); v1[j] = fmaxf(v1[j], 0.f); }
                    v0 = v0 * v0; v1 = v1 * v1;
                    w[bj] = pack_bf8(v0, v1);
                }
                wave_store_lines_u(wl, rl, (char*)(dst + (size_t)(u.pm * 256 + ai * 128 + wr * 64 + m * 16) * DFF), off0, off1, w[0], w[1]);
            }
        }
    }
};

struct EpiRes {
    bf16_t* X; float* ssq; const float* bias; const float* cscale; LAS unsigned char* lds; bf16_t* halo;
    __device__ __forceinline__ void operator()(const f32x4 (&acc)[2][2][4][2], const pg8::Unit& u, int wr, int wc, int fr_, int fq_) const {
        int lane_o = fq_ * 16 + fr_; asm volatile("" : "+v"(lane_o));
        const int fr = lane_o & 15, fq = lane_o >> 4;
        const int lane = lane_o;
        const int colw = u.pn * 256 + wc * 64;
        LAS unsigned char* wbuf = lds + pg8::WT_OFF + (wr * 4 + wc) * pg8::WT_BYTES;
        LAS unsigned char* wl = wbuf + fr * 144 + fq * 32; LAS unsigned char* rl = wbuf + (lane >> 3) * 144 + (lane & 7) * 16;
        const unsigned off0 = (unsigned)(lane >> 3) * (DM * 2) + (lane & 7) * 16, off1 = off0 + 8u * (DM * 2);
        f32x4 bv[2][2], cv[2][2];
#pragma unroll
        for (int bj = 0; bj < 2; ++bj)
#pragma unroll
            for (int hh = 0; hh < 2; ++hh) {
                const int col = colw + 16 * fq + 8 * bj + 4 * hh;
                bv[bj][hh] = bias ? *(const f32x4*)(bias + col) : (f32x4){0.f, 0.f, 0.f, 0.f};
                cv[bj][hh] = bias ? *(const f32x4*)(cscale + col) : (f32x4){1.f, 1.f, 1.f, 1.f};
            }
#pragma unroll
        for (int ai = 0; ai < 2; ++ai) {
            u32x4 t[4][2];
#pragma unroll
            for (int m = 0; m < 4; ++m) {
                const char* xg0 = (const char*)(X + (size_t)(u.pm * 256 + ai * 128 + wr * 64 + m * 16) * DM + colw);
                t[m][0] = *(const u32x4*)(xg0 + off0); t[m][1] = *(const u32x4*)(xg0 + off1);
            }
#pragma unroll
            for (int m = 0; m < 4; ++m) {
                const int row = u.pm * 256 + ai * 128 + wr * 64 + m * 16 + fr;
                char* xg0 = (char*)(X + (size_t)(u.pm * 256 + ai * 128 + wr * 64 + m * 16) * DM + colw);
                u32x4 xw[2];
                *(LAS u32x4*)(rl) = t[m][0]; *(LAS u32x4*)(rl + 8 * 144) = t[m][1];
                asm volatile("" ::: "memory");
                xw[0] = *(const LAS u32x4*)(wl); xw[1] = *(const LAS u32x4*)(wl + 16);
                asm volatile("" ::: "memory");
                float sq = 0.f;
                u32x4 w[2];
#pragma unroll
                for (int bj = 0; bj < 2; ++bj) {
                    const int col = colw + 16 * fq + 8 * bj;
                    f32x4 v0 = acc[ai][bj][m][0], v1 = acc[ai][bj][m][1];
                    if (bias) { v0 = (v0 + bv[bj][0]) * cv[bj][0]; v1 = (v1 + bv[bj][1]) * cv[bj][1]; }
                    f32x4 x0, x1; bf8_to_f32(xw[bj], x0, x1);
                    v0 = v0 + x0; v1 = v1 + x1;
                    sq += v0[0] * v0[0] + v0[1] * v0[1] + v0[2] * v0[2] + v0[3] * v0[3] + v1[0] * v1[0] + v1[1] * v1[1] + v1[2] * v1[2] + v1[3] * v1[3];
                    w[bj] = pack_bf8(v0, v1);
                }
                wave_store_lines_u(wl, rl, xg0, off0, off1, w[0], w[1]);
                if (halo && ai == 1 && m == 3 && wr == 1) wave_store_lines_u(wl, rl, (char*)(halo + (size_t)(u.pm * 16) * DM + colw), off0, off1, w[0], w[1]);
                sq += __shfl_xor(sq, 16); sq += __shfl_xor(sq, 32);
                if (fq == 0) ssq[(size_t)row * 16 + u.pn * 4 + wc] = sq;
            }
        }
    }
};

template <int KSPLIT, int STEPS, class Epi>
__device__ __forceinline__ void skinny_gemm(LAS unsigned char* lds, const bf16_t* A, int lda, int a_grp_koff, const bf16_t* Bt, int ldb, int N, int K, const Epi& E, int G) {
    const int tid = opaque_tid(), wave = tid >> 6, lane = tid & 63, fr = lane & 15, fq = lane >> 4;
    const int ntile = 8 * (N >> 4);
    constexpr int TPB = 8 / KSPLIT;
    const int klen = K / KSPLIT;
    for (int t0 = blockIdx.x * TPB; t0 < ntile; t0 += G * TPB) {
        const int tile = t0 + wave / KSPLIT, ks = wave % KSPLIT;
        const int rt = tile & 7, ct = tile >> 3;
        const bf16_t* ap = A + (size_t)(rt * 16 + fr) * lda + (ct >> 4) * a_grp_koff + ks * klen + fq * 8;
        const bf16_t* bp = Bt + (size_t)(ct * 16 + fr) * ldb + ks * klen + fq * 8;
        f32x2 pp = (f32x2){0.f, 0.f};
        if (ks == 0) pp = E.pre(rt * 16 + fr, ct * 16 + fq * 4, fq);
        f32x4 acc = (f32x4){0.f, 0.f, 0.f, 0.f};
        const int krot = (int)(((unsigned)(wave * 5 + (int)blockIdx.x * 3) * 32u) % (unsigned)klen);
        for (int k = 0; k < klen; k += STEPS * 32) {
            bf16x8 a[STEPS], b[STEPS];
#pragma unroll
            for (int j = 0; j < STEPS; ++j) { int kk = k + j * 32 + krot; kk = kk >= klen ? kk - klen : kk; a[j] = *(const bf16x8*)(ap + kk); b[j] = *(const bf16x8*)(bp + kk); }
#pragma unroll
            for (int j = 0; j < STEPS; ++j) acc = __builtin_amdgcn_mfma_f32_16x16x32_bf16(b[j], a[j], acc, 0, 0, 0);
        }
        if (KSPLIT > 1) {
            *(LAS f32x4*)(lds + (wave * 64 + lane) * 16) = acc;
            __syncthreads();
            if (ks == 0) {
#pragma unroll
                for (int j = 1; j < KSPLIT; ++j) acc = acc + *(const LAS f32x4*)(lds + ((wave + j) * 64 + lane) * 16);
                E(rt * 16 + fr, ct * 16 + fq * 4, ct, fq, acc, pp);
            }
            __syncthreads();
        } else {
            E(rt * 16 + fr, ct * 16 + fq * 4, ct, fq, acc, pp);
        }
    }
}

template <class Epi>
__device__ __forceinline__ void skinny_gemm_k1024(LAS unsigned char* lds, const bf16_t* A, int lda, const bf16_t* Bt, int ldb, int N, const Epi& E, int G) {
    const int tid = opaque_tid(), wave = tid >> 6, lane = tid & 63, fr = lane & 15, fq = lane >> 4;
    const int nct = N >> 4;
    for (int ct = blockIdx.x; ct < nct; ct += G) {
        const bf16_t* ap = A + (size_t)(wave * 16 + fr) * lda + fq * 8;
        const bf16_t* bp = Bt + (size_t)(ct * 16 + fr) * ldb + (4 * wave) * 32 + fq * 8;
        const f32x2 pp = E.pre(wave * 16 + fr, ct * 16 + fq * 4, fq);
        bf16x8 a[32], bl[4];
#pragma unroll
        for (int q = 0; q < 4; ++q) bl[q] = *(const bf16x8*)(bp + q * 32);
#pragma unroll
        for (int j = 0; j < 32; ++j) a[j] = *(const bf16x8*)(ap + j * 32);
#pragma unroll
        for (int q = 0; q < 4; ++q) *(LAS bf16x8*)(lds + ((4 * wave + q) * 64 + lane) * 16) = bl[q];
        __syncthreads();
        f32x4 acc0 = (f32x4){0.f, 0.f, 0.f, 0.f}, acc1 = acc0;
#pragma unroll
        for (int j = 0; j < 32; j += 2) {
            const bf16x8 b0 = *(const LAS bf16x8*)(lds + (j * 64 + lane) * 16), b1 = *(const LAS bf16x8*)(lds + ((j + 1) * 64 + lane) * 16);
            acc0 = __builtin_amdgcn_mfma_f32_16x16x32_bf16(b0, a[j], acc0, 0, 0, 0);
            acc1 = __builtin_amdgcn_mfma_f32_16x16x32_bf16(b1, a[j + 1], acc1, 0, 0, 0);
        }
        E(wave * 16 + fr, ct * 16 + fq * 4, ct, fq, acc0 + acc1, pp);
        __syncthreads();
    }
}

template <class Epi>
__device__ __forceinline__ void skinny_gemm_k4096(LAS unsigned char* lds, const bf16_t* A, int lda, const bf16_t* Bt, int ldb, int N, const Epi& E, int G) {
    const int tid = opaque_tid(), wave = tid >> 6, lane = tid & 63, fr = lane & 15, fq = lane >> 4;
    const int npair = 4 * (N >> 4);
    for (int pr = blockIdx.x; pr < npair; pr += G) {
        const int ct = pr >> 2, rt0 = (pr & 3) * 2;
        const bf16_t* ap0 = A + (size_t)(rt0 * 16 + fr) * lda + wave * 512 + fq * 8;
        const bf16_t* ap1 = ap0 + (size_t)16 * lda;
        const bf16_t* bp = Bt + (size_t)(ct * 16 + fr) * ldb + wave * 512 + fq * 8;
        f32x2 pp = (f32x2){0.f, 0.f};
        if (wave < 2) pp = E.pre((rt0 + wave) * 16 + fr, ct * 16 + fq * 4, fq);
        bf16x8 b[16], a0[16], a1[16];
#pragma unroll
        for (int j = 0; j < 16; ++j) { b[j] = *(const bf16x8*)(bp + j * 32); a0[j] = *(const bf16x8*)(ap0 + j * 32); a1[j] = *(const bf16x8*)(ap1 + j * 32); }
        f32x4 acc0 = (f32x4){0.f, 0.f, 0.f, 0.f}, acc1 = acc0;
#pragma unroll
        for (int j = 0; j < 16; ++j) {
            acc0 = __builtin_amdgcn_mfma_f32_16x16x32_bf16(b[j], a0[j], acc0, 0, 0, 0);
            acc1 = __builtin_amdgcn_mfma_f32_16x16x32_bf16(b[j], a1[j], acc1, 0, 0, 0);
        }
        *(LAS f32x4*)(lds + ((wave * 2 + 0) * 64 + lane) * 16) = acc0;
        *(LAS f32x4*)(lds + ((wave * 2 + 1) * 64 + lane) * 16) = acc1;
        __syncthreads();
        if (wave < 2) {
            f32x4 acc = *(const LAS f32x4*)(lds + ((0 * 2 + wave) * 64 + lane) * 16);
#pragma unroll
            for (int j = 1; j < 8; ++j) acc = acc + *(const LAS f32x4*)(lds + ((j * 2 + wave) * 64 + lane) * 16);
            E((rt0 + wave) * 16 + fr, ct * 16 + fq * 4, ct, fq, acc, pp);
        }
        __syncthreads();
    }
}

__device__ __forceinline__ f32x2 ssqs_part(const float* ssqs, int r, int fq) {
    const f32x4* q = (const f32x4*)(ssqs + (size_t)r * 64 + fq * 16);
    const f32x4 a = q[0], b = q[1], c = q[2], d = q[3];
    f32x2 o; o.x = (a[0] + a[1] + a[2] + a[3]) + (b[0] + b[1] + b[2] + b[3]); o.y = (c[0] + c[1] + c[2] + c[3]) + (d[0] + d[1] + d[2] + d[3]); return o;
}
__device__ __forceinline__ float ssqs_finish(f32x2 pp) {
    float s = pp.x + pp.y; s += __shfl_xor(s, 16); s += __shfl_xor(s, 32);
    return __builtin_amdgcn_rsqf(s * (1.0f / 1024.0f) + EPS);
}
struct SkE1 {
    const float* ssqs; bf16_t* U; float* vssqs;
    __device__ __forceinline__ f32x2 pre(int r, int col, int fq) const { return ssqs_part(ssqs, r, fq); }
    __device__ __forceinline__ void operator()(int r, int col, int ct, int fq, f32x4 v, f32x2 pp) const {
        const float rs = ssqs_finish(pp);
        const int sec = col >> 9, cc = col & 511;
        v = v * rs;
        if (sec != 3) { v[0] = gelu_t(v[0]); v[1] = gelu_t(v[1]); v[2] = gelu_t(v[2]); v[3] = gelu_t(v[3]); }
        store_bf4(U + (size_t)sec * ((size_t)MPAD * 512) + (size_t)(MP + r) * 512 + cc, v);
        float sq = v[0] * v[0] + v[1] * v[1] + v[2] * v[2] + v[3] * v[3];
        sq += __shfl_xor(sq, 16); sq += __shfl_xor(sq, 32);
        if (sec == 1 && fq == 0) vssqs[r * 32 + (cc >> 4)] = sq;
    }
};
struct SkF1 {
    const float* ssqs; bf16_t* H;
    __device__ __forceinline__ f32x2 pre(int r, int col, int fq) const { return ssqs_part(ssqs, r, fq); }
    __device__ __forceinline__ void operator()(int r, int col, int ct, int fq, f32x4 v, f32x2 pp) const {
        const float rs = ssqs_finish(pp);
        v = v * rs;
#pragma unroll
        for (int j = 0; j < 4; ++j) { const float q = fmaxf(v[j], 0.f); v[j] = q * q; }
        store_bf4(H + (size_t)(MP + r) * DFF + col, v);
    }
};
struct SkRes {
    const bf16_t* Xi; bf16_t* Xo; float* ssqs; const float* bias; const float* cscale;
    __device__ __forceinline__ f32x2 pre(int r, int col, int fq) const { const u32x2 xw = *(const u32x2*)(Xi + (size_t)r * DM + col); f32x2 o; o.x = __uint_as_float(xw.x); o.y = __uint_as_float(xw.y); return o; }
    __device__ __forceinline__ void operator()(int r, int col, int ct, int fq, f32x4 v, f32x2 pp) const {
        if (bias) v = (v + *(const f32x4*)(bias + col)) * *(const f32x4*)(cscale + col);
        bf16_t* xr = Xo + (size_t)r * DM + col;
        { const unsigned x0 = __float_as_uint(pp.x), x1 = __float_as_uint(pp.y); v[0] += bflo(x0); v[1] += bfhi(x0); v[2] += bflo(x1); v[3] += bfhi(x1); }
        store_bf4(xr, v);
        float sq = v[0] * v[0] + v[1] * v[1] + v[2] * v[2] + v[3] * v[3];
        sq += __shfl_xor(sq, 16); sq += __shfl_xor(sq, 32);
        if (fq == 0) ssqs[r * 64 + ct] = sq;
    }
};

__device__ void transpose_cvt(const float* __restrict__ src, bf16_t* __restrict__ dst, int K, int N, LAS float* sT, int G, int blk) {
    const int tid = opaque_tid();
    const int tk = K / 64, tn = N / 64, ntile = tk * tn;
    for (int t = blk; t < ntile; t += G) {
        const int k0 = (t / tn) * 64, n0 = (t % tn) * 64;
#pragma unroll
        for (int i = 0; i < 2; ++i) {
            const int k = (tid >> 4) + 32 * i, n4 = (tid & 15) * 4;
            const f32x4 v = *(const f32x4*)(src + (size_t)(k0 + k) * N + n0 + n4);
            sT[k * 65 + n4 + 0] = v[0]; sT[k * 65 + n4 + 1] = v[1]; sT[k * 65 + n4 + 2] = v[2]; sT[k * 65 + n4 + 3] = v[3];
        }
        __syncthreads();
        {
            const int n = tid >> 3, kk = (tid & 7) * 8;
            float f[8];
#pragma unroll
            for (int j = 0; j < 8; ++j) f[j] = sT[(kk + j) * 65 + n];
            u32x4 w; w.x = cvt_pk_bf16(f[0], f[1]); w.y = cvt_pk_bf16(f[2], f[3]); w.z = cvt_pk_bf16(f[4], f[5]); w.w = cvt_pk_bf16(f[6], f[7]);
            *(u32x4*)(dst + (size_t)(n0 + n) * K + k0 + kk) = w;
        }
        __syncthreads();
    }
}
__device__ void transpose_cvt_wide(const float* __restrict__ src, bf16_t* __restrict__ dst, int K, int N, int nmat, LAS float* sT, int G, int rot, const float* gk, int gstride) {
    const int tid = opaque_tid();
    const int tk = K / 64, tn = N / 256, per = tk * tn, ntile = per * nmat;
    int blk = (int)blockIdx.x + rot; if (blk >= G) blk -= G;
    for (int t = blk; t < ntile; t += G) {
        const int mat = t / per, tt = t - mat * per;
        const int k0 = (tt / tn) * 64, n0 = (tt % tn) * 256;
        const float* sp = src + (size_t)mat * K * N; bf16_t* dp = dst + (size_t)mat * K * N;
        f32x4 v[8];
#pragma unroll
        for (int i = 0; i < 8; ++i) v[i] = *(const f32x4*)(sp + (size_t)(k0 + (tid >> 6) + 8 * i) * N + n0 + (tid & 63) * 4);
        if (gk) {
#pragma unroll
            for (int i = 0; i < 8; ++i) v[i] = v[i] * gk[(size_t)mat * gstride + k0 + (tid >> 6) + 8 * i];
        }
#pragma unroll
        for (int i = 0; i < 8; ++i) {
            const int k = (tid >> 6) + 8 * i, n4 = (tid & 63) * 4;
            sT[k * 257 + n4 + 0] = v[i][0]; sT[k * 257 + n4 + 1] = v[i][1]; sT[k * 257 + n4 + 2] = v[i][2]; sT[k * 257 + n4 + 3] = v[i][3];
        }
        __syncthreads();
        {
            const int piece = tid & 7;
#pragma unroll
            for (int i = 0; i < 4; ++i) {
                const int n = (tid >> 3) + 64 * i;
                float f[8];
#pragma unroll
                for (int j = 0; j < 8; ++j) f[j] = sT[(piece * 8 + j) * 257 + n];
                u32x4 w; w.x = cvt_pk_bf16(f[0], f[1]); w.y = cvt_pk_bf16(f[2], f[3]); w.z = cvt_pk_bf16(f[4], f[5]); w.w = cvt_pk_bf16(f[6], f[7]);
                st_wt16(dp, (unsigned)(((n0 + n) * K + k0 + piece * 8) * 2), w);
            }
        }
        __syncthreads();
    }
}

__device__ void gap0_extras(const Params& p, LAS unsigned char* lds, int G) {
    LAS float* sT = (LAS float*)lds;
    unsigned char* ws = p.ws;
    transpose_cvt_wide(p.pool_w, (bf16_t*)(ws + WS_WP), 256, 256, 8, sT, G, 128, nullptr, 0);
    for (int m = (int)blockIdx.x - 192; m >= 0 && m < 32; m += G) {
        const int eh = m >> 1, gate = m & 1, e = eh >> 3, h = eh & 7;
        transpose_cvt((gate ? p.gate_x_w : p.gate_a_w) + (size_t)eh * 4096, (bf16_t*)(ws + WS_GW) + (size_t)((e * 2 + gate) * 8 + h) * 4096, 64, 64, sT, 1 << 30, 0);
    }
    const int tid0 = opaque_tid();
    const int gtid = blockIdx.x * NTHR + tid0, gthr = G * NTHR;
    {
        bf16_t* SW = (bf16_t*)(ws + WS_SW);
        for (int i = gtid; i < 2 * 8 * 128 * 128; i += gthr) { const int s = i & 127, t = (i >> 7) & 127; SW[i] = (s <= t) ? f2bf(p.sgu_w[i]) : (bf16_t)0; }
        float* SP = (float*)(ws + WS_SP);
        for (int i = gtid; i < 1024; i += gthr) { const float z = -p.lru_lambda[i]; SP[i] = fmaxf(z, 0.f) + log1pf(expf(-fabsf(z))); }
    }
    {
        u32x4* cgz = (u32x4*)(ws + WS_CG);
        const u32x4 z = (u32x4){0u, 0u, 0u, 0u};
        for (int i = gtid; i < (int)((size_t)2 * 1024 * 128 * 8 / 16); i += gthr) cgz[i] = z;
    }
}

__device__ void phase_prep(const Params& p, LAS unsigned char* lds, int G) {
    LAS float* sT = (LAS float*)lds;
    unsigned char* ws = p.ws;
    transpose_cvt_wide(p.w_in, (bf16_t*)(ws + WS_WIN), DM, DIN, 1, sT, G, 0, p.norm_mix, 2 * DM);
    const int tid0 = opaque_tid();
    {
        const int wave = tid0 >> 6, lane = tid0 & 63;
        bf16_t* XG = (bf16_t*)(ws + WS_XG); float* SSQ = (float*)(ws + WS_SSQ); float* SSQS = (float*)(ws + WS_SSQS);
        for (int row = blockIdx.x * 8 + wave; row < MR; row += G * 8) {
            float sq = 0.f;
            const float* xr = row < MP ? p.x_prompt + (size_t)row * DM : p.x_sample + (size_t)(row - MP) * DM;
#pragma unroll
            for (int q = 0; q < 4; ++q) {
                const int col = q * 256 + lane * 4;
                const f32x4 v = *(const f32x4*)(xr + col);
                sq += v[0] * v[0] + v[1] * v[1] + v[2] * v[2] + v[3] * v[3];
                { u32x2 w2; w2.x = cvt_pk_bf16(v[0], v[1]); w2.y = cvt_pk_bf16(v[2], v[3]); st_wt8(XG, (unsigned)((row * DM + col) * 2), w2); }
            }
#pragma unroll
            for (int o = 1; o < 64; o <<= 1) sq += __shfl_xor(sq, o);
            if (row < MP) { if (lane < 16) SSQ[(size_t)row * 16 + lane] = (lane == 0) ? sq : 0.f; }
            else SSQS[(size_t)(row - MP) * 64 + lane] = (lane == 0) ? sq : 0.f;
        }
    }
}

__device__ void sample_pool_pre(const Params& p, int G);
__device__ void gap_convert(const Params& p, int g, LAS unsigned char* lds, int G) {
    if (g > 9) return;
    unsigned char* ws = p.ws;
    const float* src; bf16_t* dst; int K, N, nmat = 1; const float* gk = nullptr;
    const int l = (g - 1) >> 1;
    if (g == 0) { src = p.w_out; dst = (bf16_t*)(ws + WS_WOUT); K = DM; N = DM; nmat = 2; }
    else if (g == 5) { src = p.w_in + (size_t)DM * DIN; dst = (bf16_t*)(ws + WS_WIN) + (size_t)DIN * DM; K = DM; N = DIN; gk = p.norm_mix + 2 * DM; }
    else {
        const int gg = g < 5 ? g - 1 : g - 2;
        const int layer = gg >> 1;
        if ((gg & 1) == 0) { src = p.ffn_w1 + (size_t)layer * DM * DFF; dst = (bf16_t*)(ws + WS_W1) + (size_t)layer * DFF * DM; K = DM; N = DFF; gk = p.norm_ffn + layer * DM; }
        else { src = p.ffn_w2 + (size_t)layer * DFF * DM; dst = (bf16_t*)(ws + WS_W2) + (size_t)layer * DM * DFF; K = DFF; N = DM; }
    }
    (void)l;
    transpose_cvt_wide(src, dst, K, N, nmat, (LAS float*)lds, G, 0, gk, 0);
    if (g == 3) sample_pool_pre(p, G);
}

constexpr int L_XC = 0;
constexpr int L_XF = 18432;
constexpr int PF = 68;
constexpr int L_A = L_XF + 128 * PF * 4;
constexpr int L_B = L_A + 128 * PF * 4;
constexpr int L_PE = L_B + 128 * PF * 4;
constexpr int L_HE = L_PE + 2048;
constexpr int L_CARRY = L_HE + 2048;
constexpr int L_GW = L_CARRY + 256;
constexpr int L_SC = L_GW + 2 * 64 * 72 * 2;
static_assert(L_SC + 768 <= LDS_BYTES - 16, "LDS map");

__device__ __forceinline__ void lru_gates(LAS unsigned char* lds) {
    const int tid = opaque_tid(), lane = tid & 63, w = tid >> 6, fr = lane & 15, fq = lane >> 4;
    const int t = 16 * w + fr;
    bf16x8 Af[2];
#pragma unroll
    for (int ks = 0; ks < 2; ++ks) Af[ks] = *(const LAS bf16x8*)(lds + L_XC + (t * 72 + ks * 32 + fq * 8) * 2);
#pragma unroll
    for (int nt = 0; nt < 4; ++nt) {
        f32x4 ra = (f32x4){0.f, 0.f, 0.f, 0.f}, rx = (f32x4){0.f, 0.f, 0.f, 0.f};
#pragma unroll
        for (int ks = 0; ks < 2; ++ks) {
            const bf16x8 Ba = *(const LAS bf16x8*)(lds + L_GW + ((nt * 16 + fr) * 72 + ks * 32 + fq * 8) * 2);
            const bf16x8 Bx = *(const LAS bf16x8*)(lds + L_GW + ((64 + nt * 16 + fr) * 72 + ks * 32 + fq * 8) * 2);
            ra = __builtin_amdgcn_mfma_f32_16x16x32_bf16(Ba, Af[ks], ra, 0, 0, 0);
            rx = __builtin_amdgcn_mfma_f32_16x16x32_bf16(Bx, Af[ks], rx, 0, 0, 0);
        }
        const int c = nt * 16 + fq * 4;
        const f32x4 bav = *(const LAS f32x4*)(lds + L_SC + c * 4), bxv = *(const LAS f32x4*)(lds + L_SC + 256 + c * 4), spv = *(const LAS f32x4*)(lds + L_SC + 512 + c * 4);
        const f32x4 xc = *(const LAS f32x4*)(lds + L_XF + (t * PF + c) * 4);
        f32x4 av, bv;
#pragma unroll
        for (int j = 0; j < 4; ++j) {
            const float r = sigmoid_f(ra[j] + bav[j]), ig = sigmoid_f(rx[j] + bxv[j]);
            const float la = -8.0f * r * spv[j];
            const float a = __builtin_amdgcn_exp2f(la * 1.442695041f);
            const float mult = __builtin_amdgcn_sqrtf(fmaxf(1.0f - a * a, 0.f));
            av[j] = a; bv[j] = mult * ig * xc[j];
        }
        *(LAS f32x4*)(lds + L_A + (t * PF + c) * 4) = av;
        *(LAS f32x4*)(lds + L_B + (t * PF + c) * 4) = bv;
    }
}

__device__ __forceinline__ u32x4 f32_to_bf8(f32x4 lo, f32x4 hi) {
    u32x4 w; w.x = cvt_pk_bf16(lo[0], lo[1]); w.y = cvt_pk_bf16(lo[2], lo[3]); w.z = cvt_pk_bf16(hi[0], hi[1]); w.w = cvt_pk_bf16(hi[2], hi[3]); return w;
}

__device__ void lru_item(const Params& p, int e, int item, LAS unsigned char* lds) {
    const int tid = opaque_tid(), lane = tid & 63, w = tid >> 6;
    const bool sample = item >= 1024;
    const int h = sample ? item - 1024 : (item & 7), b = sample ? 0 : ((item >> 3) & 7);
    const int ch0 = h * 64, ch = lane, tq = w;
    const int rr8 = tid >> 3, part = tid & 7;
    unsigned char* ws = p.ws;
    const bf16_t* XB = (const bf16_t*)(ws + WS_XB); const bf16_t* GG = (const bf16_t*)(ws + WS_GG); bf16_t* AB = (bf16_t*)(ws + WS_AB);
    const float* ba = p.gate_a_b + e * 512; const float* bx = p.gate_x_b + e * 512; const float* sp = (const float*)(ws + WS_SP) + e * 512;
    LAS float* sXF = (LAS float*)(lds + L_XF); LAS bf16_t* sXC = (LAS bf16_t*)(lds + L_XC);
    LAS float* sA = (LAS float*)(lds + L_A); LAS float* sB = (LAS float*)(lds + L_B); LAS float* sXR = (LAS float*)(lds + L_A);
    LAS float* sPE = (LAS float*)(lds + L_PE); LAS float* sHE = (LAS float*)(lds + L_HE);
    {
        const int g = tid >> 8, n = (tid >> 2) & 63, pt = tid & 3;
        const bf16_t* gw = (const bf16_t*)(ws + WS_GW) + (size_t)((e * 2 + g) * 8 + h) * 4096 + n * 64 + pt * 16;
        const u32x4 w0 = *(const u32x4*)gw, w1 = *(const u32x4*)(gw + 8);
        LAS unsigned char* d = lds + L_GW + ((g * 64 + n) * 72 + pt * 16) * 2;
        *(LAS u32x4*)d = w0; *(LAS u32x4*)(d + 16) = w1;
        if (tid < 48) {
            const int which = tid >> 4, c4 = (tid & 15) * 4;
            const float* src = which == 0 ? ba : (which == 1 ? bx : sp);
            *(LAS f32x4*)(lds + L_SC + which * 256 + c4 * 4) = *(const f32x4*)(src + ch0 + c4);
        }
    }

    if (sample) {
        const int cc = ch0 + part * 8;
        f32x4 cwl[4], cwh[4];
#pragma unroll
        for (int k = 0; k < 4; ++k) { cwl[k] = *(const f32x4*)(p.conv_w + (e * 4 + k) * 512 + cc); cwh[k] = *(const f32x4*)(p.conv_w + (e * 4 + k) * 512 + cc + 4); }
        const f32x4 cbl = *(const f32x4*)(p.conv_b + e * 512 + cc), cbh = *(const f32x4*)(p.conv_b + e * 512 + cc + 4);
#pragma unroll
        for (int i = 0; i < 2; ++i) {
            const int r = rr8 + 64 * i;
            const float* sc = p.state_conv + ((size_t)(e * 128 + r) * 3) * 512 + cc;
            const f32x4 s0l = *(const f32x4*)sc, s0h = *(const f32x4*)(sc + 4), s1l = *(const f32x4*)(sc + 512), s1h = *(const f32x4*)(sc + 516),
                        s2l = *(const f32x4*)(sc + 1024), s2h = *(const f32x4*)(sc + 1028);
            f32x4 xl, xh; bf8_to_f32(*(const u32x4*)(XB + (size_t)(MP + r) * 512 + cc), xl, xh);
            const f32x4 xcl = cbl + cwl[0] * s0l + cwl[1] * s1l + cwl[2] * s2l + cwl[3] * xl;
            const f32x4 xch = cbh + cwh[0] * s0h + cwh[1] * s1h + cwh[2] * s2h + cwh[3] * xh;
            *(LAS f32x4*)(sXF + r * PF + part * 8) = xcl; *(LAS f32x4*)(sXF + r * PF + part * 8 + 4) = xch;
            *(LAS u32x4*)(sXC + r * 72 + part * 8) = f32_to_bf8(xcl, xch);
            float* co = p.out + O_CONVS + ((size_t)(e * 128 + r) * 3) * 512 + cc;
            *(f32x4*)co = s1l; *(f32x4*)(co + 4) = s1h; *(f32x4*)(co + 512) = s2l; *(f32x4*)(co + 516) = s2h; *(f32x4*)(co + 1024) = xl; *(f32x4*)(co + 1028) = xh;
        }
        __syncthreads();
        lru_gates(lds);
        __syncthreads();
#pragma unroll
        for (int i = 0; i < 2; ++i) {
            const int r = rr8 + 64 * i;
            const float* hp = p.state_rglru + (size_t)(e * 128 + r) * 512 + cc;
            const f32x4 h0l = *(const f32x4*)hp, h0h = *(const f32x4*)(hp + 4);
            const f32x4 al = *(const LAS f32x4*)(sA + r * PF + part * 8), ah = *(const LAS f32x4*)(sA + r * PF + part * 8 + 4);
            const f32x4 bl = *(const LAS f32x4*)(sB + r * PF + part * 8), bh = *(const LAS f32x4*)(sB + r * PF + part * 8 + 4);
            const f32x4 hl = al * h0l + bl, hh = ah * h0h + bh;
            float* ho = p.out + O_HS + (size_t)(e * 128 + r) * 512 + cc;
            *(f32x4*)ho = hl; *(f32x4*)(ho + 4) = hh;
            f32x4 gl, gh; bf8_to_f32(*(const u32x4*)(GG + (size_t)(MP + r) * 512 + cc), gl, gh);
            *(u32x4*)(AB + (size_t)(MP + r) * DM + 512 + cc) = f32_to_bf8(hl * gl, hh * gh);
        }
        __syncthreads();
        return;
    }

}

constexpr int L_VT = 0;
__device__ void sgu_item(const Params& p, int e, int it, LAS unsigned char* lds) {
    const int tid = opaque_tid(), lane = tid & 63, w = tid >> 6, fr = lane & 15, fq = lane >> 4;
    unsigned char* ws = p.ws;
    const bf16_t* U = (const bf16_t*)(ws + WS_U); const bf16_t* VP = (const bf16_t*)(ws + WS_VP); bf16_t* AB = (bf16_t*)(ws + WS_AB);
    const float* VSSQ = (const float*)(ws + WS_VSSQ);
    if (it >= 1024) {
        float* vo = p.out + O_SGUV + (size_t)e * MS * 512;
        {
            const int r = (it - 1024) * 4 + (tid >> 7), c4 = (tid & 127) * 4, h = c4 >> 6;
            const float rsv = rsv_sample_full((const float*)(ws + WS_VSSQS), r);
            const u32x2 vw = *(const u32x2*)(VP + (size_t)(MP + r) * 512 + c4), uw = *(const u32x2*)(U + (size_t)(MP + r) * 512 + c4);
            const f32x4 vn = *(const f32x4*)(p.v_norm + e * 512 + c4);
            f32x4 v; v[0] = bflo(vw.x) * rsv * vn[0]; v[1] = bfhi(vw.x) * rsv * vn[1]; v[2] = bflo(vw.y) * rsv * vn[2]; v[3] = bfhi(vw.y) * rsv * vn[3];
            *(f32x4*)(vo + (size_t)r * 512 + c4) = v;
            const float w00 = p.sgu_w[(size_t)(e * 8 + h) * 16384], b0 = p.sgu_b[(e * 8 + h) * 128];
            f32x4 a; a[0] = bflo(uw.x) * (w00 * v[0] + b0); a[1] = bfhi(uw.x) * (w00 * v[1] + b0); a[2] = bflo(uw.y) * (w00 * v[2] + b0); a[3] = bfhi(uw.y) * (w00 * v[3] + b0);
            store_bf4(AB + (size_t)(MP + r) * DM + c4, a);
        }
        return;
    }
}

struct SguPre { bf16x8 wf[4]; u32x2 uw[4]; float bsv; u32x4 v0, v1; f32x4 q0, q1; f32x4 vn0, vn1, vn2, vn3; };
__device__ __forceinline__ void sgu_load(const Params& p, int e, int it, SguPre& R, int tid) {
    const int lane = tid & 63, w = tid >> 6, fr = lane & 15, fq = lane >> 4;
    unsigned char* ws = p.ws;
    const bf16_t* U = (const bf16_t*)(ws + WS_U); const bf16_t* VP = (const bf16_t*)(ws + WS_VP); const float* VSSQ = (const float*)(ws + WS_VSSQ);
    const int h = it & 7, row0 = (it >> 3) * 128, t = 16 * w + fr, nks = (16 * w + 15) / 32 + 1;
    const bf16_t* SW = (const bf16_t*)(ws + WS_SW) + (size_t)(e * 8 + h) * 16384;
#pragma unroll
    for (int ks = 0; ks < 4; ++ks) R.wf[ks] = (ks < nks) ? *(const bf16x8*)(SW + t * 128 + ks * 32 + fq * 8) : (bf16x8){0, 0, 0, 0, 0, 0, 0, 0};
#pragma unroll
    for (int nt = 0; nt < 4; ++nt) R.uw[nt] = *(const u32x2*)(U + (size_t)(row0 + t) * 512 + h * 64 + nt * 16 + fq * 4);
    R.bsv = p.sgu_b[(e * 8 + h) * 128 + t];
    const int s = tid >> 2, dq = (tid & 3) * 16;
    R.q0 = *(const f32x4*)(VSSQ + (size_t)(row0 + s) * 8); R.q1 = *(const f32x4*)(VSSQ + (size_t)(row0 + s) * 8 + 4);
    R.v0 = *(const u32x4*)(VP + (size_t)(row0 + s) * 512 + h * 64 + dq); R.v1 = *(const u32x4*)(VP + (size_t)(row0 + s) * 512 + h * 64 + dq + 8);
    const float* vn = p.v_norm + e * 512 + h * 64 + dq;
    R.vn0 = *(const f32x4*)(vn); R.vn1 = *(const f32x4*)(vn + 4); R.vn2 = *(const f32x4*)(vn + 8); R.vn3 = *(const f32x4*)(vn + 12);
}
__device__ __forceinline__ void sgu_compute(const Params& p, int it, const SguPre& R, LAS unsigned char* lds, int tid) {
    const int lane = tid & 63, w = tid >> 6, fr = lane & 15, fq = lane >> 4;
    bf16_t* AB = (bf16_t*)(p.ws + WS_AB);
    const int h = it & 7, row0 = (it >> 3) * 128, t = 16 * w + fr, nks = (16 * w + 15) / 32 + 1;
    LAS bf16_t* sVT = (LAS bf16_t*)(lds + L_VT);
    {
        const int s = tid >> 2, dq = (tid & 3) * 16;
        const float ssum = (R.q0[0] + R.q0[1] + R.q0[2] + R.q0[3]) + (R.q1[0] + R.q1[1] + R.q1[2] + R.q1[3]);
        const float rsv = __builtin_amdgcn_rsqf(ssum * (1.0f / 512.0f) + EPS);
        f32x4 f0, f1, f2, f3; bf8_to_f32(R.v0, f0, f1); bf8_to_f32(R.v1, f2, f3);
        f0 = f0 * R.vn0 * rsv; f1 = f1 * R.vn1 * rsv; f2 = f2 * R.vn2 * rsv; f3 = f3 * R.vn3 * rsv;
#pragma unroll
        for (int j = 0; j < 4; ++j) {
            sVT[(dq + j) * 136 + s] = f2bf(f0[j]); sVT[(dq + 4 + j) * 136 + s] = f2bf(f1[j]);
            sVT[(dq + 8 + j) * 136 + s] = f2bf(f2[j]); sVT[(dq + 12 + j) * 136 + s] = f2bf(f3[j]);
        }
    }
    __syncthreads();
    {
        f32x4 acc[4];
#pragma unroll
        for (int nt = 0; nt < 4; ++nt) acc[nt] = (f32x4){0.f, 0.f, 0.f, 0.f};
#pragma unroll
        for (int ks = 0; ks < 4; ++ks) {
            if (ks < nks) {
#pragma unroll
                for (int nt = 0; nt < 4; ++nt) {
                    const bf16x8 vf = *(const LAS bf16x8*)(lds + L_VT + ((nt * 16 + fr) * 136 + ks * 32 + fq * 8) * 2);
                    acc[nt] = __builtin_amdgcn_mfma_f32_16x16x32_bf16(vf, R.wf[ks], acc[nt], 0, 0, 0);
                }
            }
        }
#pragma unroll
        for (int nt = 0; nt < 4; ++nt) {
            const int c = h * 64 + nt * 16 + fq * 4;
            f32x4 o; o[0] = bflo(R.uw[nt].x) * (acc[nt][0] + R.bsv); o[1] = bfhi(R.uw[nt].x) * (acc[nt][1] + R.bsv); o[2] = bflo(R.uw[nt].y) * (acc[nt][2] + R.bsv); o[3] = bfhi(R.uw[nt].y) * (acc[nt][3] + R.bsv);
            store_bf4(AB + (size_t)(row0 + t) * DM + c, o);
        }
    }
    __syncthreads();
}

struct LruPre { u32x4 x[3]; u32x4 gg[2]; unsigned long long gq[2][2]; };
__device__ __forceinline__ void lru_load(const Params& p, int e, int item, LruPre& R, int tid) {
    const int lane = tid & 63, tq = tid >> 6, ch = lane, rr8 = tid >> 3, part = tid & 7;
    const int h = item & 7, b = (item >> 3) & 7, c = item >> 6, ch0 = h * 64, row0 = b * SEQ + c * 128;
    unsigned char* ws = p.ws;
    const bf16_t* XB = (const bf16_t*)(ws + WS_XB); const bf16_t* GG = (const bf16_t*)(ws + WS_GG);
    unsigned long long* CG = (unsigned long long*)(ws + WS_CG) + (size_t)e * 1024 * 128;
#pragma unroll
    for (int i = 0; i < 3; ++i) {
        const int rr = rr8 + 64 * i, tl = c * 128 - 3 + rr;
        R.x[i] = (rr < 131 && tl >= 0) ? *(const u32x4*)(XB + (size_t)(b * SEQ + tl) * 512 + ch0 + part * 8) : (u32x4){0u, 0u, 0u, 0u};
    }
#pragma unroll
    for (int i = 0; i < 2; ++i) R.gg[i] = *(const u32x4*)(GG + (size_t)(row0 + rr8 + 64 * i) * 512 + ch0 + part * 8);
#pragma unroll
    for (int q = 0; q < 2; ++q) {
        const int j = tq + 8 * q;
        R.gq[q][0] = 0ull; R.gq[q][1] = 0ull;
        if (j < c) { unsigned long long* g = CG + (size_t)(j * 64 + (item & 63)) * 128 + ch;
            R.gq[q][0] = __hip_atomic_load(g, __ATOMIC_RELAXED, __HIP_MEMORY_SCOPE_AGENT); R.gq[q][1] = __hip_atomic_load(g + 64, __ATOMIC_RELAXED, __HIP_MEMORY_SCOPE_AGENT); }
    }
}

__device__ void lru_prompt_loop(const Params& p, int e, LAS unsigned char* lds, int G) {
    const int tid = opaque_tid(), lane = tid & 63, w = tid >> 6;
    const int ch = lane, tq = w, rr8 = tid >> 3, part = tid & 7;
    unsigned char* ws = p.ws;
    bf16_t* AB = (bf16_t*)(ws + WS_AB);
    const float* ba = p.gate_a_b + e * 512; const float* bx = p.gate_x_b + e * 512; const float* sp = (const float*)(ws + WS_SP) + e * 512;
    LAS float* sXF = (LAS float*)(lds + L_XF); LAS bf16_t* sXC = (LAS bf16_t*)(lds + L_XC);
    LAS float* sA = (LAS float*)(lds + L_A); LAS float* sB = (LAS float*)(lds + L_B); LAS float* sXR = (LAS float*)(lds + L_A);
    LAS float* sPE = (LAS float*)(lds + L_PE); LAS float* sHE = (LAS float*)(lds + L_HE);
    LAS float* sCP = (LAS float*)(lds + L_A); LAS float* sCH = (LAS float*)(lds + L_A + 4096);
    unsigned long long* CG = (unsigned long long*)(ws + WS_CG) + (size_t)e * 1024 * 128;
    int item = blockIdx.x;
    if (item >= 1024) return;
    LruPre cur; lru_load(p, e, item, cur, tid);
    int cur_h = -1;
    float cw0 = 0.f, cw1 = 0.f, cw2 = 0.f, cw3 = 0.f, cb = 0.f;
    for (;;) {
        const int h = item & 7, b = (item >> 3) & 7, c = item >> 6, ch0 = h * 64, row0 = b * SEQ + c * 128;
        if (h != cur_h) {
            cur_h = h;
            const int g = tid >> 8, n = (tid >> 2) & 63, pt = tid & 3;
            const bf16_t* gw = (const bf16_t*)(ws + WS_GW) + (size_t)((e * 2 + g) * 8 + h) * 4096 + n * 64 + pt * 16;
            const u32x4 w0 = *(const u32x4*)gw, w1 = *(const u32x4*)(gw + 8);
            LAS unsigned char* d = lds + L_GW + ((g * 64 + n) * 72 + pt * 16) * 2;
            *(LAS u32x4*)d = w0; *(LAS u32x4*)(d + 16) = w1;
            if (tid < 48) {
                const int which = tid >> 4, c4 = (tid & 15) * 4;
                const float* src = which == 0 ? ba : (which == 1 ? bx : sp);
                *(LAS f32x4*)(lds + L_SC + which * 256 + c4 * 4) = *(const f32x4*)(src + ch0 + c4);
            }
            cw0 = p.conv_w[(e * 4 + 0) * 512 + ch0 + ch]; cw1 = p.conv_w[(e * 4 + 1) * 512 + ch0 + ch]; cw2 = p.conv_w[(e * 4 + 2) * 512 + ch0 + ch];
            cw3 = p.conv_w[(e * 4 + 3) * 512 + ch0 + ch]; cb = p.conv_b[e * 512 + ch0 + ch];
        }
#pragma unroll
        for (int i = 0; i < 3; ++i) {
            const int rr = rr8 + 64 * i;
            if (rr < 131) { f32x4 xl, xh; bf8_to_f32(cur.x[i], xl, xh);
                *(LAS f32x4*)(sXR + rr * 64 + part * 8) = xl; *(LAS f32x4*)(sXR + rr * 64 + part * 8 + 4) = xh; }
        }
        const int nitem = item + G; const bool has_next = nitem < 1024;
        LruPre nxt = cur;
        if (has_next) lru_load(p, e, nitem, nxt, tid);
        __syncthreads();
        {
            float xv[19];
#pragma unroll
            for (int j = 0; j < 19; ++j) xv[j] = sXR[(tq * 16 + j) * 64 + ch];
#pragma unroll
            for (int i = 0; i < 16; ++i) {
                const float xc = cb + cw0 * xv[i] + cw1 * xv[i + 1] + cw2 * xv[i + 2] + cw3 * xv[i + 3];
                const int t = tq * 16 + i;
                sXF[t * PF + ch] = xc; sXC[t * 72 + ch] = f2bf(xc);
            }
            if (c == 15 && tq == 7) {
                float* co = p.out + O_CONVP + ((size_t)(e * 8 + b) * 3) * 512 + ch0 + ch;
                co[0] = xv[16]; co[512] = xv[17]; co[1024] = xv[18];
            }
        }
        __syncthreads();
        lru_gates(lds);
        __syncthreads();
        {
            float Hl[16], Pc[16];
            float Hh = 0.f, Pp = 1.f;
#pragma unroll
            for (int i = 0; i < 16; ++i) {
                const float a = sA[(tq * 16 + i) * PF + ch], bb = sB[(tq * 16 + i) * PF + ch];
                Hh = a * Hh + bb; Pp = Pp * a; Hl[i] = Hh; Pc[i] = Pp;
            }
            sPE[tq * 64 + ch] = Pp; sHE[tq * 64 + ch] = Hh;
            __syncthreads();
            if (tq == 7 && c < 15) {
                float Pt = 1.f, Ht = 0.f;
#pragma unroll
                for (int s2 = 0; s2 < 8; ++s2) { const float pe = sPE[s2 * 64 + ch]; Ht = pe * Ht + sHE[s2 * 64 + ch]; Pt *= pe; }
                unsigned long long* g = CG + (size_t)item * 128 + ch;
                __hip_atomic_store(g, (1ull << 32) | (unsigned long long)__float_as_uint(Pt), __ATOMIC_RELAXED, __HIP_MEMORY_SCOPE_AGENT);
                __hip_atomic_store(g + 64, (1ull << 32) | (unsigned long long)__float_as_uint(Ht), __ATOMIC_RELAXED, __HIP_MEMORY_SCOPE_AGENT);
            }
#pragma unroll
            for (int q = 0; q < 2; ++q) {
                const int j = tq + 8 * q;
                if (j < c) {
                    unsigned long long* g = CG + (size_t)(j * 64 + (item & 63)) * 128 + ch;
                    unsigned long long gp = cur.gq[q][0], gh = cur.gq[q][1]; unsigned spin = 0;
                    while (!((gp >> 32) == 1ull && (gh >> 32) == 1ull) && ++spin < (1u << 24)) {
                        __builtin_amdgcn_s_sleep(1);
                        gp = __hip_atomic_load(g, __ATOMIC_RELAXED, __HIP_MEMORY_SCOPE_AGENT); gh = __hip_atomic_load(g + 64, __ATOMIC_RELAXED, __HIP_MEMORY_SCOPE_AGENT);
                    }
                    sCP[j * 64 + ch] = __uint_as_float((unsigned)gp); sCH[j * 64 + ch] = __uint_as_float((unsigned)gh);
                }
            }
            __syncthreads();
            float hin = 0.f;
            {
                float cp[15], chv[15], pe[7], he[7];
#pragma unroll
                for (int j = 0; j < 15; ++j) { cp[j] = sCP[j * 64 + ch]; chv[j] = sCH[j * 64 + ch]; }
#pragma unroll
                for (int s2 = 0; s2 < 7; ++s2) { pe[s2] = sPE[s2 * 64 + ch]; he[s2] = sHE[s2 * 64 + ch]; }
#pragma unroll
                for (int j = 0; j < 15; ++j) hin = (j < c) ? cp[j] * hin + chv[j] : hin;
#pragma unroll
                for (int s2 = 0; s2 < 7; ++s2) hin = (s2 < tq) ? pe[s2] * hin + he[s2] : hin;
            }
            float hlast = 0.f;
#pragma unroll
            for (int i = 0; i < 16; ++i) { const float hv = Hl[i] + Pc[i] * hin; hlast = hv; sXF[(tq * 16 + i) * PF + ch] = hv; }
            if (tq == 7 && c == 15) p.out[O_HP + (size_t)(e * 8 + b) * 512 + ch0 + ch] = hlast;
            __syncthreads();
        }
#pragma unroll
        for (int i = 0; i < 2; ++i) {
            const int t = rr8 + 64 * i;
            f32x4 gl, gh; bf8_to_f32(cur.gg[i], gl, gh);
            const f32x4 hl = *(const LAS f32x4*)(sXF + t * PF + part * 8), hh = *(const LAS f32x4*)(sXF + t * PF + part * 8 + 4);
            *(u32x4*)(AB + (size_t)(row0 + t) * DM + 512 + ch0 + part * 8) = f32_to_bf8(hl * gl, hh * gh);
        }
        if (!has_next) break;
        cur = nxt; item = nitem;
    }
    __syncthreads();
}

__device__ void phase_e2(const Params& p, int e, LAS unsigned char* lds, int G) {
    lru_prompt_loop(p, e, lds, G);
    constexpr int NLRU = 1032;
    int itg = blockIdx.x; while (itg < 1024) itg += G;
    for (; itg < NLRU; itg += G) lru_item(p, e, itg, lds);
    const int tid = opaque_tid();
    const int blk = blockIdx.x;
    const int j0 = blk >= 8 ? blk - 8 : 248 + blk;
    const int nit = blk < 8 ? 2 : ((blk >= 40 && blk < 56) ? 5 : 4);
#define SGU_IDX(k) ((k) < 4 ? j0 + 256 * (k) : 760 + ((blk - 40) & 7) + 256 * ((blk - 40) >> 3))
    {
        SguPre A, B; sgu_load(p, e, SGU_IDX(0), A, tid); B = A;
        int k = 0;
        for (;;) {
            if (k + 1 < nit) sgu_load(p, e, SGU_IDX(k + 1), B, tid);
            sgu_compute(p, SGU_IDX(k), A, lds, tid);
            if (++k >= nit) break;
            if (k + 1 < nit) sgu_load(p, e, SGU_IDX(k + 1), A, tid);
            sgu_compute(p, SGU_IDX(k), B, lds, tid);
            if (++k >= nit) break;
        }
    }
#undef SGU_IDX
    if (blk >= 8 && blk < 40) sgu_item(p, e, 1024 + blk - 8, lds);
}

template <int W>
__device__ __forceinline__ void pool_rows(const float (&v0)[31], const float (&v1)[31], int t0, bf16_t* pa) {
    float s0 = 0.f, s1 = 0.f;
#pragma unroll
    for (int q = 0; q < W; ++q) { s0 += v0[15 - q]; s1 += v1[15 - q]; }
#pragma unroll
    for (int i = 0; i < 16; ++i) {
        const int jj = 15 + i, t = t0 + i;
        if (i > 0) { s0 += v0[jj] - v0[jj - W]; s1 += v1[jj] - v1[jj - W]; }
        const float ic = (t + 1 < W) ? 1.0f / (float)(t + 1) : (1.0f / (float)W);
        *(unsigned*)(pa + (size_t)i * DM) = cvt_pk_bf16(s0 * ic - v0[jj], s1 * ic - v1[jj]);
    }
}

__device__ void sample_pool_pre(const Params& p, int G) {
    const int tid = opaque_tid();
    const int c = tid * 2, w = 2 << (c >> 8);
    float* SPS = (float*)(p.ws + WS_SPSUM);
    for (int it = blockIdx.x; it < 2 * MS; it += G) {
        const int o = it >> 7, r = it & 127;
        const float* sp = p.state_pool + ((size_t)(o * 128 + r) * 15) * DM + c;
        float* po = p.out + O_POOLS + ((size_t)(o * 128 + r) * 15) * DM + c;
        f32x2 z[15];
#pragma unroll
        for (int k = 0; k < 15; ++k) z[k] = *(const f32x2*)(sp + (size_t)k * DM);
        float s0 = 0.f, s1 = 0.f;
#pragma unroll
        for (int k = 14; k >= 0; --k) {
            if (14 - k < w - 1) { s0 += z[k].x; s1 += z[k].y; }
            if (k >= 1) *(f32x2*)(po + (size_t)(k - 1) * DM) = z[k];
        }
        f32x2 sv; sv.x = s0; sv.y = s1;
        *(f32x2*)(SPS + (size_t)(o * 128 + r) * DM + c) = sv;
    }
}

template <int W>
__device__ __forceinline__ void pool_tile_rows(const Params& p, int layer, int pm, int pn, LAS float* sRS, int tid) {
    const int o = layer >> 1, b = pm >> 3, tbase = (pm & 7) * 256;
    const bf16_t* X = (const bf16_t*)(p.ws + WS_XG); bf16_t* PA = (bf16_t*)(p.ws + WS_PA);
    const bf16_t* HALO = (const bf16_t*)(p.ws + WS_HALO);
    const int c = pn * 256 + (tid & 127) * 2;
    const f32x2 gmix = *(const f32x2*)(p.norm_mix + layer * DM + c);
    for (int s = tid >> 7; s < 16; s += 4) {
        const int t0 = tbase + s * 16;
        unsigned wv[31];
#pragma unroll
        for (int j = 0; j < 31; ++j) {
            const int tl = t0 - 15 + j;
            const bf16_t* src = (s == 0 && j < 15) ? HALO + (size_t)((pm - 1) * 16 + j + 1) * DM + c : X + (size_t)(b * SEQ + tl) * DM + c;
            wv[j] = (tl >= 0) ? *(const unsigned*)src : 0u;
        }
        float v0[31], v1[31];
#pragma unroll
        for (int j = 0; j < 31; ++j) { const float rs = sRS[s * 16 + j]; v0[j] = bflo(wv[j]) * rs * gmix.x; v1[j] = bfhi(wv[j]) * rs * gmix.y; }
        pool_rows<W>(v0, v1, t0, PA + (size_t)(b * SEQ + t0) * DM + c);
        if (t0 == SEQ - 16) {
#pragma unroll
            for (int k = 0; k < 15; ++k) { f32x2 z; z.x = v0[16 + k]; z.y = v1[16 + k]; *(f32x2*)(p.out + O_POOLP + ((size_t)(o * 8 + b) * 15 + k) * DM + c) = z; }
        }
    }
}
__device__ void pool_tile_prep(const Params& p, int layer, int pm, int pn, LAS unsigned char* lds) {
    const int tid = opaque_tid();
    const float* SSQ = (const float*)(p.ws + WS_SSQ);
    LAS float* sRS = (LAS float*)lds;
    const int b = pm >> 3, tbase = (pm & 7) * 256;
    if (tid < 271) { const int tl = tbase - 15 + tid; sRS[tid] = tl >= 0 ? row_rs16(SSQ, b * SEQ + tl) : 0.f; }
    __syncthreads();
    if (pn == 0) pool_tile_rows<2>(p, layer, pm, pn, sRS, tid); else if (pn == 1) pool_tile_rows<4>(p, layer, pm, pn, sRS, tid);
    else if (pn == 2) pool_tile_rows<8>(p, layer, pm, pn, sRS, tid); else pool_tile_rows<16>(p, layer, pm, pn, sRS, tid);
    asm volatile("s_waitcnt vmcnt(0)" ::: "memory");
    __syncthreads();
}

template <class Epi>
__device__ __forceinline__ void skinny_pool(const Params& p, int layer, const bf16_t* Bt, const Epi& E, int G, const bf16_t* Xs, const float* SSQS) {
    const int tid = opaque_tid(), wave = tid >> 6, lane = tid & 63, fr = lane & 15, fq = lane >> 4;
    const int o = layer >> 1;
    const float* SPS = (const float*)(p.ws + WS_SPSUM) + (size_t)o * MS * DM;
    for (int ct = blockIdx.x; ct < 64; ct += G) {
        const int r = wave * 16 + fr, grp = ct >> 4, w = 2 << grp;
        const float invw = 1.0f / (float)w;
        const f32x2 pp = E.pre(r, ct * 16 + fq * 4, fq);
        const f32x2 ssp = ssqs_part(SSQS, r, fq);
        u32x4 xw[8]; bf16x8 bfr[8];
#pragma unroll
        for (int j = 0; j < 8; ++j) {
            const int col = grp * 256 + j * 32 + fq * 8;
            xw[j] = *(const u32x4*)(Xs + (size_t)r * DM + col);
            bfr[j] = *(const bf16x8*)(Bt + (size_t)(ct * 16 + fr) * 256 + j * 32 + fq * 8);
        }
        const float rs = ssqs_finish(ssp);
        f32x4 acc = (f32x4){0.f, 0.f, 0.f, 0.f};
#pragma unroll
        for (int j = 0; j < 8; ++j) {
            const int col = grp * 256 + j * 32 + fq * 8;
            const f32x4 s0 = *(const f32x4*)(SPS + (size_t)r * DM + col), s1 = *(const f32x4*)(SPS + (size_t)r * DM + col + 4);
            const f32x4 g0 = *(const f32x4*)(p.norm_mix + layer * DM + col), g1 = *(const f32x4*)(p.norm_mix + layer * DM + col + 4);
            f32x4 x0, x1; bf8_to_f32(xw[j], x0, x1);
            x0 = x0 * g0 * rs; x1 = x1 * g1 * rs;
            if ((ct & 15) == 0) { float* po = p.out + O_POOLS + ((size_t)(o * 128 + r) * 15 + 14) * DM + col; *(f32x4*)po = x0; *(f32x4*)(po + 4) = x1; }
            const f32x4 p0 = (x0 + s0) * invw - x0, p1 = (x1 + s1) * invw - x1;
            const u32x4 pk = pack_bf8(p0, p1);
            bf16x8 af; __builtin_memcpy(&af, &pk, 16);
            acc = __builtin_amdgcn_mfma_f32_16x16x32_bf16(bfr[j], af, acc, 0, 0, 0);
        }
        E(r, ct * 16 + fq * 4, ct, fq, acc, pp);
    }
}

__device__ void phase_final(const Params& p, int G, const bf16_t* Xs, const float* SSQS) {
    const int tidf = opaque_tid();
    const int wave = tidf >> 6, lane = tidf & 63;
    const float* SSQ = (const float*)(p.ws + WS_SSQ);
    const bf16_t* X = (const bf16_t*)(p.ws + WS_XG);
    for (int row = blockIdx.x * 8 + wave; row < MR; row += G * 8) {
        const float rs = row < MP ? row_rs16(SSQ, row) : rs_sample_full(SSQS, row - MP);
        float* yr = p.out + (size_t)row * DM;
#pragma unroll
        for (int q = 0; q < 4; ++q) {
            const int col = q * 256 + lane * 4;
            const u32x2 xw = row < MP ? *(const u32x2*)(X + (size_t)row * DM + col) : *(const u32x2*)(Xs + (size_t)(row - MP) * DM + col);
            const f32x4 gv = *(const f32x4*)(p.norm_final + col);
            f32x4 v; v[0] = bflo(xw.x); v[1] = bfhi(xw.x); v[2] = bflo(xw.y); v[3] = bfhi(xw.y);
            *(f32x4*)(yr + col) = v * gv * rs;
        }
    }
}

__global__ void __launch_bounds__(NTHR, 2) fwd_megakernel(Params p) {
    extern __shared__ __attribute__((aligned(16))) unsigned char smem[];
    LAS unsigned char* lds = (LAS unsigned char*)smem;
    cg::grid_group grid = cg::this_grid();
    const int G = gridDim.x;
    unsigned char* ws = p.ws;
    bf16_t* XG = (bf16_t*)(ws + WS_XG); float* SSQ = (float*)(ws + WS_SSQ);

    volatile LAS unsigned* st = (volatile LAS unsigned*)(lds + LDS_BYTES - 16);
    if (threadIdx.x < 4) st[threadIdx.x] = 0u;
    __syncthreads();
    const XcdBarrier bar = xcd_barrier_post((unsigned*)(ws + WS_BAR), st);
    float* SSQ2 = (float*)(ws + WS_SSQ2); bf16_t* HALO = (bf16_t*)(ws + WS_HALO);
    bf16_t* Xs_cur = XG + (size_t)MP * DM; bf16_t* Xs_alt = (bf16_t*)(ws + WS_XS2);
    float* SSQS_cur = (float*)(ws + WS_SSQS); float* SSQS_alt = (float*)(ws + WS_SSQS2);

    if (p.ws == nullptr) grid.sync();
    phase_prep(p, lds, G);
    xcd_barrier_arrive(bar); gap_convert(p, 0, lds, G); gap0_extras(p, lds, G); xcd_barrier_wait(bar);

    for (int ph = 0; ph < 16; ++ph) {
        const int q = ph & 7, layer = (ph >> 3) * 2 + (q >= 5 ? 1 : 0);
        const int kind = q < 5 ? q : (q == 5 ? 6 : q - 3);
        if (kind == 0) {
            const int e = layer >> 1;
            const bf16_t* Wt = (const bf16_t*)(ws + WS_WIN) + (size_t)e * DIN * DM;
            pg8::Gemm g{XG, Wt, MP, DIN, DM, DM, DM, 0};
            pg8::StaticOrder S; S.init(MP, DIN, G, (int)blockIdx.x);
            pg8::Unit u0; const int pm0 = S.next(0, u0) ? u0.pm : -1;
            if (pm0 >= 0) fill_rs_table(lds, SSQ, pm0);
            EpiE1 E{SSQ, (bf16_t*)(ws + WS_U), (float*)(ws + WS_VSSQ), lds, pm0};
            pg8::gemm_phase<EpiE1>(lds, g, S, E);
            SkE1 Es{SSQS_cur, (bf16_t*)(ws + WS_U), (float*)(ws + WS_VSSQS)};
            skinny_gemm_k1024<SkE1>(lds, Xs_cur, DM, Wt, DM, DIN, Es, G);
        } else if (kind == 1) {
            phase_e2(p, layer >> 1, lds, G);
        } else if (kind == 2) {
            const int e = layer >> 1;
            const bf16_t* Wt = (const bf16_t*)(ws + WS_WOUT) + (size_t)e * DM * DM;
            pg8::Gemm g{(const bf16_t*)(ws + WS_AB), Wt, MP, DM, DM, DM, DM, 0};
            pg8::StaticOrder S; S.init(MP, DM, G, (int)blockIdx.x);
            EpiRes E{XG, SSQ, nullptr, nullptr, lds, nullptr};
            pg8::gemm_phase<EpiRes>(lds, g, S, E);
            SkRes Es{Xs_cur, Xs_cur, SSQS_cur, nullptr, nullptr};
            skinny_gemm<4, 8, SkRes>(lds, (const bf16_t*)(ws + WS_AB) + (size_t)MP * DM, DM, 0, Wt, DM, DM, DM, Es, G);
        } else if (kind == 6) {
            const int o = layer >> 1;
            const bf16_t* Wt = (const bf16_t*)(ws + WS_WP) + (size_t)o * DM * 256;
            pg8::Gemm g{(const bf16_t*)(ws + WS_PA), Wt, MP, DM, 256, DM, 256, 256};
            pg8::StaticOrder S; S.init(MP, DM, G, (int)blockIdx.x);
            { pg8::Unit u0; if (S.next(0, u0)) pool_tile_prep(p, layer, u0.pm, u0.pn, lds); }
            EpiRes E{XG, SSQ2, p.pool_b + o * DM, p.pool_scale + o * DM, lds, nullptr};
            pg8::gemm_phase<EpiRes>(lds, g, S, E);
            SkRes Es{Xs_cur, Xs_alt, SSQS_alt, p.pool_b + o * DM, p.pool_scale + o * DM};
            skinny_pool<SkRes>(p, layer, Wt, Es, G, Xs_cur, SSQS_cur);
            { bf16_t* tx = Xs_cur; Xs_cur = Xs_alt; Xs_alt = tx; float* ts = SSQS_cur; SSQS_cur = SSQS_alt; SSQS_alt = ts; }
        } else if (kind == 3) {
            const bf16_t* Wt = (const bf16_t*)(ws + WS_W1) + (size_t)layer * DFF * DM;
            pg8::Gemm g{XG, Wt, MP, DFF, DM, DM, DM, 0};
            pg8::StaticOrder S; S.init(MP, DFF, G, (int)blockIdx.x);
            pg8::Unit u0; const int pm0 = S.next(0, u0) ? u0.pm : -1;
            const float* ssq_in = (layer & 1) ? SSQ2 : SSQ;
            if (pm0 >= 0) fill_rs_table(lds, ssq_in, pm0);
            EpiF1 E{ssq_in, (bf16_t*)(ws + WS_H), lds, pm0};
            pg8::gemm_phase<EpiF1>(lds, g, S, E);
            SkF1 Es{SSQS_cur, (bf16_t*)(ws + WS_H)};
            skinny_gemm_k1024<SkF1>(lds, Xs_cur, DM, Wt, DM, DFF, Es, G);
        } else {
            const bf16_t* Wt = (const bf16_t*)(ws + WS_W2) + (size_t)layer * DM * DFF;
            pg8::Gemm g{(const bf16_t*)(ws + WS_H), Wt, MP, DM, DFF, DFF, DFF, 0};
            pg8::StaticOrder S; S.init(MP, DM, G, (int)blockIdx.x);
            EpiRes E{XG, SSQ, nullptr, nullptr, lds, (layer & 1) ? nullptr : HALO};
            pg8::gemm_phase<EpiRes>(lds, g, S, E);
            SkRes Es{Xs_cur, Xs_cur, SSQS_cur, nullptr, nullptr};
            skinny_gemm_k4096<SkRes>(lds, (const bf16_t*)(ws + WS_H) + (size_t)MP * DFF, DFF, Wt, DFF, DM, Es, G);
        }
        xcd_barrier_arrive(bar); gap_convert(p, ph + 1, lds, G); xcd_barrier_wait(bar);
    }
    phase_final(p, G, Xs_cur, SSQS_cur);
}

extern "C" void kernel_launch(void* const* d_in, const int* in_sizes, int n_in, void* d_out, int out_size, void* d_ws, size_t ws_size, hipStream_t stream) {
    static int grid_blocks = 0;
    if (grid_blocks == 0) {
        if (n_in != 25 || (size_t)out_size != O_END || ws_size < WS_END) {
            fprintf(stderr, "kernel_launch: unexpected shapes: n_in %d out %d (want %zu) ws %zu (need %zu)\n", n_in, out_size, (size_t)O_END, ws_size, (size_t)WS_END);
            grid_blocks = -1; return;
        }
        int dev = 0, cus = 0, per_cu = 0;
        hipGetDevice(&dev);
        hipDeviceGetAttribute(&cus, hipDeviceAttributeMultiprocessorCount, dev);
        if (hipFuncSetAttribute((const void*)fwd_megakernel, hipFuncAttributeMaxDynamicSharedMemorySize, LDS_BYTES) != hipSuccess) { fprintf(stderr, "kernel_launch: hipFuncSetAttribute failed\n"); grid_blocks = -1; return; }
        if (hipOccupancyMaxActiveBlocksPerMultiprocessor(&per_cu, (const void*)fwd_megakernel, NTHR, LDS_BYTES) != hipSuccess || per_cu < 1) { fprintf(stderr, "kernel_launch: occupancy query failed (%d)\n", per_cu); (void)hipGetLastError(); per_cu = 1; }
        grid_blocks = cus * 1;
        if (grid_blocks != 256) { fprintf(stderr, "kernel_launch: this kernel is laid out for 256 CUs, found %d\n", cus); grid_blocks = -1; return; }
    }
    if (grid_blocks < 0) return;
    Params p{};
    const float** pp = (const float**)&p;
    for (int i = 0; i < 25; ++i) pp[i] = (const float*)d_in[i];
    p.out = (float*)d_out; p.ws = (unsigned char*)d_ws;
    if (hipMemsetAsync((char*)d_ws + WS_BAR, 0, 16384, stream) != hipSuccess) { fprintf(stderr, "kernel_launch: memset failed\n"); return; }
    void* args[] = {&p};
    hipError_t e = hipLaunchCooperativeKernel((const void*)fwd_megakernel, dim3(grid_blocks), dim3(NTHR), args, LDS_BYTES, stream);
    if (e != hipSuccess) fprintf(stderr, "cooperative launch failed: %s (grid %d)\n", hipGetErrorString(e), grid_blocks);
}
```

```cpp
#include <hip/hip_runtime.h>
#include <hip/hip_cooperative_groups.h>
#include <cstdio>
namespace cg = cooperative_groups;

#define LAS __attribute__((address_space(3)))
typedef unsigned short bf16_t;
typedef short bf16x8 __attribute__((ext_vector_type(8)));
typedef float f32x4 __attribute__((ext_vector_type(4)));
typedef float f32x2 __attribute__((ext_vector_type(2)));
typedef unsigned u32x4 __attribute__((ext_vector_type(4)));
typedef unsigned u32x2 __attribute__((ext_vector_type(2)));

constexpr int DM = 1024, NBATCH = 8, SEQ = 2048, MP = NBATCH * SEQ, MS = 128, MR = MP + MS, MPAD = 16640;
constexpr int DFF = 4096, WA = 512, WB = 512, DIN = 2048;
constexpr float EPS = 1e-6f;
constexpr int NTHR = 512;
constexpr int LDS_BYTES = 148 * 1024;

constexpr size_t O_YP = 0, O_YS = O_YP + (size_t)MP * DM, O_SGUV = O_YS + (size_t)MS * DM, O_CONVP = O_SGUV + 2 * MS * WA,
                 O_CONVS = O_CONVP + 2 * NBATCH * 3 * WB, O_HP = O_CONVS + 2 * MS * 3 * WB, O_HS = O_HP + 2 * NBATCH * WB,
                 O_POOLP = O_HS + 2 * MS * WB, O_POOLS = O_POOLP + 2 * NBATCH * 15 * DM, O_END = O_POOLS + (size_t)2 * MS * 15 * DM;

constexpr size_t WS_WIN = 0;
constexpr size_t WS_WOUT = WS_WIN + (size_t)2 * DIN * DM * 2;
constexpr size_t WS_W1 = WS_WOUT + (size_t)2 * DM * DM * 2;
constexpr size_t WS_W2 = WS_W1 + (size_t)4 * DFF * DM * 2;
constexpr size_t WS_WP = WS_W2 + (size_t)4 * DFF * DM * 2;
constexpr size_t WS_GW = WS_WP + (size_t)2 * DM * 256 * 2;
constexpr size_t WS_SW = WS_GW + (size_t)2 * 2 * 8 * 64 * 64 * 2;
constexpr size_t WS_SP = WS_SW + (size_t)2 * 8 * 128 * 128 * 2;
constexpr size_t WS_SSQ = WS_SP + 4096;
constexpr size_t WS_VSSQ = WS_SSQ + (size_t)MPAD * 16 * 4;
constexpr size_t WS_XG = WS_VSSQ + (size_t)MPAD * 8 * 4;
constexpr size_t WS_H = WS_XG + (size_t)MPAD * DM * 2;
constexpr size_t WS_U = WS_H, WS_VP = WS_U + (size_t)MPAD * 512 * 2, WS_GG = WS_VP + (size_t)MPAD * 512 * 2, WS_XB = WS_GG + (size_t)MPAD * 512 * 2,
                 WS_AB = WS_XB + (size_t)MPAD * 512 * 2, WS_PA = WS_H;
constexpr size_t WS_SSQS = WS_H + (size_t)MPAD * DFF * 2;
constexpr size_t WS_VSSQS = WS_SSQS + (size_t)MS * 64 * 4;
constexpr size_t WS_CG = WS_VSSQS + (size_t)MS * 32 * 4;
constexpr size_t WS_BAR = WS_CG + (size_t)2 * 1024 * 128 * 8;
constexpr size_t WS_SPSUM = WS_BAR + 16384;
constexpr size_t WS_SSQ2 = WS_SPSUM + (size_t)2 * MS * DM * 4;
constexpr size_t WS_HALO = WS_SSQ2 + (size_t)MPAD * 16 * 4;
constexpr size_t WS_XS2 = WS_HALO + (size_t)64 * 16 * DM * 2;
constexpr size_t WS_SSQS2 = WS_XS2 + (size_t)MS * DM * 2;
constexpr size_t WS_END = WS_SSQS2 + (size_t)MS * 64 * 4;

struct Params {
    const float *x_prompt, *x_sample, *state_conv, *state_rglru, *state_pool;
    const float *norm_mix, *norm_ffn, *norm_final, *w_in, *w_out, *v_norm, *sgu_w, *sgu_b;
    const float *conv_w, *conv_b, *gate_a_w, *gate_a_b, *gate_x_w, *gate_x_b, *lru_lambda;
    const float *pool_w, *pool_b, *pool_scale, *ffn_w1, *ffn_w2;
    float* out;
    unsigned char* ws;
};

__device__ __forceinline__ int opaque_tid() { int t = threadIdx.x; asm volatile("" : "+v"(t)); return t; }
__device__ __forceinline__ unsigned cvt_pk_bf16(float lo, float hi) { unsigned r; asm volatile("v_cvt_pk_bf16_f32 %0, %1, %2" : "=v"(r) : "v"(lo), "v"(hi)); return r; }
__device__ __forceinline__ float bf2f(unsigned short b) { return __uint_as_float(((unsigned)b) << 16); }
__device__ __forceinline__ float bflo(unsigned w) { return __uint_as_float(w << 16); }
__device__ __forceinline__ float bfhi(unsigned w) { return __uint_as_float(w & 0xffff0000u); }
__device__ __forceinline__ unsigned short f2bf(float f) { return (unsigned short)(cvt_pk_bf16(f, 0.f) & 0xffffu); }
__device__ __forceinline__ void bf8_to_f32(u32x4 w, f32x4& lo, f32x4& hi) {
    lo[0] = bflo(w.x); lo[1] = bfhi(w.x); lo[2] = bflo(w.y); lo[3] = bfhi(w.y);
    hi[0] = bflo(w.z); hi[1] = bfhi(w.z); hi[2] = bflo(w.w); hi[3] = bfhi(w.w);
}
__device__ __forceinline__ void st_wt16(void* base, unsigned off, u32x4 v) { const __amdgpu_buffer_rsrc_t rs = __builtin_amdgcn_make_buffer_rsrc(base, 0, 0x7fffffff, 0x00020000); __builtin_amdgcn_raw_buffer_store_b128(v, rs, off, 0, 16); }
__device__ __forceinline__ void st_wt8(void* base, unsigned off, u32x2 v) { const __amdgpu_buffer_rsrc_t rs = __builtin_amdgcn_make_buffer_rsrc(base, 0, 0x7fffffff, 0x00020000); __builtin_amdgcn_raw_buffer_store_b64(v, rs, off, 0, 16); }
__device__ __forceinline__ float gelu_t(float x) {
    const float z = x * (0.7978845608f + 0.0356774081f * x * x);
    const float e = __builtin_amdgcn_exp2f(z * 2.885390082f);
    return x - x * __builtin_amdgcn_rcpf(e + 1.0f);
}
__device__ __forceinline__ f32x2 gelu_t2(f32x2 x) {
    const f32x2 t = x * x;
    const f32x2 u = t * 0.1029432397f + 2.302208198f;
    const f32x2 a = x * u;
    f32x2 e; e.x = __builtin_amdgcn_exp2f(a.x); e.y = __builtin_amdgcn_exp2f(a.y);
    const f32x2 d = e + 1.0f;
    f32x2 r; r.x = __builtin_amdgcn_rcpf(d.x); r.y = __builtin_amdgcn_rcpf(d.y);
    return x - x * r;
}
__device__ __forceinline__ float sigmoid_f(float x) { return __builtin_amdgcn_rcpf(1.0f + __builtin_amdgcn_exp2f(-1.442695041f * x)); }
__device__ __forceinline__ float row_rs16(const float* ssq, int row) {
    const f32x4* q = (const f32x4*)(ssq + (size_t)row * 16);
    const f32x4 a = q[0], b = q[1], c = q[2], d = q[3];
    const float s = (a[0] + a[1] + a[2] + a[3]) + (b[0] + b[1] + b[2] + b[3]) + (c[0] + c[1] + c[2] + c[3]) + (d[0] + d[1] + d[2] + d[3]);
    return __builtin_amdgcn_rsqf(s * (1.0f / 1024.0f) + EPS);
}
__device__ __forceinline__ float row_rs8(const float* vssq, int row) {
    const f32x4* q = (const f32x4*)(vssq + (size_t)row * 8);
    const f32x4 a = q[0], b = q[1];
    const float s = (a[0] + a[1] + a[2] + a[3]) + (b[0] + b[1] + b[2] + b[3]);
    return __builtin_amdgcn_rsqf(s * (1.0f / 512.0f) + EPS);
}


__device__ __forceinline__ float rs_sample_q(const float* ssqs, int r, int fq) {
    const f32x4* q = (const f32x4*)(ssqs + (size_t)r * 64 + fq * 16);
    const f32x4 a = q[0], b = q[1], c = q[2], d = q[3];
    float s = (a[0] + a[1] + a[2] + a[3]) + (b[0] + b[1] + b[2] + b[3]) + (c[0] + c[1] + c[2] + c[3]) + (d[0] + d[1] + d[2] + d[3]);
    s += __shfl_xor(s, 16); s += __shfl_xor(s, 32);
    return __builtin_amdgcn_rsqf(s * (1.0f / 1024.0f) + EPS);
}
__device__ __forceinline__ float rs_sample_full(const float* ssqs, int r) {
    float s = 0.f;
#pragma unroll
    for (int i = 0; i < 16; ++i) { const f32x4 a = *(const f32x4*)(ssqs + (size_t)r * 64 + i * 4); s += (a[0] + a[1]) + (a[2] + a[3]); }
    return __builtin_amdgcn_rsqf(s * (1.0f / 1024.0f) + EPS);
}
__device__ __forceinline__ float rsv_sample_full(const float* vssqs, int r) {
    float s = 0.f;
#pragma unroll
    for (int i = 0; i < 8; ++i) { const f32x4 a = *(const f32x4*)(vssqs + (size_t)r * 32 + i * 4); s += (a[0] + a[1]) + (a[2] + a[3]); }
    return __builtin_amdgcn_rsqf(s * (1.0f / 512.0f) + EPS);
}

#define XB_TMO      128
#define XB_XCNT(j)  (256  + 64 * (j))
#define XB_XSUB(j)  (1280 + 64 * (j))
#define XB_XGEN(j)  (2304 + 64 * (j))
#define XB_TOP      3328
#define XB_TOPGEN   3392
#define XCD_BAR_WORDS 3456
#define XB_SPIN_CAP (1u << 22)
__device__ __forceinline__ unsigned xb_ld(unsigned* p)              { return __hip_atomic_load(p, __ATOMIC_RELAXED, __HIP_MEMORY_SCOPE_AGENT); }
__device__ __forceinline__ unsigned xb_add(unsigned* p, unsigned v) { return __hip_atomic_fetch_add(p, v, __ATOMIC_RELAXED, __HIP_MEMORY_SCOPE_AGENT); }
__device__ __forceinline__ unsigned xb_xcc_id() { return (unsigned)__builtin_amdgcn_s_getreg((3 << 11) | 20) & 0xFu; }
#define XB_SPIN(cond, bar) do { unsigned _sp = 0; while (cond) { __builtin_amdgcn_s_sleep(1); \
    if ((++_sp & 255u) == 0u) { if (xb_ld(&(bar)[XB_TMO])) break; if (_sp > XB_SPIN_CAP) { atomicAdd(&(bar)[XB_TMO], 1u); break; } } } } while (0)
struct XcdBarrier { unsigned* bar; unsigned x; volatile LAS unsigned* st; };
__device__ __forceinline__ XcdBarrier xcd_barrier_post(unsigned* bar, volatile LAS unsigned* st) {
    XcdBarrier b; b.bar = bar; b.x = xb_xcc_id(); b.st = st;
    if (threadIdx.x == 0) (void)xb_add(&bar[XB_XCNT(b.x)], 1u);
    return b;
}
__device__ __forceinline__ void xcd_barrier_complete(unsigned* bar, unsigned x, unsigned& nloc, unsigned& nx) {
    const unsigned G = gridDim.x * gridDim.y * gridDim.z;
    unsigned sum, cnt, mine, sp = 0u;
    for (;;) {
        sum = 0u; cnt = 0u; mine = 0u;
#pragma unroll
        for (unsigned j = 0; j < 16; ++j) { const unsigned c = xb_ld(&bar[XB_XCNT(j)]); sum += c; cnt += (c > 0u) ? 1u : 0u; mine = (j == x) ? c : mine; }
        if (sum == G) break;
        __builtin_amdgcn_s_sleep(1);
        if ((++sp & 255u) == 0u) { if (xb_ld(&bar[XB_TMO])) break; if (sp > XB_SPIN_CAP) { atomicAdd(&bar[XB_TMO], 1u); break; } }
    }
    nloc = mine > 0u ? mine : 1u; nx = cnt > 0u ? cnt : 1u;
}
__device__ __forceinline__ void xcd_barrier_arrive(const XcdBarrier& b) {
    asm volatile("s_waitcnt vmcnt(0)" ::: "memory");
    __syncthreads();
    if (threadIdx.x == 0) {
        unsigned* bar = b.bar;
        __builtin_amdgcn_s_waitcnt(0);
        unsigned nloc = b.st[0], nx = b.st[1];
        if (nloc == 0u) { xcd_barrier_complete(bar, b.x, nloc, nx); b.st[0] = nloc; b.st[1] = nx; }
        const unsigned old = xb_add(&bar[XB_XSUB(b.x)], 1u);
        const unsigned gen = old / nloc;
        unsigned leader = 0u, tg = 0u, lastx = 0u;
        if (old + 1u == (gen + 1u) * nloc) {
            leader = 1u;
            __builtin_amdgcn_fence(__ATOMIC_RELEASE, "agent");
            asm volatile("s_waitcnt vmcnt(0)" ::: "memory");
            const unsigned og = xb_add(&bar[XB_TOP], 1u);
            tg = og / nx;
            if (og + 1u == (tg + 1u) * nx) { xb_add(&bar[XB_TOPGEN], 1u); lastx = 1u; }
        }
        b.st[2] = gen * 2u + leader; b.st[3] = tg * 2u + lastx;
    }
}
__device__ __forceinline__ void xcd_barrier_wait(const XcdBarrier& b) {
    if (threadIdx.x == 0) {
        unsigned* bar = b.bar;
        const unsigned s2 = b.st[2], s3 = b.st[3];
        const unsigned gen = s2 >> 1, leader = s2 & 1u, tg = s3 >> 1, lastx = s3 & 1u;
        if (leader) {
            if (!lastx) XB_SPIN(xb_ld(&bar[XB_TOPGEN]) == tg, bar);
            __builtin_amdgcn_fence(__ATOMIC_ACQUIRE, "agent");
            asm volatile("s_waitcnt vmcnt(0)" ::: "memory");
        } else {
            XB_SPIN(xb_ld(&bar[XB_TOPGEN]) == gen, bar);
            __builtin_amdgcn_fence(__ATOMIC_ACQUIRE, "agent");
            asm volatile("s_waitcnt vmcnt(0)" ::: "memory");
        }
    }
    __syncthreads();
}

namespace pg8 {
constexpr int BM = 256, BK = 64, HALF = 128, HTB = HALF * BK * 2, STAGE_BYTES = 8 * HTB, NXCD = 8, WGM = 8;
__host__ __device__ __forceinline__ int lds_byte(int r, int c) { const int st = (r >> 4) * 2 + (c >> 5), rr = r & 15, cc = c & 31, ob = rr * 64 + cc * 2; return st * 1024 + (ob ^ (((ob >> 9) & 1) << 5)); }
__host__ __device__ __forceinline__ int perm32(int rho) { const int n = rho >> 4, i = rho & 15; return 8 * (i >> 2) + 4 * n + (i & 3); }
__host__ __device__ __forceinline__ void stage_rc(int b, int& R, int& C) { const int st = b / 1024, sb = b % 1024, swz = sb ^ (((sb >> 9) & 1) << 5); R = (st >> 1) * 16 + swz / 64; C = (st & 1) * 32 + (swz % 64) / 2; }

struct Unit { int pm, pn; };
struct Gemm { const bf16_t* A; const bf16_t* Bt; int M, N, K, lda, ldb, a_pn_koff; };

struct StaticOrder {
    int nM, nN, nwg, G, c;
    __device__ void init(int M, int N, int G_, int c_) { nM = M / BM; nN = N / BM; nwg = nM * nN; G = G_; c = c_; }
    __device__ bool next(int i, Unit& u) const {
        const long L = (long)i * G + c; if (L >= nwg) return false;
        int wgid = (int)L; { const int q = nwg / NXCD, r = nwg % NXCD, xcd = wgid % NXCD, off = wgid / NXCD; wgid = (xcd < r ? xcd * (q + 1) : r * (q + 1) + (xcd - r) * q) + off; }
        const int nig = WGM * nN, gid = wgid / nig, fm = gid * WGM, gsz = (nM - fm) < WGM ? (nM - fm) : WGM;
        u.pm = fm + ((wgid % nig) % gsz); u.pn = (wgid % nig) / gsz; return true;
    }
};

constexpr int RS_TAB_OFF = 131072, WT_OFF = 132096, WT_BYTES = 16 * 144;
constexpr int RS_TAB_OFF_UNUSED = 0;
__device__ __forceinline__ f32x4 zero4_b64() {
    f32x2 a, b; asm volatile("v_mov_b64 %0, 0" : "=v"(a)); asm volatile("v_mov_b64 %0, 0" : "=v"(b));
    return (f32x4){a.x, a.y, b.x, b.y};
}
template <class Epi>
__device__ __forceinline__ void gemm_phase(LAS unsigned char* lds, const Gemm g, const StaticOrder& S, const Epi& E) {
    const int tid = opaque_tid(), wid = __builtin_amdgcn_readfirstlane(tid >> 6), lane = tid & 63, wr = wid >> 2, wc = wid & 3, fr = lane & 15, fq = lane >> 4;
    const int K = g.K, nt = K / BK;
    unsigned voffA[2], voffB[2];
#pragma unroll
    for (int i = 0; i < 2; ++i) { int R, C; stage_rc(tid * 16 + i * 8192, R, C);
        const int Rb = 64 * (R >> 5) + 16 * ((R >> 2) & 3) + 4 * ((R >> 4) & 1) + (R & 3);
        voffA[i] = (unsigned)(R * g.lda + C) * 2u; voffB[i] = (unsigned)(Rb * g.ldb + C) * 2u; }
    const size_t kstep = (size_t)(BK * 2);
    const size_t hstepA = (size_t)HALF * g.lda * 2, hstepB = (size_t)8 * g.ldb * 2;
    const size_t tstepA = 2 * hstepA, tstepB = (size_t)BM * g.ldb * 2;
    const size_t pnoffA = (size_t)g.a_pn_koff * 2;
    const unsigned ldsw = (unsigned)wid * 1024u;
    const int aoff = lds_byte(wr * 64 + fr, fq * 8), boff = lds_byte(wc * 32 + fr, fq * 8);
#define PG8_SA(b, h) (((b) * 2 + (h)) * HTB)
#define PG8_SB(b, h) ((4 + (b) * 2 + (h)) * HTB)
#define PG8_STAGE(bufoff, gbase, voff) do { _Pragma("unroll") for (int _i = 0; _i < 2; ++_i) \
        __builtin_amdgcn_global_load_lds((const unsigned*)((const char*)(gbase) + (voff)[_i]), (LAS unsigned*)(lds + (bufoff) + ldsw + _i * 8192), 16, 0, 0); } while (0)
#define PG8_LDA(dst, b, h) do { _Pragma("unroll") for (int m = 0; m < 4; ++m) _Pragma("unroll") for (int k = 0; k < 2; ++k) dst[m][k] = *(const LAS bf16x8*)(lds + PG8_SA(b, h) + aoff + m * 2048 + k * 1024); } while (0)
#define PG8_LDB(dst, b, h) do { _Pragma("unroll") for (int n = 0; n < 2; ++n) _Pragma("unroll") for (int k = 0; k < 2; ++k) dst[n][k] = *(const LAS bf16x8*)(lds + PG8_SB(b, h) + boff + n * 2048 + k * 1024); } while (0)
#define PG8_MMA(ai, bj, At, Bt) do { __builtin_amdgcn_s_setprio(1); _Pragma("unroll") for (int m = 0; m < 4; ++m) _Pragma("unroll") for (int n = 0; n < 2; ++n) _Pragma("unroll") for (int k = 0; k < 2; ++k) \
        acc[ai][bj][m][n] = __builtin_amdgcn_mfma_f32_16x16x32_bf16(Bt[n][k], At[m][k], acc[ai][bj][m][n], 0, 0, 0); __builtin_amdgcn_s_setprio(0); } while (0)
#define PG8_WAIT_V(n) asm volatile("s_waitcnt vmcnt(" #n ")" ::: "memory")
#define PG8_WAIT_L(n) asm volatile("s_waitcnt lgkmcnt(" #n ")" ::: "memory")
#define PG8_BAR __builtin_amdgcn_s_barrier()
#define PG8_SCHED __builtin_amdgcn_sched_barrier(0)
    Unit cur, nxt; int ui = 0;
    if (!S.next(0, cur)) return;
    f32x4 acc[2][2][4][2];
#pragma unroll
    for (int a = 0; a < 2; ++a)
#pragma unroll
        for (int b = 0; b < 2; ++b)
#pragma unroll
            for (int m = 0; m < 4; ++m)
#pragma unroll
                for (int n = 0; n < 2; ++n) acc[a][b][m][n] = zero4_b64();
    bf16x8 At[4][2], B0[2][2], B1[2][2];
    const char* cA = (const char*)g.A + (size_t)cur.pm * tstepA + (size_t)cur.pn * pnoffA; const char* cB = (const char*)g.Bt + (size_t)cur.pn * tstepB;
    PG8_STAGE(PG8_SB(0, 0), cB, voffB); PG8_STAGE(PG8_SA(0, 0), cA, voffA); PG8_STAGE(PG8_SB(0, 1), cB + hstepB, voffB); PG8_STAGE(PG8_SA(0, 1), cA + hstepA, voffA);
    if (wr == 1) PG8_BAR;
    PG8_WAIT_V(4); PG8_BAR;
    PG8_STAGE(PG8_SB(1, 0), cB + kstep, voffB); PG8_STAGE(PG8_SA(1, 0), cA + kstep, voffA); PG8_STAGE(PG8_SB(1, 1), cB + hstepB + kstep, voffB);
    PG8_WAIT_V(6); PG8_BAR;
    for (;;) {
        const bool has_next = S.next(ui + 1, nxt);
        const char* nA = has_next ? (const char*)g.A + (size_t)nxt.pm * tstepA + (size_t)nxt.pn * pnoffA : cA; const char* nB = has_next ? (const char*)g.Bt + (size_t)nxt.pn * tstepB : cB;
        for (int t = 0; t < nt; t += 2) {
            const bool last = (t == nt - 2);
            const char* a1 = cA + (size_t)(t + 1) * kstep;
            const char* a2 = last ? nA : cA + (size_t)(t + 2) * kstep; const char* b2 = last ? nB : cB + (size_t)(t + 2) * kstep;
            const char* a3 = a2 + kstep; const char* b3 = b2 + kstep;
            PG8_LDB(B0, 0, 0); PG8_SCHED; PG8_LDA(At, 0, 0); PG8_STAGE(PG8_SA(1, 1), a1 + hstepA, voffA);
            PG8_WAIT_L(8); PG8_BAR; PG8_WAIT_L(0); PG8_MMA(0, 0, At, B0); PG8_BAR; PG8_SCHED;
            PG8_LDB(B1, 0, 1); PG8_STAGE(PG8_SB(0, 0), b2, voffB);
            PG8_BAR; PG8_WAIT_L(0); PG8_MMA(0, 1, At, B1); PG8_BAR;
            PG8_LDA(At, 0, 1); PG8_STAGE(PG8_SA(0, 0), a2, voffA);
            PG8_BAR; PG8_WAIT_L(0); PG8_MMA(1, 0, At, B0); PG8_BAR; PG8_SCHED;
            PG8_STAGE(PG8_SB(0, 1), b2 + hstepB, voffB);
            PG8_WAIT_V(6); PG8_BAR; PG8_MMA(1, 1, At, B1); PG8_BAR;
            PG8_LDB(B0, 1, 0); PG8_SCHED; PG8_LDA(At, 1, 0); PG8_STAGE(PG8_SA(0, 1), a2 + hstepA, voffA);
            PG8_WAIT_L(8); PG8_BAR; PG8_WAIT_L(0); PG8_MMA(0, 0, At, B0); PG8_BAR; PG8_SCHED;
            PG8_LDB(B1, 1, 1); PG8_STAGE(PG8_SB(1, 0), b3, voffB);
            PG8_BAR; PG8_WAIT_L(0); PG8_MMA(0, 1, At, B1); PG8_BAR;
            PG8_LDA(At, 1, 1); PG8_STAGE(PG8_SA(1, 0), a3, voffA);
            PG8_BAR; PG8_WAIT_L(0); PG8_MMA(1, 0, At, B0); PG8_BAR; PG8_SCHED;
            PG8_STAGE(PG8_SB(1, 1), b3 + hstepB, voffB);
            PG8_WAIT_V(6); PG8_BAR; PG8_MMA(1, 1, At, B1); PG8_BAR;
        }
        E(acc, cur, wr, wc, fr, fq);
        if (!has_next) break;
#pragma unroll
        for (int a = 0; a < 2; ++a)
#pragma unroll
            for (int b = 0; b < 2; ++b)
#pragma unroll
                for (int m = 0; m < 4; ++m)
#pragma unroll
                    for (int n = 0; n < 2; ++n) acc[a][b][m][n] = zero4_b64();
        cur = nxt; cA = nA; cB = nB; ++ui;
    }
    PG8_WAIT_V(0);
    if (wr == 0) PG8_BAR;
    PG8_BAR;
#undef PG8_SA
#undef PG8_SB
#undef PG8_STAGE
#undef PG8_LDA
#undef PG8_LDB
#undef PG8_MMA
#undef PG8_WAIT_V
#undef PG8_WAIT_L
#undef PG8_BAR
#undef PG8_SCHED
}
}

__device__ __forceinline__ void store_bf4(bf16_t* p, f32x4 v) { u32x2 w; w.x = cvt_pk_bf16(v[0], v[1]); w.y = cvt_pk_bf16(v[2], v[3]); *(u32x2*)p = w; }
__device__ __forceinline__ u32x4 pack_bf8(f32x4 a, f32x4 b) { u32x4 w; w.x = cvt_pk_bf16(a[0], a[1]); w.y = cvt_pk_bf16(a[2], a[3]); w.z = cvt_pk_bf16(b[0], b[1]); w.w = cvt_pk_bf16(b[2], b[3]); return w; }
__device__ __forceinline__ void wave_store_lines(LAS unsigned char* wbuf, bf16_t* g0, size_t ld, u32x4 w0, u32x4 w1, int lane) {
    const int fr = lane & 15, fq = lane >> 4;
    *(LAS u32x4*)(wbuf + fr * 144 + fq * 32) = w0; *(LAS u32x4*)(wbuf + fr * 144 + fq * 32 + 16) = w1;
    asm volatile("s_waitcnt lgkmcnt(0)" ::: "memory");
#pragma unroll
    for (int i = 0; i < 2; ++i) { const int row = 8 * i + (lane >> 3); const u32x4 t = *(const LAS u32x4*)(wbuf + row * 144 + (lane & 7) * 16); *(u32x4*)(g0 + (size_t)row * ld + (lane & 7) * 8) = t; }
    asm volatile("" ::: "memory");
}
__device__ __forceinline__ void wave_load_lines(LAS unsigned char* wbuf, const bf16_t* g0, size_t ld, u32x4& w0, u32x4& w1, int lane) {
    const int fr = lane & 15, fq = lane >> 4;
    u32x4 t[2];
#pragma unroll
    for (int i = 0; i < 2; ++i) t[i] = *(const u32x4*)(g0 + (size_t)(8 * i + (lane >> 3)) * ld + (lane & 7) * 8);
#pragma unroll
    for (int i = 0; i < 2; ++i) *(LAS u32x4*)(wbuf + (8 * i + (lane >> 3)) * 144 + (lane & 7) * 16) = t[i];
    asm volatile("s_waitcnt lgkmcnt(0)" ::: "memory");
    w0 = *(const LAS u32x4*)(wbuf + fr * 144 + fq * 32); w1 = *(const LAS u32x4*)(wbuf + fr * 144 + fq * 32 + 16);
    asm volatile("s_waitcnt lgkmcnt(0)" ::: "memory");
}
__device__ __forceinline__ void wave_store_lines_u(LAS unsigned char* wl, LAS unsigned char* rl, char* gbase, unsigned off0, unsigned off1, u32x4 w0, u32x4 w1) {
    *(LAS u32x4*)(wl) = w0; *(LAS u32x4*)(wl + 16) = w1;
    asm volatile("" ::: "memory");
    const u32x4 t0 = *(const LAS u32x4*)(rl), t1 = *(const LAS u32x4*)(rl + 8 * 144);
    asm volatile("" ::: "memory");
    {
        const __amdgpu_buffer_rsrc_t rs = __builtin_amdgcn_make_buffer_rsrc((void*)gbase, 0, 0x7fffffff, 0x00020000);
        __builtin_amdgcn_raw_buffer_store_b128(t0, rs, off0, 0, 16);
        __builtin_amdgcn_raw_buffer_store_b128(t1, rs, off1, 0, 16);
    }
}
__device__ __forceinline__ float unit_rs(LAS unsigned char* lds, const float* ssq, int pm0, int pm, int lr) {
    return *(const LAS float*)(lds + pg8::RS_TAB_OFF + lr * 4);
}
__device__ __forceinline__ void fill_rs_table(LAS unsigned char* lds, const float* ssq, int pm0) {
    const int t = opaque_tid();
    if (t < 256) *(LAS float*)(lds + pg8::RS_TAB_OFF + t * 4) = row_rs16(ssq, pm0 * 256 + t);
    __syncthreads();
}

struct EpiE1 {
    const float* ssq; bf16_t* U; float* vssq; LAS unsigned char* lds; int pm0;
    __device__ __forceinline__ void operator()(const f32x4 (&acc)[2][2][4][2], const pg8::Unit& u, int wr, int wc, int fr_, int fq_) const {
        int lane_o = fq_ * 16 + fr_; asm volatile("" : "+v"(lane_o));
        const int fr = lane_o & 15, fq = lane_o >> 4;
        const int sec = u.pn >> 1, lane = lane_o;
        bf16_t* dst = U + (size_t)sec * ((size_t)MPAD * 512) + (u.pn & 1) * 256 + wc * 64;
        LAS unsigned char* wbuf = lds + pg8::WT_OFF + (wr * 4 + wc) * pg8::WT_BYTES;
        LAS unsigned char* wl = wbuf + fr * 144 + fq * 32; LAS unsigned char* rl = wbuf + (lane >> 3) * 144 + (lane & 7) * 16;
        const unsigned off0 = (unsigned)(lane >> 3) * (512 * 2) + (lane & 7) * 16, off1 = off0 + 8u * (512 * 2);
#pragma unroll
        for (int ai = 0; ai < 2; ++ai) {
#pragma unroll
            for (int m = 0; m < 4; ++m) {
                const int lr = ai * 128 + wr * 64 + m * 16 + fr, row = u.pm * 256 + lr;
                const float rs = unit_rs(lds, ssq, pm0, u.pm, lr);
                float sq = 0.f;
                u32x4 w[2];
#pragma unroll
                for (int bj = 0; bj < 2; ++bj) {
                    f32x4 v0 = acc[ai][bj][m][0] * rs, v1 = acc[ai][bj][m][1] * rs;
                    if (sec != 3) {
                        const f32x2 g0 = gelu_t2((f32x2){v0[0], v0[1]}), g1 = gelu_t2((f32x2){v0[2], v0[3]}), g2 = gelu_t2((f32x2){v1[0], v1[1]}), g3 = gelu_t2((f32x2){v1[2], v1[3]});
                        v0 = (f32x4){g0.x, g0.y, g1.x, g1.y}; v1 = (f32x4){g2.x, g2.y, g3.x, g3.y};
                    }
                    sq += v0[0] * v0[0] + v0[1] * v0[1] + v0[2] * v0[2] + v0[3] * v0[3] + v1[0] * v1[0] + v1[1] * v1[1] + v1[2] * v1[2] + v1[3] * v1[3];
                    w[bj] = pack_bf8(v0, v1);
                }
                wave_store_lines_u(wl, rl, (char*)(dst + (size_t)(u.pm * 256 + ai * 128 + wr * 64 + m * 16) * 512), off0, off1, w[0], w[1]);
                if (sec == 1) {
                    sq += __shfl_xor(sq, 16); sq += __shfl_xor(sq, 32);
                    if (fq == 0) vssq[(size_t)row * 8 + (u.pn & 1) * 4 + wc] = sq;
                }
            }
        }
    }
};

struct EpiF1 {
    const float* ssq; bf16_t* H; LAS unsigned char* lds; int pm0;
    __device__ __forceinline__ void operator()(const f32x4 (&acc)[2][2][4][2], const pg8::Unit& u, int wr, int wc, int fr_, int fq_) const {
        int lane_o = fq_ * 16 + fr_; asm volatile("" : "+v"(lane_o));
        const int fr = lane_o & 15, fq = lane_o >> 4;
        const int lane = lane_o;
        bf16_t* dst = H + u.pn * 256 + wc * 64;
        LAS unsigned char* wbuf = lds + pg8::WT_OFF + (wr * 4 + wc) * pg8::WT_BYTES;
        LAS unsigned char* wl = wbuf + fr * 144 + fq * 32; LAS unsigned char* rl = wbuf + (lane >> 3) * 144 + (lane & 7) * 16;
        const unsigned off0 = (unsigned)(lane >> 3) * (DFF * 2) + (lane & 7) * 16, off1 = off0 + 8u * (DFF * 2);
#pragma unroll
        for (int ai = 0; ai < 2; ++ai) {
#pragma unroll
            for (int m = 0; m < 4; ++m) {
                const int lr = ai * 128 + wr * 64 + m * 16 + fr;
                const float rs = unit_rs(lds, ssq, pm0, u.pm, lr);
                u32x4 w[2];
#pragma unroll
                for (int bj = 0; bj < 2; ++bj) {
                    f32x4 v0 = acc[ai][bj][m][0] * rs, v1 = acc[ai][bj][m][1] * rs;
#pragma unroll
                    for (int j = 0; j < 4; ++j) { v0[j] = fmaxf(v0[j], 0.f); v1[j] = fmaxf(v1[j], 0.f); }
                    v0 = v0 * v0; v1 = v1 * v1;
                    w[bj] = pack_bf8(v0, v1);
                }
                wave_store_lines_u(wl, rl, (char*)(dst + (size_t)(u.pm * 256 + ai * 128 + wr * 64 + m * 16) * DFF), off0, off1, w[0], w[1]);
            }
        }
    }
};

struct EpiRes {
    bf16_t* X; float* ssq; const float* bias; const float* cscale; LAS unsigned char* lds; bf16_t* halo;
    __device__ __forceinline__ void operator()(const f32x4 (&acc)[2][2][4][2], const pg8::Unit& u, int wr, int wc, int fr_, int fq_) const {
        int lane_o = fq_ * 16 + fr_; asm volatile("" : "+v"(lane_o));
        const int fr = lane_o & 15, fq = lane_o >> 4;
        const int lane = lane_o;
        const int colw = u.pn * 256 + wc * 64;
        LAS unsigned char* wbuf = lds + pg8::WT_OFF + (wr * 4 + wc) * pg8::WT_BYTES;
        LAS unsigned char* wl = wbuf + fr * 144 + fq * 32; LAS unsigned char* rl = wbuf + (lane >> 3) * 144 + (lane & 7) * 16;
        const unsigned off0 = (unsigned)(lane >> 3) * (DM * 2) + (lane & 7) * 16, off1 = off0 + 8u * (DM * 2);
        f32x4 bv[2][2], cv[2][2];
#pragma unroll
        for (int bj = 0; bj < 2; ++bj)
#pragma unroll
            for (int hh = 0; hh < 2; ++hh) {
                const int col = colw + 16 * fq + 8 * bj + 4 * hh;
                bv[bj][hh] = bias ? *(const f32x4*)(bias + col) : (f32x4){0.f, 0.f, 0.f, 0.f};
                cv[bj][hh] = bias ? *(const f32x4*)(cscale + col) : (f32x4){1.f, 1.f, 1.f, 1.f};
            }
#pragma unroll
        for (int ai = 0; ai < 2; ++ai) {
            u32x4 t[4][2];
#pragma unroll
            for (int m = 0; m < 4; ++m) {
                const char* xg0 = (const char*)(X + (size_t)(u.pm * 256 + ai * 128 + wr * 64 + m * 16) * DM + colw);
                t[m][0] = *(const u32x4*)(xg0 + off0); t[m][1] = *(const u32x4*)(xg0 + off1);
            }
#pragma unroll
            for (int m = 0; m < 4; ++m) {
                const int row = u.pm * 256 + ai * 128 + wr * 64 + m * 16 + fr;
                char* xg0 = (char*)(X + (size_t)(u.pm * 256 + ai * 128 + wr * 64 + m * 16) * DM + colw);
                u32x4 xw[2];
                *(LAS u32x4*)(rl) = t[m][0]; *(LAS u32x4*)(rl + 8 * 144) = t[m][1];
                asm volatile("" ::: "memory");
                xw[0] = *(const LAS u32x4*)(wl); xw[1] = *(const LAS u32x4*)(wl + 16);
                asm volatile("" ::: "memory");
                float sq = 0.f;
                u32x4 w[2];
#pragma unroll
                for (int bj = 0; bj < 2; ++bj) {
                    const int col = colw + 16 * fq + 8 * bj;
                    f32x4 v0 = acc[ai][bj][m][0], v1 = acc[ai][bj][m][1];
                    if (bias) { v0 = (v0 + bv[bj][0]) * cv[bj][0]; v1 = (v1 + bv[bj][1]) * cv[bj][1]; }
                    f32x4 x0, x1; bf8_to_f32(xw[bj], x0, x1);
                    v0 = v0 + x0; v1 = v1 + x1;
                    sq += v0[0] * v0[0] + v0[1] * v0[1] + v0[2] * v0[2] + v0[3] * v0[3] + v1[0] * v1[0] + v1[1] * v1[1] + v1[2] * v1[2] + v1[3] * v1[3];
                    w[bj] = pack_bf8(v0, v1);
                }
                wave_store_lines_u(wl, rl, xg0, off0, off1, w[0], w[1]);
                if (halo && ai == 1 && m == 3 && wr == 1) wave_store_lines_u(wl, rl, (char*)(halo + (size_t)(u.pm * 16) * DM + colw), off0, off1, w[0], w[1]);
                sq += __shfl_xor(sq, 16); sq += __shfl_xor(sq, 32);
                if (fq == 0) ssq[(size_t)row * 16 + u.pn * 4 + wc] = sq;
            }
        }
    }
};

template <int KSPLIT, int STEPS, class Epi>
__device__ __forceinline__ void skinny_gemm(LAS unsigned char* lds, const bf16_t* A, int lda, int a_grp_koff, const bf16_t* Bt, int ldb, int N, int K, const Epi& E, int G) {
    const int tid = opaque_tid(), wave = tid >> 6, lane = tid & 63, fr = lane & 15, fq = lane >> 4;
    const int ntile = 8 * (N >> 4);
    constexpr int TPB = 8 / KSPLIT;
    const int klen = K / KSPLIT;
    for (int t0 = blockIdx.x * TPB; t0 < ntile; t0 += G * TPB) {
        const int tile = t0 + wave / KSPLIT, ks = wave % KSPLIT;
        const int rt = tile & 7, ct = tile >> 3;
        const bf16_t* ap = A + (size_t)(rt * 16 + fr) * lda + (ct >> 4) * a_grp_koff + ks * klen + fq * 8;
        const bf16_t* bp = Bt + (size_t)(ct * 16 + fr) * ldb + ks * klen + fq * 8;
        f32x2 pp = (f32x2){0.f, 0.f};
        if (ks == 0) pp = E.pre(rt * 16 + fr, ct * 16 + fq * 4, fq);
        f32x4 acc = (f32x4){0.f, 0.f, 0.f, 0.f};
        const int krot = (int)(((unsigned)(wave * 5 + (int)blockIdx.x * 3) * 32u) % (unsigned)klen);
        for (int k = 0; k < klen; k += STEPS * 32) {
            bf16x8 a[STEPS], b[STEPS];
#pragma unroll
            for (int j = 0; j < STEPS; ++j) { int kk = k + j * 32 + krot; kk = kk >= klen ? kk - klen : kk; a[j] = *(const bf16x8*)(ap + kk); b[j] = *(const bf16x8*)(bp + kk); }
#pragma unroll
            for (int j = 0; j < STEPS; ++j) acc = __builtin_amdgcn_mfma_f32_16x16x32_bf16(b[j], a[j], acc, 0, 0, 0);
        }
        if (KSPLIT > 1) {
            *(LAS f32x4*)(lds + (wave * 64 + lane) * 16) = acc;
            __syncthreads();
            if (ks == 0) {
#pragma unroll
                for (int j = 1; j < KSPLIT; ++j) acc = acc + *(const LAS f32x4*)(lds + ((wave + j) * 64 + lane) * 16);
                E(rt * 16 + fr, ct * 16 + fq * 4, ct, fq, acc, pp);
            }
            __syncthreads();
        } else {
            E(rt * 16 + fr, ct * 16 + fq * 4, ct, fq, acc, pp);
        }
    }
}

template <class Epi>
__device__ __forceinline__ void skinny_gemm_k1024(LAS unsigned char* lds, const bf16_t* A, int lda, const bf16_t* Bt, int ldb, int N, const Epi& E, int G) {
    const int tid = opaque_tid(), wave = tid >> 6, lane = tid & 63, fr = lane & 15, fq = lane >> 4;
    const int nct = N >> 4;
    for (int ct = blockIdx.x; ct < nct; ct += G) {
        const bf16_t* ap = A + (size_t)(wave * 16 + fr) * lda + fq * 8;
        const bf16_t* bp = Bt + (size_t)(ct * 16 + fr) * ldb + (4 * wave) * 32 + fq * 8;
        const f32x2 pp = E.pre(wave * 16 + fr, ct * 16 + fq * 4, fq);
        bf16x8 a[32], bl[4];
#pragma unroll
        for (int q = 0; q < 4; ++q) bl[q] = *(const bf16x8*)(bp + q * 32);
#pragma unroll
        for (int j = 0; j < 32; ++j) a[j] = *(const bf16x8*)(ap + j * 32);
#pragma unroll
        for (int q = 0; q < 4; ++q) *(LAS bf16x8*)(lds + ((4 * wave + q) * 64 + lane) * 16) = bl[q];
        __syncthreads();
        f32x4 acc0 = (f32x4){0.f, 0.f, 0.f, 0.f}, acc1 = acc0;
#pragma unroll
        for (int j = 0; j < 32; j += 2) {
            const bf16x8 b0 = *(const LAS bf16x8*)(lds + (j * 64 + lane) * 16), b1 = *(const LAS bf16x8*)(lds + ((j + 1) * 64 + lane) * 16);
            acc0 = __builtin_amdgcn_mfma_f32_16x16x32_bf16(b0, a[j], acc0, 0, 0, 0);
            acc1 = __builtin_amdgcn_mfma_f32_16x16x32_bf16(b1, a[j + 1], acc1, 0, 0, 0);
        }
        E(wave * 16 + fr, ct * 16 + fq * 4, ct, fq, acc0 + acc1, pp);
        __syncthreads();
    }
}

template <class Epi>
__device__ __forceinline__ void skinny_gemm_k4096(LAS unsigned char* lds, const bf16_t* A, int lda, const bf16_t* Bt, int ldb, int N, const Epi& E, int G) {
    const int tid = opaque_tid(), wave = tid >> 6, lane = tid & 63, fr = lane & 15, fq = lane >> 4;
    const int npair = 4 * (N >> 4);
    for (int pr = blockIdx.x; pr < npair; pr += G) {
        const int ct = pr >> 2, rt0 = (pr & 3) * 2;
        const bf16_t* ap0 = A + (size_t)(rt0 * 16 + fr) * lda + wave * 512 + fq * 8;
        const bf16_t* ap1 = ap0 + (size_t)16 * lda;
        const bf16_t* bp = Bt + (size_t)(ct * 16 + fr) * ldb + wave * 512 + fq * 8;
        f32x2 pp = (f32x2){0.f, 0.f};
        if (wave < 2) pp = E.pre((rt0 + wave) * 16 + fr, ct * 16 + fq * 4, fq);
        bf16x8 b[16], a0[16], a1[16];
#pragma unroll
        for (int j = 0; j < 16; ++j) { b[j] = *(const bf16x8*)(bp + j * 32); a0[j] = *(const bf16x8*)(ap0 + j * 32); a1[j] = *(const bf16x8*)(ap1 + j * 32); }
        f32x4 acc0 = (f32x4){0.f, 0.f, 0.f, 0.f}, acc1 = acc0;
#pragma unroll
        for (int j = 0; j < 16; ++j) {
            acc0 = __builtin_amdgcn_mfma_f32_16x16x32_bf16(b[j], a0[j], acc0, 0, 0, 0);
            acc1 = __builtin_amdgcn_mfma_f32_16x16x32_bf16(b[j], a1[j], acc1, 0, 0, 0);
        }
        *(LAS f32x4*)(lds + ((wave * 2 + 0) * 64 + lane) * 16) = acc0;
        *(LAS f32x4*)(lds + ((wave * 2 + 1) * 64 + lane) * 16) = acc1;
        __syncthreads();
        if (wave < 2) {
            f32x4 acc = *(const LAS f32x4*)(lds + ((0 * 2 + wave) * 64 + lane) * 16);
#pragma unroll
            for (int j = 1; j < 8; ++j) acc = acc + *(const LAS f32x4*)(lds + ((j * 2 + wave) * 64 + lane) * 16);
            E((rt0 + wave) * 16 + fr, ct * 16 + fq * 4, ct, fq, acc, pp);
        }
        __syncthreads();
    }
}

__device__ __forceinline__ f32x2 ssqs_part(const float* ssqs, int r, int fq) {
    const f32x4* q = (const f32x4*)(ssqs + (size_t)r * 64 + fq * 16);
    const f32x4 a = q[0], b = q[1], c = q[2], d = q[3];
    f32x2 o; o.x = (a[0] + a[1] + a[2] + a[3]) + (b[0] + b[1] + b[2] + b[3]); o.y = (c[0] + c[1] + c[2] + c[3]) + (d[0] + d[1] + d[2] + d[3]); return o;
}
__device__ __forceinline__ float ssqs_finish(f32x2 pp) {
    float s = pp.x + pp.y; s += __shfl_xor(s, 16); s += __shfl_xor(s, 32);
    return __builtin_amdgcn_rsqf(s * (1.0f / 1024.0f) + EPS);
}
struct SkE1 {
    const float* ssqs; bf16_t* U; float* vssqs;
    __device__ __forceinline__ f32x2 pre(int r, int col, int fq) const { return ssqs_part(ssqs, r, fq); }
    __device__ __forceinline__ void operator()(int r, int col, int ct, int fq, f32x4 v, f32x2 pp) const {
        const float rs = ssqs_finish(pp);
        const int sec = col >> 9, cc = col & 511;
        v = v * rs;
        if (sec != 3) { v[0] = gelu_t(v[0]); v[1] = gelu_t(v[1]); v[2] = gelu_t(v[2]); v[3] = gelu_t(v[3]); }
        store_bf4(U + (size_t)sec * ((size_t)MPAD * 512) + (size_t)(MP + r) * 512 + cc, v);
        float sq = v[0] * v[0] + v[1] * v[1] + v[2] * v[2] + v[3] * v[3];
        sq += __shfl_xor(sq, 16); sq += __shfl_xor(sq, 32);
        if (sec == 1 && fq == 0) vssqs[r * 32 + (cc >> 4)] = sq;
    }
};
struct SkF1 {
    const float* ssqs; bf16_t* H;
    __device__ __forceinline__ f32x2 pre(int r, int col, int fq) const { return ssqs_part(ssqs, r, fq); }
    __device__ __forceinline__ void operator()(int r, int col, int ct, int fq, f32x4 v, f32x2 pp) const {
        const float rs = ssqs_finish(pp);
        v = v * rs;
#pragma unroll
        for (int j = 0; j < 4; ++j) { const float q = fmaxf(v[j], 0.f); v[j] = q * q; }
        store_bf4(H + (size_t)(MP + r) * DFF + col, v);
    }
};
struct SkRes {
    const bf16_t* Xi; bf16_t* Xo; float* ssqs; const float* bias; const float* cscale;
    __device__ __forceinline__ f32x2 pre(int r, int col, int fq) const { const u32x2 xw = *(const u32x2*)(Xi + (size_t)r * DM + col); f32x2 o; o.x = __uint_as_float(xw.x); o.y = __uint_as_float(xw.y); return o; }
    __device__ __forceinline__ void operator()(int r, int col, int ct, int fq, f32x4 v, f32x2 pp) const {
        if (bias) v = (v + *(const f32x4*)(bias + col)) * *(const f32x4*)(cscale + col);
        bf16_t* xr = Xo + (size_t)r * DM + col;
        { const unsigned x0 = __float_as_uint(pp.x), x1 = __float_as_uint(pp.y); v[0] += bflo(x0); v[1] += bfhi(x0); v[2] += bflo(x1); v[3] += bfhi(x1); }
        store_bf4(xr, v);
        float sq = v[0] * v[0] + v[1] * v[1] + v[2] * v[2] + v[3] * v[3];
        sq += __shfl_xor(sq, 16); sq += __shfl_xor(sq, 32);
        if (fq == 0) ssqs[r * 64 + ct] = sq;
    }
};

__device__ void transpose_cvt(const float* __restrict__ src, bf16_t* __restrict__ dst, int K, int N, LAS float* sT, int G, int blk) {
    const int tid = opaque_tid();
    const int tk = K / 64, tn = N / 64, ntile = tk * tn;
    for (int t = blk; t < ntile; t += G) {
        const int k0 = (t / tn) * 64, n0 = (t % tn) * 64;
#pragma unroll
        for (int i = 0; i < 2; ++i) {
            const int k = (tid >> 4) + 32 * i, n4 = (tid & 15) * 4;
            const f32x4 v = *(const f32x4*)(src + (size_t)(k0 + k) * N + n0 + n4);
            sT[k * 65 + n4 + 0] = v[0]; sT[k * 65 + n4 + 1] = v[1]; sT[k * 65 + n4 + 2] = v[2]; sT[k * 65 + n4 + 3] = v[3];
        }
        __syncthreads();
        {
            const int n = tid >> 3, kk = (tid & 7) * 8;
            float f[8];
#pragma unroll
            for (int j = 0; j < 8; ++j) f[j] = sT[(kk + j) * 65 + n];
            u32x4 w; w.x = cvt_pk_bf16(f[0], f[1]); w.y = cvt_pk_bf16(f[2], f[3]); w.z = cvt_pk_bf16(f[4], f[5]); w.w = cvt_pk_bf16(f[6], f[7]);
            *(u32x4*)(dst + (size_t)(n0 + n) * K + k0 + kk) = w;
        }
        __syncthreads();
    }
}
__device__ void transpose_cvt_wide(const float* __restrict__ src, bf16_t* __restrict__ dst, int K, int N, int nmat, LAS float* sT, int G, int rot, const float* gk, int gstride) {
    const int tid = opaque_tid();
    const int tk = K / 64, tn = N / 256, per = tk * tn, ntile = per * nmat;
    int blk = (int)blockIdx.x + rot; if (blk >= G) blk -= G;
    for (int t = blk; t < ntile; t += G) {
        const int mat = t / per, tt = t - mat * per;
        const int k0 = (tt / tn) * 64, n0 = (tt % tn) * 256;
        const float* sp = src + (size_t)mat * K * N; bf16_t* dp = dst + (size_t)mat * K * N;
        f32x4 v[8];
#pragma unroll
        for (int i = 0; i < 8; ++i) v[i] = *(const f32x4*)(sp + (size_t)(k0 + (tid >> 6) + 8 * i) * N + n0 + (tid & 63) * 4);
        if (gk) {
#pragma unroll
            for (int i = 0; i < 8; ++i) v[i] = v[i] * gk[(size_t)mat * gstride + k0 + (tid >> 6) + 8 * i];
        }
#pragma unroll
        for (int i = 0; i < 8; ++i) {
            const int k = (tid >> 6) + 8 * i, n4 = (tid & 63) * 4;
            sT[k * 257 + n4 + 0] = v[i][0]; sT[k * 257 + n4 + 1] = v[i][1]; sT[k * 257 + n4 + 2] = v[i][2]; sT[k * 257 + n4 + 3] = v[i][3];
        }
        __syncthreads();
        {
            const int piece = tid & 7;
#pragma unroll
            for (int i = 0; i < 4; ++i) {
                const int n = (tid >> 3) + 64 * i;
                float f[8];
#pragma unroll
                for (int j = 0; j < 8; ++j) f[j] = sT[(piece * 8 + j) * 257 + n];
                u32x4 w; w.x = cvt_pk_bf16(f[0], f[1]); w.y = cvt_pk_bf16(f[2], f[3]); w.z = cvt_pk_bf16(f[4], f[5]); w.w = cvt_pk_bf16(f[6], f[7]);
                st_wt16(dp, (unsigned)(((n0 + n) * K + k0 + piece * 8) * 2), w);
            }
        }
        __syncthreads();
    }
}

__device__ void gap0_extras(const Params& p, LAS unsigned char* lds, int G) {
    LAS float* sT = (LAS float*)lds;
    unsigned char* ws = p.ws;
    transpose_cvt_wide(p.pool_w, (bf16_t*)(ws + WS_WP), 256, 256, 8, sT, G, 128, nullptr, 0);
    for (int m = (int)blockIdx.x - 192; m >= 0 && m < 32; m += G) {
        const int eh = m >> 1, gate = m & 1, e = eh >> 3, h = eh & 7;
        transpose_cvt((gate ? p.gate_x_w : p.gate_a_w) + (size_t)eh * 4096, (bf16_t*)(ws + WS_GW) + (size_t)((e * 2 + gate) * 8 + h) * 4096, 64, 64, sT, 1 << 30, 0);
    }
    const int tid0 = opaque_tid();
    const int gtid = blockIdx.x * NTHR + tid0, gthr = G * NTHR;
    {
        bf16_t* SW = (bf16_t*)(ws + WS_SW);
        for (int i = gtid; i < 2 * 8 * 128 * 128; i += gthr) { const int s = i & 127, t = (i >> 7) & 127; SW[i] = (s <= t) ? f2bf(p.sgu_w[i]) : (bf16_t)0; }
        float* SP = (float*)(ws + WS_SP);
        for (int i = gtid; i < 1024; i += gthr) { const float z = -p.lru_lambda[i]; SP[i] = fmaxf(z, 0.f) + log1pf(expf(-fabsf(z))); }
    }
    {
        u32x4* cgz = (u32x4*)(ws + WS_CG);
        const u32x4 z = (u32x4){0u, 0u, 0u, 0u};
        for (int i = gtid; i < (int)((size_t)2 * 1024 * 128 * 8 / 16); i += gthr) cgz[i] = z;
    }
}

__device__ void phase_prep(const Params& p, LAS unsigned char* lds, int G) {
    LAS float* sT = (LAS float*)lds;
    unsigned char* ws = p.ws;
    transpose_cvt_wide(p.w_in, (bf16_t*)(ws + WS_WIN), DM, DIN, 1, sT, G, 0, p.norm_mix, 2 * DM);
    const int tid0 = opaque_tid();
    {
        const int wave = tid0 >> 6, lane = tid0 & 63;
        bf16_t* XG = (bf16_t*)(ws + WS_XG); float* SSQ = (float*)(ws + WS_SSQ); float* SSQS = (float*)(ws + WS_SSQS);
        for (int row = blockIdx.x * 8 + wave; row < MR; row += G * 8) {
            float sq = 0.f;
            const float* xr = row < MP ? p.x_prompt + (size_t)row * DM : p.x_sample + (size_t)(row - MP) * DM;
#pragma unroll
            for (int q = 0; q < 4; ++q) {
                const int col = q * 256 + lane * 4;
                const f32x4 v = *(const f32x4*)(xr + col);
                sq += v[0] * v[0] + v[1] * v[1] + v[2] * v[2] + v[3] * v[3];
                { u32x2 w2; w2.x = cvt_pk_bf16(v[0], v[1]); w2.y = cvt_pk_bf16(v[2], v[3]); st_wt8(XG, (unsigned)((row * DM + col) * 2), w2); }
            }
#pragma unroll
            for (int o = 1; o < 64; o <<= 1) sq += __shfl_xor(sq, o);
            if (row < MP) { if (lane < 16) SSQ[(size_t)row * 16 + lane] = (lane == 0) ? sq : 0.f; }
            else SSQS[(size_t)(row - MP) * 64 + lane] = (lane == 0) ? sq : 0.f;
        }
    }
}

__device__ void sample_pool_pre(const Params& p, int G);
__device__ void gap_convert(const Params& p, int g, LAS unsigned char* lds, int G) {
    if (g > 9) return;
    unsigned char* ws = p.ws;
    const float* src; bf16_t* dst; int K, N, nmat = 1; const float* gk = nullptr;
    const int l = (g - 1) >> 1;
    if (g == 0) { src = p.w_out; dst = (bf16_t*)(ws + WS_WOUT); K = DM; N = DM; nmat = 2; }
    else if (g == 5) { src = p.w_in + (size_t)DM * DIN; dst = (bf16_t*)(ws + WS_WIN) + (size_t)DIN * DM; K = DM; N = DIN; gk = p.norm_mix + 2 * DM; }
    else {
        const int gg = g < 5 ? g - 1 : g - 2;
        const int layer = gg >> 1;
        if ((gg & 1) == 0) { src = p.ffn_w1 + (size_t)layer * DM * DFF; dst = (bf16_t*)(ws + WS_W1) + (size_t)layer * DFF * DM; K = DM; N = DFF; gk = p.norm_ffn + layer * DM; }
        else { src = p.ffn_w2 + (size_t)layer * DFF * DM; dst = (bf16_t*)(ws + WS_W2) + (size_t)layer * DM * DFF; K = DFF; N = DM; }
    }
    (void)l;
    transpose_cvt_wide(src, dst, K, N, nmat, (LAS float*)lds, G, 0, gk, 0);
    if (g == 3) sample_pool_pre(p, G);
}

constexpr int L_XC = 0;
constexpr int L_XF = 18432;
constexpr int PF = 68;
constexpr int L_A = L_XF + 128 * PF * 4;
constexpr int L_B = L_A + 128 * PF * 4;
constexpr int L_PE = L_B + 128 * PF * 4;
constexpr int L_HE = L_PE + 2048;
constexpr int L_CARRY = L_HE + 2048;
constexpr int L_GW = L_CARRY + 256;
constexpr int L_SC = L_GW + 2 * 64 * 72 * 2;
static_assert(L_SC + 768 <= LDS_BYTES - 16, "LDS map");

__device__ __forceinline__ void lru_gates(LAS unsigned char* lds) {
    const int tid = opaque_tid(), lane = tid & 63, w = tid >> 6, fr = lane & 15, fq = lane >> 4;
    const int t = 16 * w + fr;
    bf16x8 Af[2];
#pragma unroll
    for (int ks = 0; ks < 2; ++ks) Af[ks] = *(const LAS bf16x8*)(lds + L_XC + (t * 72 + ks * 32 + fq * 8) * 2);
#pragma unroll
    for (int nt = 0; nt < 4; ++nt) {
        f32x4 ra = (f32x4){0.f, 0.f, 0.f, 0.f}, rx = (f32x4){0.f, 0.f, 0.f, 0.f};
#pragma unroll
        for (int ks = 0; ks < 2; ++ks) {
            const bf16x8 Ba = *(const LAS bf16x8*)(lds + L_GW + ((nt * 16 + fr) * 72 + ks * 32 + fq * 8) * 2);
            const bf16x8 Bx = *(const LAS bf16x8*)(lds + L_GW + ((64 + nt * 16 + fr) * 72 + ks * 32 + fq * 8) * 2);
            ra = __builtin_amdgcn_mfma_f32_16x16x32_bf16(Ba, Af[ks], ra, 0, 0, 0);
            rx = __builtin_amdgcn_mfma_f32_16x16x32_bf16(Bx, Af[ks], rx, 0, 0, 0);
        }
        const int c = nt * 16 + fq * 4;
        const f32x4 bav = *(const LAS f32x4*)(lds + L_SC + c * 4), bxv = *(const LAS f32x4*)(lds + L_SC + 256 + c * 4), spv = *(const LAS f32x4*)(lds + L_SC + 512 + c * 4);
        const f32x4 xc = *(const LAS f32x4*)(lds + L_XF + (t * PF + c) * 4);
        f32x4 av, bv;
#pragma unroll
        for (int j = 0; j < 4; ++j) {
            const float r = sigmoid_f(ra[j] + bav[j]), ig = sigmoid_f(rx[j] + bxv[j]);
            const float la = -8.0f * r * spv[j];
            const float a = __builtin_amdgcn_exp2f(la * 1.442695041f);
            const float mult = __builtin_amdgcn_sqrtf(fmaxf(1.0f - a * a, 0.f));
            av[j] = a; bv[j] = mult * ig * xc[j];
        }
        *(LAS f32x4*)(lds + L_A + (t * PF + c) * 4) = av;
        *(LAS f32x4*)(lds + L_B + (t * PF + c) * 4) = bv;
    }
}

__device__ __forceinline__ u32x4 f32_to_bf8(f32x4 lo, f32x4 hi) {
    u32x4 w; w.x = cvt_pk_bf16(lo[0], lo[1]); w.y = cvt_pk_bf16(lo[2], lo[3]); w.z = cvt_pk_bf16(hi[0], hi[1]); w.w = cvt_pk_bf16(hi[2], hi[3]); return w;
}

__device__ void lru_item(const Params& p, int e, int item, LAS unsigned char* lds) {
    const int tid = opaque_tid(), lane = tid & 63, w = tid >> 6;
    const bool sample = item >= 1024;
    const int h = sample ? item - 1024 : (item & 7), b = sample ? 0 : ((item >> 3) & 7);
    const int ch0 = h * 64, ch = lane, tq = w;
    const int rr8 = tid >> 3, part = tid & 7;
    unsigned char* ws = p.ws;
    const bf16_t* XB = (const bf16_t*)(ws + WS_XB); const bf16_t* GG = (const bf16_t*)(ws + WS_GG); bf16_t* AB = (bf16_t*)(ws + WS_AB);
    const float* ba = p.gate_a_b + e * 512; const float* bx = p.gate_x_b + e * 512; const float* sp = (const float*)(ws + WS_SP) + e * 512;
    LAS float* sXF = (LAS float*)(lds + L_XF); LAS bf16_t* sXC = (LAS bf16_t*)(lds + L_XC);
    LAS float* sA = (LAS float*)(lds + L_A); LAS float* sB = (LAS float*)(lds + L_B); LAS float* sXR = (LAS float*)(lds + L_A);
    LAS float* sPE = (LAS float*)(lds + L_PE); LAS float* sHE = (LAS float*)(lds + L_HE);
    {
        const int g = tid >> 8, n = (tid >> 2) & 63, pt = tid & 3;
        const bf16_t* gw = (const bf16_t*)(ws + WS_GW) + (size_t)((e * 2 + g) * 8 + h) * 4096 + n * 64 + pt * 16;
        const u32x4 w0 = *(const u32x4*)gw, w1 = *(const u32x4*)(gw + 8);
        LAS unsigned char* d = lds + L_GW + ((g * 64 + n) * 72 + pt * 16) * 2;
        *(LAS u32x4*)d = w0; *(LAS u32x4*)(d + 16) = w1;
        if (tid < 48) {
            const int which = tid >> 4, c4 = (tid & 15) * 4;
            const float* src = which == 0 ? ba : (which == 1 ? bx : sp);
            *(LAS f32x4*)(lds + L_SC + which * 256 + c4 * 4) = *(const f32x4*)(src + ch0 + c4);
        }
    }

    if (sample) {
        const int cc = ch0 + part * 8;
        f32x4 cwl[4], cwh[4];
#pragma unroll
        for (int k = 0; k < 4; ++k) { cwl[k] = *(const f32x4*)(p.conv_w + (e * 4 + k) * 512 + cc); cwh[k] = *(const f32x4*)(p.conv_w + (e * 4 + k) * 512 + cc + 4); }
        const f32x4 cbl = *(const f32x4*)(p.conv_b + e * 512 + cc), cbh = *(const f32x4*)(p.conv_b + e * 512 + cc + 4);
#pragma unroll
        for (int i = 0; i < 2; ++i) {
            const int r = rr8 + 64 * i;
            const float* sc = p.state_conv + ((size_t)(e * 128 + r) * 3) * 512 + cc;
            const f32x4 s0l = *(const f32x4*)sc, s0h = *(const f32x4*)(sc + 4), s1l = *(const f32x4*)(sc + 512), s1h = *(const f32x4*)(sc + 516),
                        s2l = *(const f32x4*)(sc + 1024), s2h = *(const f32x4*)(sc + 1028);
            f32x4 xl, xh; bf8_to_f32(*(const u32x4*)(XB + (size_t)(MP + r) * 512 + cc), xl, xh);
            const f32x4 xcl = cbl + cwl[0] * s0l + cwl[1] * s1l + cwl[2] * s2l + cwl[3] * xl;
            const f32x4 xch = cbh + cwh[0] * s0h + cwh[1] * s1h + cwh[2] * s2h + cwh[3] * xh;
            *(LAS f32x4*)(sXF + r * PF + part * 8) = xcl; *(LAS f32x4*)(sXF + r * PF + part * 8 + 4) = xch;
            *(LAS u32x4*)(sXC + r * 72 + part * 8) = f32_to_bf8(xcl, xch);
            float* co = p.out + O_CONVS + ((size_t)(e * 128 + r) * 3) * 512 + cc;
            *(f32x4*)co = s1l; *(f32x4*)(co + 4) = s1h; *(f32x4*)(co + 512) = s2l; *(f32x4*)(co + 516) = s2h; *(f32x4*)(co + 1024) = xl; *(f32x4*)(co + 1028) = xh;
        }
        __syncthreads();
        lru_gates(lds);
        __syncthreads();
#pragma unroll
        for (int i = 0; i < 2; ++i) {
            const int r = rr8 + 64 * i;
            const float* hp = p.state_rglru + (size_t)(e * 128 + r) * 512 + cc;
            const f32x4 h0l = *(const f32x4*)hp, h0h = *(const f32x4*)(hp + 4);
            const f32x4 al = *(const LAS f32x4*)(sA + r * PF + part * 8), ah = *(const LAS f32x4*)(sA + r * PF + part * 8 + 4);
            const f32x4 bl = *(const LAS f32x4*)(sB + r * PF + part * 8), bh = *(const LAS f32x4*)(sB + r * PF + part * 8 + 4);
            const f32x4 hl = al * h0l + bl, hh = ah * h0h + bh;
            float* ho = p.out + O_HS + (size_t)(e * 128 + r) * 512 + cc;
            *(f32x4*)ho = hl; *(f32x4*)(ho + 4) = hh;
            f32x4 gl, gh; bf8_to_f32(*(const u32x4*)(GG + (size_t)(MP + r) * 512 + cc), gl, gh);
            *(u32x4*)(AB + (size_t)(MP + r) * DM + 512 + cc) = f32_to_bf8(hl * gl, hh * gh);
        }
        __syncthreads();
        return;
    }

}

constexpr int L_VT = 0;
__device__ void sgu_item(const Params& p, int e, int it, LAS unsigned char* lds) {
    const int tid = opaque_tid(), lane = tid & 63, w = tid >> 6, fr = lane & 15, fq = lane >> 4;
    unsigned char* ws = p.ws;
    const bf16_t* U = (const bf16_t*)(ws + WS_U); const bf16_t* VP = (const bf16_t*)(ws + WS_VP); bf16_t* AB = (bf16_t*)(ws + WS_AB);
    const float* VSSQ = (const float*)(ws + WS_VSSQ);
    if (it >= 1024) {
        float* vo = p.out + O_SGUV + (size_t)e * MS * 512;
        {
            const int r = (it - 1024) * 4 + (tid >> 7), c4 = (tid & 127) * 4, h = c4 >> 6;
            const float rsv = rsv_sample_full((const float*)(ws + WS_VSSQS), r);
            const u32x2 vw = *(const u32x2*)(VP + (size_t)(MP + r) * 512 + c4), uw = *(const u32x2*)(U + (size_t)(MP + r) * 512 + c4);
            const f32x4 vn = *(const f32x4*)(p.v_norm + e * 512 + c4);
            f32x4 v; v[0] = bflo(vw.x) * rsv * vn[0]; v[1] = bfhi(vw.x) * rsv * vn[1]; v[2] = bflo(vw.y) * rsv * vn[2]; v[3] = bfhi(vw.y) * rsv * vn[3];
            *(f32x4*)(vo + (size_t)r * 512 + c4) = v;
            const float w00 = p.sgu_w[(size_t)(e * 8 + h) * 16384], b0 = p.sgu_b[(e * 8 + h) * 128];
            f32x4 a; a[0] = bflo(uw.x) * (w00 * v[0] + b0); a[1] = bfhi(uw.x) * (w00 * v[1] + b0); a[2] = bflo(uw.y) * (w00 * v[2] + b0); a[3] = bfhi(uw.y) * (w00 * v[3] + b0);
            store_bf4(AB + (size_t)(MP + r) * DM + c4, a);
        }
        return;
    }
}

struct SguPre { bf16x8 wf[4]; u32x2 uw[4]; float bsv; u32x4 v0, v1; f32x4 q0, q1; f32x4 vn0, vn1, vn2, vn3; };
__device__ __forceinline__ void sgu_load(const Params& p, int e, int it, SguPre& R, int tid) {
    const int lane = tid & 63, w = tid >> 6, fr = lane & 15, fq = lane >> 4;
    unsigned char* ws = p.ws;
    const bf16_t* U = (const bf16_t*)(ws + WS_U); const bf16_t* VP = (const bf16_t*)(ws + WS_VP); const float* VSSQ = (const float*)(ws + WS_VSSQ);
    const int h = it & 7, row0 = (it >> 3) * 128, t = 16 * w + fr, nks = (16 * w + 15) / 32 + 1;
    const bf16_t* SW = (const bf16_t*)(ws + WS_SW) + (size_t)(e * 8 + h) * 16384;
#pragma unroll
    for (int ks = 0; ks < 4; ++ks) R.wf[ks] = (ks < nks) ? *(const bf16x8*)(SW + t * 128 + ks * 32 + fq * 8) : (bf16x8){0, 0, 0, 0, 0, 0, 0, 0};
#pragma unroll
    for (int nt = 0; nt < 4; ++nt) R.uw[nt] = *(const u32x2*)(U + (size_t)(row0 + t) * 512 + h * 64 + nt * 16 + fq * 4);
    R.bsv = p.sgu_b[(e * 8 + h) * 128 + t];
    const int s = tid >> 2, dq = (tid & 3) * 16;
    R.q0 = *(const f32x4*)(VSSQ + (size_t)(row0 + s) * 8); R.q1 = *(const f32x4*)(VSSQ + (size_t)(row0 + s) * 8 + 4);
    R.v0 = *(const u32x4*)(VP + (size_t)(row0 + s) * 512 + h * 64 + dq); R.v1 = *(const u32x4*)(VP + (size_t)(row0 + s) * 512 + h * 64 + dq + 8);
    const float* vn = p.v_norm + e * 512 + h * 64 + dq;
    R.vn0 = *(const f32x4*)(vn); R.vn1 = *(const f32x4*)(vn + 4); R.vn2 = *(const f32x4*)(vn + 8); R.vn3 = *(const f32x4*)(vn + 12);
}
__device__ __forceinline__ void sgu_compute(const Params& p, int it, const SguPre& R, LAS unsigned char* lds, int tid) {
    const int lane = tid & 63, w = tid >> 6, fr = lane & 15, fq = lane >> 4;
    bf16_t* AB = (bf16_t*)(p.ws + WS_AB);
    const int h = it & 7, row0 = (it >> 3) * 128, t = 16 * w + fr, nks = (16 * w + 15) / 32 + 1;
    LAS bf16_t* sVT = (LAS bf16_t*)(lds + L_VT);
    {
        const int s = tid >> 2, dq = (tid & 3) * 16;
        const float ssum = (R.q0[0] + R.q0[1] + R.q0[2] + R.q0[3]) + (R.q1[0] + R.q1[1] + R.q1[2] + R.q1[3]);
        const float rsv = __builtin_amdgcn_rsqf(ssum * (1.0f / 512.0f) + EPS);
        f32x4 f0, f1, f2, f3; bf8_to_f32(R.v0, f0, f1); bf8_to_f32(R.v1, f2, f3);
        f0 = f0 * R.vn0 * rsv; f1 = f1 * R.vn1 * rsv; f2 = f2 * R.vn2 * rsv; f3 = f3 * R.vn3 * rsv;
#pragma unroll
        for (int j = 0; j < 4; ++j) {
            sVT[(dq + j) * 136 + s] = f2bf(f0[j]); sVT[(dq + 4 + j) * 136 + s] = f2bf(f1[j]);
            sVT[(dq + 8 + j) * 136 + s] = f2bf(f2[j]); sVT[(dq + 12 + j) * 136 + s] = f2bf(f3[j]);
        }
    }
    __syncthreads();
    {
        f32x4 acc[4];
#pragma unroll
        for (int nt = 0; nt < 4; ++nt) acc[nt] = (f32x4){0.f, 0.f, 0.f, 0.f};
#pragma unroll
        for (int ks = 0; ks < 4; ++ks) {
            if (ks < nks) {
#pragma unroll
                for (int nt = 0; nt < 4; ++nt) {
                    const bf16x8 vf = *(const LAS bf16x8*)(lds + L_VT + ((nt * 16 + fr) * 136 + ks * 32 + fq * 8) * 2);
                    acc[nt] = __builtin_amdgcn_mfma_f32_16x16x32_bf16(vf, R.wf[ks], acc[nt], 0, 0, 0);
                }
            }
        }
#pragma unroll
        for (int nt = 0; nt < 4; ++nt) {
            const int c = h * 64 + nt * 16 + fq * 4;
            f32x4 o; o[0] = bflo(R.uw[nt].x) * (acc[nt][0] + R.bsv); o[1] = bfhi(R.uw[nt].x) * (acc[nt][1] + R.bsv); o[2] = bflo(R.uw[nt].y) * (acc[nt][2] + R.bsv); o[3] = bfhi(R.uw[nt].y) * (acc[nt][3] + R.bsv);
            store_bf4(AB + (size_t)(row0 + t) * DM + c, o);
        }
    }
    __syncthreads();
}

struct LruPre { u32x4 x[3]; u32x4 gg[2]; unsigned long long gq[2][2]; };
__device__ __forceinline__ void lru_load(const Params& p, int e, int item, LruPre& R, int tid) {
    const int lane = tid & 63, tq = tid >> 6, ch = lane, rr8 = tid >> 3, part = tid & 7;
    const int h = item & 7, b = (item >> 3) & 7, c = item >> 6, ch0 = h * 64, row0 = b * SEQ + c * 128;
    unsigned char* ws = p.ws;
    const bf16_t* XB = (const bf16_t*)(ws + WS_XB); const bf16_t* GG = (const bf16_t*)(ws + WS_GG);
    unsigned long long* CG = (unsigned long long*)(ws + WS_CG) + (size_t)e * 1024 * 128;
#pragma unroll
    for (int i = 0; i < 3; ++i) {
        const int rr = rr8 + 64 * i, tl = c * 128 - 3 + rr;
        R.x[i] = (rr < 131 && tl >= 0) ? *(const u32x4*)(XB + (size_t)(b * SEQ + tl) * 512 + ch0 + part * 8) : (u32x4){0u, 0u, 0u, 0u};
    }
#pragma unroll
    for (int i = 0; i < 2; ++i) R.gg[i] = *(const u32x4*)(GG + (size_t)(row0 + rr8 + 64 * i) * 512 + ch0 + part * 8);
#pragma unroll
    for (int q = 0; q < 2; ++q) {
        const int j = tq + 8 * q;
        R.gq[q][0] = 0ull; R.gq[q][1] = 0ull;
        if (j < c) { unsigned long long* g = CG + (size_t)(j * 64 + (item & 63)) * 128 + ch;
            R.gq[q][0] = __hip_atomic_load(g, __ATOMIC_RELAXED, __HIP_MEMORY_SCOPE_AGENT); R.gq[q][1] = __hip_atomic_load(g + 64, __ATOMIC_RELAXED, __HIP_MEMORY_SCOPE_AGENT); }
    }
}

__device__ void lru_prompt_loop(const Params& p, int e, LAS unsigned char* lds, int G) {
    const int tid = opaque_tid(), lane = tid & 63, w = tid >> 6;
    const int ch = lane, tq = w, rr8 = tid >> 3, part = tid & 7;
    unsigned char* ws = p.ws;
    bf16_t* AB = (bf16_t*)(ws + WS_AB);
    const float* ba = p.gate_a_b + e * 512; const float* bx = p.gate_x_b + e * 512; const float* sp = (const float*)(ws + WS_SP) + e * 512;
    LAS float* sXF = (LAS float*)(lds + L_XF); LAS bf16_t* sXC = (LAS bf16_t*)(lds + L_XC);
    LAS float* sA = (LAS float*)(lds + L_A); LAS float* sB = (LAS float*)(lds + L_B); LAS float* sXR = (LAS float*)(lds + L_A);
    LAS float* sPE = (LAS float*)(lds + L_PE); LAS float* sHE = (LAS float*)(lds + L_HE);
    LAS float* sCP = (LAS float*)(lds + L_A); LAS float* sCH = (LAS float*)(lds + L_A + 4096);
    unsigned long long* CG = (unsigned long long*)(ws + WS_CG) + (size_t)e * 1024 * 128;
    int item = blockIdx.x;
    if (item >= 1024) return;
    LruPre cur; lru_load(p, e, item, cur, tid);
    int cur_h = -1;
    float cw0 = 0.f, cw1 = 0.f, cw2 = 0.f, cw3 = 0.f, cb = 0.f;
    for (;;) {
        const int h = item & 7, b = (item >> 3) & 7, c = item >> 6, ch0 = h * 64, row0 = b * SEQ + c * 128;
        if (h != cur_h) {
            cur_h = h;
            const int g = tid >> 8, n = (tid >> 2) & 63, pt = tid & 3;
            const bf16_t* gw = (const bf16_t*)(ws + WS_GW) + (size_t)((e * 2 + g) * 8 + h) * 4096 + n * 64 + pt * 16;
            const u32x4 w0 = *(const u32x4*)gw, w1 = *(const u32x4*)(gw + 8);
            LAS unsigned char* d = lds + L_GW + ((g * 64 + n) * 72 + pt * 16) * 2;
            *(LAS u32x4*)d = w0; *(LAS u32x4*)(d + 16) = w1;
            if (tid < 48) {
                const int which = tid >> 4, c4 = (tid & 15) * 4;
                const float* src = which == 0 ? ba : (which == 1 ? bx : sp);
                *(LAS f32x4*)(lds + L_SC + which * 256 + c4 * 4) = *(const f32x4*)(src + ch0 + c4);
            }
            cw0 = p.conv_w[(e * 4 + 0) * 512 + ch0 + ch]; cw1 = p.conv_w[(e * 4 + 1) * 512 + ch0 + ch]; cw2 = p.conv_w[(e * 4 + 2) * 512 + ch0 + ch];
            cw3 = p.conv_w[(e * 4 + 3) * 512 + ch0 + ch]; cb = p.conv_b[e * 512 + ch0 + ch];
        }
#pragma unroll
        for (int i = 0; i < 3; ++i) {
            const int rr = rr8 + 64 * i;
            if (rr < 131) { f32x4 xl, xh; bf8_to_f32(cur.x[i], xl, xh);
                *(LAS f32x4*)(sXR + rr * 64 + part * 8) = xl; *(LAS f32x4*)(sXR + rr * 64 + part * 8 + 4) = xh; }
        }
        const int nitem = item + G; const bool has_next = nitem < 1024;
        LruPre nxt = cur;
        if (has_next) lru_load(p, e, nitem, nxt, tid);
        __syncthreads();
        {
            float xv[19];
#pragma unroll
            for (int j = 0; j < 19; ++j) xv[j] = sXR[(tq * 16 + j) * 64 + ch];
#pragma unroll
            for (int i = 0; i < 16; ++i) {
                const float xc = cb + cw0 * xv[i] + cw1 * xv[i + 1] + cw2 * xv[i + 2] + cw3 * xv[i + 3];
                const int t = tq * 16 + i;
                sXF[t * PF + ch] = xc; sXC[t * 72 + ch] = f2bf(xc);
            }
            if (c == 15 && tq == 7) {
                float* co = p.out + O_CONVP + ((size_t)(e * 8 + b) * 3) * 512 + ch0 + ch;
                co[0] = xv[16]; co[512] = xv[17]; co[1024] = xv[18];
            }
        }
        __syncthreads();
        lru_gates(lds);
        __syncthreads();
        {
            float Hl[16], Pc[16];
            float Hh = 0.f, Pp = 1.f;
#pragma unroll
            for (int i = 0; i < 16; ++i) {
                const float a = sA[(tq * 16 + i) * PF + ch], bb = sB[(tq * 16 + i) * PF + ch];
                Hh = a * Hh + bb; Pp = Pp * a; Hl[i] = Hh; Pc[i] = Pp;
            }
            sPE[tq * 64 + ch] = Pp; sHE[tq * 64 + ch] = Hh;
            __syncthreads();
            if (tq == 7 && c < 15) {
                float Pt = 1.f, Ht = 0.f;
#pragma unroll
                for (int s2 = 0; s2 < 8; ++s2) { const float pe = sPE[s2 * 64 + ch]; Ht = pe * Ht + sHE[s2 * 64 + ch]; Pt *= pe; }
                unsigned long long* g = CG + (size_t)item * 128 + ch;
                __hip_atomic_store(g, (1ull << 32) | (unsigned long long)__float_as_uint(Pt), __ATOMIC_RELAXED, __HIP_MEMORY_SCOPE_AGENT);
                __hip_atomic_store(g + 64, (1ull << 32) | (unsigned long long)__float_as_uint(Ht), __ATOMIC_RELAXED, __HIP_MEMORY_SCOPE_AGENT);
            }
#pragma unroll
            for (int q = 0; q < 2; ++q) {
                const int j = tq + 8 * q;
                if (j < c) {
                    unsigned long long* g = CG + (size_t)(j * 64 + (item & 63)) * 128 + ch;
                    unsigned long long gp = cur.gq[q][0], gh = cur.gq[q][1]; unsigned spin = 0;
                    while (!((gp >> 32) == 1ull && (gh >> 32) == 1ull) && ++spin < (1u << 24)) {
                        __builtin_amdgcn_s_sleep(1);
                        gp = __hip_atomic_load(g, __ATOMIC_RELAXED, __HIP_MEMORY_SCOPE_AGENT); gh = __hip_atomic_load(g + 64, __ATOMIC_RELAXED, __HIP_MEMORY_SCOPE_AGENT);
                    }
                    sCP[j * 64 + ch] = __uint_as_float((unsigned)gp); sCH[j * 64 + ch] = __uint_as_float((unsigned)gh);
                }
            }
            __syncthreads();
            float hin = 0.f;
            {
                float cp[15], chv[15], pe[7], he[7];
#pragma unroll
                for (int j = 0; j < 15; ++j) { cp[j] = sCP[j * 64 + ch]; chv[j] = sCH[j * 64 + ch]; }
#pragma unroll
                for (int s2 = 0; s2 < 7; ++s2) { pe[s2] = sPE[s2 * 64 + ch]; he[s2] = sHE[s2 * 64 + ch]; }
#pragma unroll
                for (int j = 0; j < 15; ++j) hin = (j < c) ? cp[j] * hin + chv[j] : hin;
#pragma unroll
                for (int s2 = 0; s2 < 7; ++s2) hin = (s2 < tq) ? pe[s2] * hin + he[s2] : hin;
            }
            float hlast = 0.f;
#pragma unroll
            for (int i = 0; i < 16; ++i) { const float hv = Hl[i] + Pc[i] * hin; hlast = hv; sXF[(tq * 16 + i) * PF + ch] = hv; }
            if (tq == 7 && c == 15) p.out[O_HP + (size_t)(e * 8 + b) * 512 + ch0 + ch] = hlast;
            __syncthreads();
        }
#pragma unroll
        for (int i = 0; i < 2; ++i) {
            const int t = rr8 + 64 * i;
            f32x4 gl, gh; bf8_to_f32(cur.gg[i], gl, gh);
            const f32x4 hl = *(const LAS f32x4*)(sXF + t * PF + part * 8), hh = *(const LAS f32x4*)(sXF + t * PF + part * 8 + 4);
            *(u32x4*)(AB + (size_t)(row0 + t) * DM + 512 + ch0 + part * 8) = f32_to_bf8(hl * gl, hh * gh);
        }
        if (!has_next) break;
        cur = nxt; item = nitem;
    }
    __syncthreads();
}

__device__ void phase_e2(const Params& p, int e, LAS unsigned char* lds, int G) {
    lru_prompt_loop(p, e, lds, G);
    constexpr int NLRU = 1032;
    int itg = blockIdx.x; while (itg < 1024) itg += G;
    for (; itg < NLRU; itg += G) lru_item(p, e, itg, lds);
    const int tid = opaque_tid();
    const int blk = blockIdx.x;
    const int j0 = blk >= 8 ? blk - 8 : 248 + blk;
    const int nit = blk < 8 ? 2 : ((blk >= 40 && blk < 56) ? 5 : 4);
#define SGU_IDX(k) ((k) < 4 ? j0 + 256 * (k) : 760 + ((blk - 40) & 7) + 256 * ((blk - 40) >> 3))
    {
        SguPre A, B; sgu_load(p, e, SGU_IDX(0), A, tid); B = A;
        int k = 0;
        for (;;) {
            if (k + 1 < nit) sgu_load(p, e, SGU_IDX(k + 1), B, tid);
            sgu_compute(p, SGU_IDX(k), A, lds, tid);
            if (++k >= nit) break;
            if (k + 1 < nit) sgu_load(p, e, SGU_IDX(k + 1), A, tid);
            sgu_compute(p, SGU_IDX(k), B, lds, tid);
            if (++k >= nit) break;
        }
    }
#undef SGU_IDX
    if (blk >= 8 && blk < 40) sgu_item(p, e, 1024 + blk - 8, lds);
}

template <int W>
__device__ __forceinline__ void pool_rows(const float (&v0)[31], const float (&v1)[31], int t0, bf16_t* pa) {
    float s0 = 0.f, s1 = 0.f;
#pragma unroll
    for (int q = 0; q < W; ++q) { s0 += v0[15 - q]; s1 += v1[15 - q]; }
#pragma unroll
    for (int i = 0; i < 16; ++i) {
        const int jj = 15 + i, t = t0 + i;
        if (i > 0) { s0 += v0[jj] - v0[jj - W]; s1 += v1[jj] - v1[jj - W]; }
        const float ic = (t + 1 < W) ? 1.0f / (float)(t + 1) : (1.0f / (float)W);
        *(unsigned*)(pa + (size_t)i * DM) = cvt_pk_bf16(s0 * ic - v0[jj], s1 * ic - v1[jj]);
    }
}

__device__ void sample_pool_pre(const Params& p, int G) {
    const int tid = opaque_tid();
    const int c = tid * 2, w = 2 << (c >> 8);
    float* SPS = (float*)(p.ws + WS_SPSUM);
    for (int it = blockIdx.x; it < 2 * MS; it += G) {
        const int o = it >> 7, r = it & 127;
        const float* sp = p.state_pool + ((size_t)(o * 128 + r) * 15) * DM + c;
        float* po = p.out + O_POOLS + ((size_t)(o * 128 + r) * 15) * DM + c;
        f32x2 z[15];
#pragma unroll
        for (int k = 0; k < 15; ++k) z[k] = *(const f32x2*)(sp + (size_t)k * DM);
        float s0 = 0.f, s1 = 0.f;
#pragma unroll
        for (int k = 14; k >= 0; --k) {
            if (14 - k < w - 1) { s0 += z[k].x; s1 += z[k].y; }
            if (k >= 1) *(f32x2*)(po + (size_t)(k - 1) * DM) = z[k];
        }
        f32x2 sv; sv.x = s0; sv.y = s1;
        *(f32x2*)(SPS + (size_t)(o * 128 + r) * DM + c) = sv;
    }
}

template <int W>
__device__ __forceinline__ void pool_tile_rows(const Params& p, int layer, int pm, int pn, LAS float* sRS, int tid) {
    const int o = layer >> 1, b = pm >> 3, tbase = (pm & 7) * 256;
    const bf16_t* X = (const bf16_t*)(p.ws + WS_XG); bf16_t* PA = (bf16_t*)(p.ws + WS_PA);
    const bf16_t* HALO = (const bf16_t*)(p.ws + WS_HALO);
    const int c = pn * 256 + (tid & 127) * 2;
    const f32x2 gmix = *(const f32x2*)(p.norm_mix + layer * DM + c);
    for (int s = tid >> 7; s < 16; s += 4) {
        const int t0 = tbase + s * 16;
        unsigned wv[31];
#pragma unroll
        for (int j = 0; j < 31; ++j) {
            const int tl = t0 - 15 + j;
            const bf16_t* src = (s == 0 && j < 15) ? HALO + (size_t)((pm - 1) * 16 + j + 1) * DM + c : X + (size_t)(b * SEQ + tl) * DM + c;
            wv[j] = (tl >= 0) ? *(const unsigned*)src : 0u;
        }
        float v0[31], v1[31];
#pragma unroll
        for (int j = 0; j < 31; ++j) { const float rs = sRS[s * 16 + j]; v0[j] = bflo(wv[j]) * rs * gmix.x; v1[j] = bfhi(wv[j]) * rs * gmix.y; }
        pool_rows<W>(v0, v1, t0, PA + (size_t)(b * SEQ + t0) * DM + c);
        if (t0 == SEQ - 16) {
#pragma unroll
            for (int k = 0; k < 15; ++k) { f32x2 z; z.x = v0[16 + k]; z.y = v1[16 + k]; *(f32x2*)(p.out + O_POOLP + ((size_t)(o * 8 + b) * 15 + k) * DM + c) = z; }
        }
    }
}
__device__ void pool_tile_prep(const Params& p, int layer, int pm, int pn, LAS unsigned char* lds) {
    const int tid = opaque_tid();
    const float* SSQ = (const float*)(p.ws + WS_SSQ);
    LAS float* sRS = (LAS float*)lds;
    const int b = pm >> 3, tbase = (pm & 7) * 256;
    if (tid < 271) { const int tl = tbase - 15 + tid; sRS[tid] = tl >= 0 ? row_rs16(SSQ, b * SEQ + tl) : 0.f; }
    __syncthreads();
    if (pn == 0) pool_tile_rows<2>(p, layer, pm, pn, sRS, tid); else if (pn == 1) pool_tile_rows<4>(p, layer, pm, pn, sRS, tid);
    else if (pn == 2) pool_tile_rows<8>(p, layer, pm, pn, sRS, tid); else pool_tile_rows<16>(p, layer, pm, pn, sRS, tid);
    asm volatile("s_waitcnt vmcnt(0)" ::: "memory");
    __syncthreads();
}

template <class Epi>
__device__ __forceinline__ void skinny_pool(const Params& p, int layer, const bf16_t* Bt, const Epi& E, int G, const bf16_t* Xs, const float* SSQS) {
    const int tid = opaque_tid(), wave = tid >> 6, lane = tid & 63, fr = lane & 15, fq = lane >> 4;
    const int o = layer >> 1;
    const float* SPS = (const float*)(p.ws + WS_SPSUM) + (size_t)o * MS * DM;
    for (int ct = blockIdx.x; ct < 64; ct += G) {
        const int r = wave * 16 + fr, grp = ct >> 4, w = 2 << grp;
        const float invw = 1.0f / (float)w;
        const f32x2 pp = E.pre(r, ct * 16 + fq * 4, fq);
        const f32x2 ssp = ssqs_part(SSQS, r, fq);
        u32x4 xw[8]; bf16x8 bfr[8];
#pragma unroll
        for (int j = 0; j < 8; ++j) {
            const int col = grp * 256 + j * 32 + fq * 8;
            xw[j] = *(const u32x4*)(Xs + (size_t)r * DM + col);
            bfr[j] = *(const bf16x8*)(Bt + (size_t)(ct * 16 + fr) * 256 + j * 32 + fq * 8);
        }
        const float rs = ssqs_finish(ssp);
        f32x4 acc = (f32x4){0.f, 0.f, 0.f, 0.f};
#pragma unroll
        for (int j = 0; j < 8; ++j) {
            const int col = grp * 256 + j * 32 + fq * 8;
            const f32x4 s0 = *(const f32x4*)(SPS + (size_t)r * DM + col), s1 = *(const f32x4*)(SPS + (size_t)r * DM + col + 4);
            const f32x4 g0 = *(const f32x4*)(p.norm_mix + layer * DM + col), g1 = *(const f32x4*)(p.norm_mix + layer * DM + col + 4);
            f32x4 x0, x1; bf8_to_f32(xw[j], x0, x1);
            x0 = x0 * g0 * rs; x1 = x1 * g1 * rs;
            if ((ct & 15) == 0) { float* po = p.out + O_POOLS + ((size_t)(o * 128 + r) * 15 + 14) * DM + col; *(f32x4*)po = x0; *(f32x4*)(po + 4) = x1; }
            const f32x4 p0 = (x0 + s0) * invw - x0, p1 = (x1 + s1) * invw - x1;
            const u32x4 pk = pack_bf8(p0, p1);
            bf16x8 af; __builtin_memcpy(&af, &pk, 16);
            acc = __builtin_amdgcn_mfma_f32_16x16x32_bf16(bfr[j], af, acc, 0, 0, 0);
        }
        E(r, ct * 16 + fq * 4, ct, fq, acc, pp);
    }
}

__device__ void phase_final(const Params& p, int G, const bf16_t* Xs, const float* SSQS) {
    const int tidf = opaque_tid();
    const int wave = tidf >> 6, lane = tidf & 63;
    const float* SSQ = (const float*)(p.ws + WS_SSQ);
    const bf16_t* X = (const bf16_t*)(p.ws + WS_XG);
    for (int row = blockIdx.x * 8 + wave; row < MR; row += G * 8) {
        const float rs = row < MP ? row_rs16(SSQ, row) : rs_sample_full(SSQS, row - MP);
        float* yr = p.out + (size_t)row * DM;
#pragma unroll
        for (int q = 0; q < 4; ++q) {
            const int col = q * 256 + lane * 4;
            const u32x2 xw = row < MP ? *(const u32x2*)(X + (size_t)row * DM + col) : *(const u32x2*)(Xs + (size_t)(row - MP) * DM + col);
            const f32x4 gv = *(const f32x4*)(p.norm_final + col);
            f32x4 v; v[0] = bflo(xw.x); v[1] = bfhi(xw.x); v[2] = bflo(xw.y); v[3] = bfhi(xw.y);
            *(f32x4*)(yr + col) = v * gv * rs;
        }
    }
}

__global__ void __launch_bounds__(NTHR, 2) fwd_megakernel(Params p) {
    extern __shared__ __attribute__((aligned(16))) unsigned char smem[];
    LAS unsigned char* lds = (LAS unsigned char*)smem;
    cg::grid_group grid = cg::this_grid();
    const int G = gridDim.x;
    unsigned char* ws = p.ws;
    bf16_t* XG = (bf16_t*)(ws + WS_XG); float* SSQ = (float*)(ws + WS_SSQ);

    volatile LAS unsigned* st = (volatile LAS unsigned*)(lds + LDS_BYTES - 16);
    if (threadIdx.x < 4) st[threadIdx.x] = 0u;
    __syncthreads();
    const XcdBarrier bar = xcd_barrier_post((unsigned*)(ws + WS_BAR), st);
    float* SSQ2 = (float*)(ws + WS_SSQ2); bf16_t* HALO = (bf16_t*)(ws + WS_HALO);
    bf16_t* Xs_cur = XG + (size_t)MP * DM; bf16_t* Xs_alt = (bf16_t*)(ws + WS_XS2);
    float* SSQS_cur = (float*)(ws + WS_SSQS); float* SSQS_alt = (float*)(ws + WS_SSQS2);

    if (p.ws == nullptr) grid.sync();
    phase_prep(p, lds, G);
    xcd_barrier_arrive(bar); gap_convert(p, 0, lds, G); gap0_extras(p, lds, G); xcd_barrier_wait(bar);

    for (int ph = 0; ph < 16; ++ph) {
        const int q = ph & 7, layer = (ph >> 3) * 2 + (q >= 5 ? 1 : 0);
        const int kind = q < 5 ? q : (q == 5 ? 6 : q - 3);
        if (kind == 0) {
            const int e = layer >> 1;
            const bf16_t* Wt = (const bf16_t*)(ws + WS_WIN) + (size_t)e * DIN * DM;
            pg8::Gemm g{XG, Wt, MP, DIN, DM, DM, DM, 0};
            pg8::StaticOrder S; S.init(MP, DIN, G, (int)blockIdx.x);
            pg8::Unit u0; const int pm0 = S.next(0, u0) ? u0.pm : -1;
            if (pm0 >= 0) fill_rs_table(lds, SSQ, pm0);
            EpiE1 E{SSQ, (bf16_t*)(ws + WS_U), (float*)(ws + WS_VSSQ), lds, pm0};
            pg8::gemm_phase<EpiE1>(lds, g, S, E);
            SkE1 Es{SSQS_cur, (bf16_t*)(ws + WS_U), (float*)(ws + WS_VSSQS)};
            skinny_gemm_k1024<SkE1>(lds, Xs_cur, DM, Wt, DM, DIN, Es, G);
        } else if (kind == 1) {
            phase_e2(p, layer >> 1, lds, G);
        } else if (kind == 2) {
            const int e = layer >> 1;
            const bf16_t* Wt = (const bf16_t*)(ws + WS_WOUT) + (size_t)e * DM * DM;
            pg8::Gemm g{(const bf16_t*)(ws + WS_AB), Wt, MP, DM, DM, DM, DM, 0};
            pg8::StaticOrder S; S.init(MP, DM, G, (int)blockIdx.x);
            EpiRes E{XG, SSQ, nullptr, nullptr, lds, nullptr};
            pg8::gemm_phase<EpiRes>(lds, g, S, E);
            SkRes Es{Xs_cur, Xs_cur, SSQS_cur, nullptr, nullptr};
            skinny_gemm<4, 8, SkRes>(lds, (const bf16_t*)(ws + WS_AB) + (size_t)MP * DM, DM, 0, Wt, DM, DM, DM, Es, G);
        } else if (kind == 6) {
            const int o = layer >> 1;
            const bf16_t* Wt = (const bf16_t*)(ws + WS_WP) + (size_t)o * DM * 256;
            pg8::Gemm g{(const bf16_t*)(ws + WS_PA), Wt, MP, DM, 256, DM, 256, 256};
            pg8::StaticOrder S; S.init(MP, DM, G, (int)blockIdx.x);
            { pg8::Unit u0; if (S.next(0, u0)) pool_tile_prep(p, layer, u0.pm, u0.pn, lds); }
            EpiRes E{XG, SSQ2, p.pool_b + o * DM, p.pool_scale + o * DM, lds, nullptr};
            pg8::gemm_phase<EpiRes>(lds, g, S, E);
            SkRes Es{Xs_cur, Xs_alt, SSQS_alt, p.pool_b + o * DM, p.pool_scale + o * DM};
            skinny_pool<SkRes>(p, layer, Wt, Es, G, Xs_cur, SSQS_cur);
            { bf16_t* tx = Xs_cur; Xs_cur = Xs_alt; Xs_alt = tx; float* ts = SSQS_cur; SSQS_cur = SSQS_alt; SSQS_alt = ts; }
        } else if (kind == 3) {
            const bf16_t* Wt = (const bf16_t*)(ws + WS_W1) + (size_t)layer * DFF * DM;
            pg8::Gemm g{XG, Wt, MP, DFF, DM, DM, DM, 0};
            pg8::StaticOrder S; S.init(MP, DFF, G, (int)blockIdx.x);
            pg8::Unit u0; const int pm0 = S.next(0, u0) ? u0.pm : -1;
            const float* ssq_in = (layer & 1) ? SSQ2 : SSQ;
            if (pm0 >= 0) fill_rs_table(lds, ssq_in, pm0);
            EpiF1 E{ssq_in, (bf16_t*)(ws + WS_H), lds, pm0};
            pg8::gemm_phase<EpiF1>(lds, g, S, E);
            SkF1 Es{SSQS_cur, (bf16_t*)(ws + WS_H)};
            skinny_gemm_k1024<SkF1>(lds, Xs_cur, DM, Wt, DM, DFF, Es, G);
        } else {
            const bf16_t* Wt = (const bf16_t*)(ws + WS_W2) + (size_t)layer * DM * DFF;
            pg8::Gemm g{(const bf16_t*)(ws + WS_H), Wt, MP, DM, DFF, DFF, DFF, 0};
            pg8::StaticOrder S; S.init(MP, DM, G, (int)blockIdx.x);
            EpiRes E{XG, SSQ, nullptr, nullptr, lds, (layer & 1) ? nullptr : HALO};
            pg8::gemm_phase<EpiRes>(lds, g, S, E);
            SkRes Es{Xs_cur, Xs_cur, SSQS_cur, nullptr, nullptr};
            skinny_gemm_k4096<SkRes>(lds, (const bf16_t*)(ws + WS_H) + (size_t)MP * DFF, DFF, Wt, DFF, DM, Es, G);
        }
        xcd_barrier_arrive(bar); gap_convert(p, ph + 1, lds, G); xcd_barrier_wait(bar);
    }
    phase_final(p, G, Xs_cur, SSQS_cur);
}

extern "C" void kernel_launch(void* const* d_in, const int* in_sizes, int n_in, void* d_out, int out_size, void* d_ws, size_t ws_size, hipStream_t stream) {
    static int grid_blocks = 0;
    if (grid_blocks == 0) {
        if (n_in != 25 || (size_t)out_size != O_END || ws_size < WS_END) {
            fprintf(stderr, "kernel_launch: unexpected shapes: n_in %d out %d (want %zu) ws %zu (need %zu)\n", n_in, out_size, (size_t)O_END, ws_size, (size_t)WS_END);
            grid_blocks = -1; return;
        }
        int dev = 0, cus = 0, per_cu = 0;
        hipGetDevice(&dev);
        hipDeviceGetAttribute(&cus, hipDeviceAttributeMultiprocessorCount, dev);
        if (hipFuncSetAttribute((const void*)fwd_megakernel, hipFuncAttributeMaxDynamicSharedMemorySize, LDS_BYTES) != hipSuccess) { fprintf(stderr, "kernel_launch: hipFuncSetAttribute failed\n"); grid_blocks = -1; return; }
        if (hipOccupancyMaxActiveBlocksPerMultiprocessor(&per_cu, (const void*)fwd_megakernel, NTHR, LDS_BYTES) != hipSuccess || per_cu < 1) { fprintf(stderr, "kernel_launch: occupancy query failed (%d)\n", per_cu); (void)hipGetLastError(); per_cu = 1; }
        grid_blocks = cus * 1;
        if (grid_blocks != 256) { fprintf(stderr, "kernel_launch: this kernel is laid out for 256 CUs, found %d\n", cus); grid_blocks = -1; return; }
    }
    if (grid_blocks < 0) return;
    Params p{};
    const float** pp = (const float**)&p;
    for (int i = 0; i < 25; ++i) pp[i] = (const float*)d_in[i];
    p.out = (float*)d_out; p.ws = (unsigned char*)d_ws;
    if (hipMemsetAsync((char*)d_ws + WS_BAR, 0, 16384, stream) != hipSuccess) { fprintf(stderr, "kernel_launch: memset failed\n"); return; }
    void* args[] = {&p};
    hipError_t e = hipLaunchCooperativeKernel((const void*)fwd_megakernel, dim3(grid_blocks), dim3(NTHR), args, LDS_BYTES, stream);
    if (e != hipSuccess) fprintf(stderr, "cooperative launch failed: %s (grid %d)\n", hipGetErrorString(e), grid_blocks);
}
```
